# Optimizing an MI355X kernel written in HIP

```python
import math
import jax, jax.numpy as jnp
from jax import lax
import numpy as np

D_MODEL = 1024
BATCH = 16
SEQ = 4096
DEPTH = 1
DEC_BATCH = 8
DEC_SEQ = 8192
PAST_LEN = 128

N_HEADS = 4
HEAD_DIM = 64
V_DIM = 2 * HEAD_DIM
ATTN_WIDTH = N_HEADS * V_DIM
QK_WIDTH = N_HEADS * 2 * HEAD_DIM
POOL_WINDOWS = (2, 4, 8, 16)
N_POOL_GROUPS = len(POOL_WINDOWS)
POOL_GROUP_DIM = 128
POOL_WIDTH = N_POOL_GROUPS * POOL_GROUP_DIM
MIX_WIDTH = ATTN_WIDTH + POOL_WIDTH
IN_WIDTH = 2 * QK_WIDTH + ATTN_WIDTH + POOL_WIDTH
D_FF = 2816
CONV_WIDTH = 3
ROPE_THETA = 10000.0
Q_BLOCK = 128
EPS = 1e-6

kernel_name = "hybrid_pool_diffattn_encoder"


def rms_norm(x, g):
    xf = x.astype(jnp.float32)
    y = xf * lax.rsqrt(jnp.mean(xf * xf, axis=-1, keepdims=True) + EPS)
    return (y * g.astype(jnp.float32)).astype(x.dtype)


def rope_tables(seq_len, dtype):
    inv = ROPE_THETA ** (-jnp.arange(0, HEAD_DIM, 2, dtype=jnp.float32) / HEAD_DIM)
    ang = jnp.arange(seq_len, dtype=jnp.float32)[:, None] * inv[None, :]
    ang = jnp.concatenate([ang, ang], axis=-1)
    return jnp.cos(ang).astype(dtype), jnp.sin(ang).astype(dtype)


def apply_rope(x, cos, sin):
    c = cos[None, :, None, None, :]
    s = sin[None, :, None, None, :]
    x1, x2 = jnp.split(x, 2, axis=-1)
    return x * c + jnp.concatenate([-x2, x1], axis=-1) * s


def diff_attention(q, k, v, lam):
    B, S = q.shape[0], q.shape[1]
    nb = S // Q_BLOCK
    scale = 1.0 / math.sqrt(HEAD_DIM)
    qb = jnp.moveaxis(q.reshape(B, nb, Q_BLOCK, N_HEADS, 2, HEAD_DIM), 1, 0)

    def one_block(qblk):
        s = jnp.einsum('bqhmd,bkhmd->bhmqk', qblk, k).astype(jnp.float32) * scale
        p = jax.nn.softmax(s, axis=-1)
        a = p[:, :, 0] - lam * p[:, :, 1]
        return jnp.einsum('bhqk,bkhe->bqhe', a.astype(v.dtype), v)

    o = lax.map(one_block, qb)
    return jnp.moveaxis(o, 0, 1).reshape(B, S, N_HEADS, V_DIM)


def multiscale_pool(p):
    B, S = p.shape[0], p.shape[1]
    pf = p.astype(jnp.float32)
    cs = jnp.concatenate([jnp.zeros((B, 1) + pf.shape[2:], jnp.float32),
                          jnp.cumsum(pf, axis=1)], axis=1)
    idx = jnp.arange(S)
    outs = []
    for g, w in enumerate(POOL_WINDOWS):
        lo = jnp.maximum(idx - w // 2, 0)
        hi = jnp.minimum(idx + w // 2 - 1, S - 1)
        csg = cs[:, :, g]
        tot = csg[:, hi + 1] - csg[:, lo]
        cnt = (hi - lo + 1).astype(jnp.float32)[None, :, None]
        outs.append(tot / cnt - pf[:, :, g])
    return jnp.stack(outs, axis=2).astype(p.dtype)


def depthwise_conv_centred(h, w, b):
    hp = jnp.pad(h, ((0, 0), (1, 1), (0, 0)))
    S = h.shape[1]
    return hp[:, 0:S] * w[0] + hp[:, 1:S + 1] * w[1] + hp[:, 2:S + 2] * w[2] + b


def encoder_layer(x, layer_idx, norm1_g, w_in, q_norm_g, k_norm_g, lambda_q1,
                  lambda_k1, lambda_q2, lambda_k2, subln_g, w_pool, pool_scale,
                  w_out, norm2_g, w_up, conv_w, conv_b, w_down):
    B, S, _ = x.shape
    lambda_init = 0.8 - 0.6 * math.exp(-0.3 * layer_idx)
    h = rms_norm(x, norm1_g)
    z = jnp.einsum('bsd,de->bse', h, w_in)
    zq, zk, zv, zp = jnp.split(
        z, [QK_WIDTH, 2 * QK_WIDTH, 2 * QK_WIDTH + ATTN_WIDTH], axis=-1)
    q = rms_norm(zq.reshape(B, S, N_HEADS, 2, HEAD_DIM), q_norm_g)
    k = rms_norm(zk.reshape(B, S, N_HEADS, 2, HEAD_DIM), k_norm_g)
    cos, sin = rope_tables(S, x.dtype)
    q = apply_rope(q, cos, sin)
    k = apply_rope(k, cos, sin)
    v = zv.reshape(B, S, N_HEADS, V_DIM)
    lam = (jnp.exp(jnp.sum(lambda_q1.astype(jnp.float32) * lambda_k1.astype(jnp.float32)))
           - jnp.exp(jnp.sum(lambda_q2.astype(jnp.float32) * lambda_k2.astype(jnp.float32)))
           + lambda_init)
    o = diff_attention(q, k, v, lam)
    o = rms_norm(o, subln_g) * (1.0 - lambda_init)
    o_attn = o.reshape(B, S, ATTN_WIDTH)
    pg = multiscale_pool(zp.reshape(B, S, N_POOL_GROUPS, POOL_GROUP_DIM))
    pg = jnp.einsum('bsgc,gce->bsge', pg, w_pool).reshape(B, S, POOL_WIDTH)
    o_pool = pg * pool_scale
    mixed = jnp.concatenate([o_attn, o_pool], axis=-1)
    x = x + jnp.einsum('bse,ed->bsd', mixed, w_out)
    h2 = rms_norm(x, norm2_g)
    u = jnp.einsum('bsd,df->bsf', h2, w_up)
    u = depthwise_conv_centred(u, conv_w, conv_b)
    gate, val = jnp.split(u, 2, axis=-1)
    x = x + jnp.einsum('bsf,fd->bsd', jax.nn.silu(gate) * val, w_down)
    return x


def setup_inputs(seed: int = 0) -> dict:
    key = jax.random.key(seed)
    ks = jax.random.split(key, 20)
    n = lambda k, shape, s: jax.random.normal(k, shape, jnp.float32) * s
    L = DEPTH
    return {
        "x_prompt": n(ks[0], (BATCH, SEQ, D_MODEL), 1.0),
        "x_sample": n(ks[1], (DEC_BATCH, DEC_SEQ, D_MODEL), 1.0),
        "norm1_g": 1.0 + n(ks[2], (L, D_MODEL), 0.02),
        "w_in": n(ks[3], (L, D_MODEL, IN_WIDTH), D_MODEL ** -0.5),
        "q_norm_g": 1.0 + n(ks[4], (L, HEAD_DIM), 0.02),
        "k_norm_g": 1.0 + n(ks[5], (L, HEAD_DIM), 0.02),
        "lambda_q1": n(ks[6], (L, HEAD_DIM), 0.1),
        "lambda_k1": n(ks[7], (L, HEAD_DIM), 0.1),
        "lambda_q2": n(ks[8], (L, HEAD_DIM), 0.1),
        "lambda_k2": n(ks[9], (L, HEAD_DIM), 0.1),
        "subln_g": 1.0 + n(ks[10], (L, V_DIM), 0.02),
        "w_pool": n(ks[11], (L, N_POOL_GROUPS, POOL_GROUP_DIM, POOL_GROUP_DIM), POOL_GROUP_DIM ** -0.5),
        "pool_scale": 1.0 + n(ks[12], (L, POOL_WIDTH), 0.1),
        "w_out": n(ks[13], (L, MIX_WIDTH, D_MODEL), MIX_WIDTH ** -0.5),
        "norm2_g": 1.0 + n(ks[14], (L, D_MODEL), 0.02),
        "w_up": n(ks[15], (L, D_MODEL, 2 * D_FF), D_MODEL ** -0.5),
        "conv_w": n(ks[16], (L, CONV_WIDTH, 2 * D_FF), CONV_WIDTH ** -0.5),
        "conv_b": n(ks[17], (L, 2 * D_FF), 0.01),
        "w_down": n(ks[18], (L, D_FF, D_MODEL), D_FF ** -0.5),
    }


def reference(x_prompt, x_sample, norm1_g, w_in, q_norm_g, k_norm_g, lambda_q1,
              lambda_k1, lambda_q2, lambda_k2, subln_g, w_pool, pool_scale,
              w_out, norm2_g, w_up, conv_w, conv_b, w_down):
    yp = x_prompt
    ys = x_sample
    for l in range(DEPTH):
        params = (norm1_g[l], w_in[l], q_norm_g[l], k_norm_g[l], lambda_q1[l],
                  lambda_k1[l], lambda_q2[l], lambda_k2[l], subln_g[l], w_pool[l],
                  pool_scale[l], w_out[l], norm2_g[l], w_up[l], conv_w[l],
                  conv_b[l], w_down[l])
        yp = encoder_layer(yp, l, *params)
        ys = encoder_layer(ys, l, *params)
    return (yp, ys)
```

```cpp
#include <hip/hip_runtime.h>
#include <hip/hip_cooperative_groups.h>
#include <cstdio>
#include <cstdint>
namespace cg = cooperative_groups;

namespace pg8 {
#define PG8_LAS __attribute__((address_space(3)))
typedef unsigned short bf16_t;
typedef short bf16x8 __attribute__((ext_vector_type(8)));
typedef float f32x4 __attribute__((ext_vector_type(4)));
typedef unsigned u32x4 __attribute__((ext_vector_type(4)));
constexpr int BM = 256, BK = 64, HALF = 128, HTB = HALF * BK * 2  , STAGE_BYTES = 8 * HTB, NXCD = 8, WGM = 8;

__host__ __device__ __forceinline__ int lds_byte(int r, int c) { const int st = (r >> 4) * 2 + (c >> 5), rr = r & 15, cc = c & 31, ob = rr * 64 + cc * 2; return st * 1024 + (ob ^ (((ob >> 9) & 1) << 5)); }
__host__ __device__ __forceinline__ void stage_rc(int b, int& R, int& C) { const int st = b / 1024, sb = b % 1024, swz = sb ^ (((sb >> 9) & 1) << 5); R = (st >> 1) * 16 + swz / 64; C = (st & 1) * 32 + (swz % 64) / 2; }
__host__ __device__ __forceinline__ int perm32(int rho) { const int n = rho >> 4, i = rho & 15; return 8 * (i >> 2) + 4 * n + (i & 3); }

struct Unit { int pm, pn; };
struct Gemm { const bf16_t* A; const bf16_t* Bt; int M, N, K; };

struct StaticOrder {
    int nM, nN, nwg, G, c; int halo;
    __host__ __device__ void init_tiles(int nM_, int nN_, int G_, int c_, int halo_) { nM = nM_; nN = nN_; nwg = nM * nN; G = G_; c = c_; halo = halo_; }
    __device__ __forceinline__ long a_off(int pm, int K) const { return halo ? ((long)254 * pm - 1) * (long)K * 2 : (long)pm * 256 * (long)K * 2; }
    __host__ __device__ void init(int M, int N, int G_, int c_) { nM = M / BM; nN = N / BM; nwg = nM * nN; G = G_; c = c_; halo = 0; }
    __host__ __device__ bool next(int i, Unit& u) const {
        const long L = (long)i * G + c; if (L >= nwg) return false;
        int wgid = (int)L; { const int q = nwg / NXCD, r = nwg % NXCD, xcd = wgid % NXCD, off = wgid / NXCD; wgid = (xcd < r ? xcd * (q + 1) : r * (q + 1) + (xcd - r) * q) + off; }
        const int nig = WGM * nN, gid = wgid / nig, fm = gid * WGM, gsz = (nM - fm) < WGM ? (nM - fm) : WGM;
        u.pm = fm + ((wgid % nig) % gsz); u.pn = (wgid % nig) / gsz; return true;
    }
    __device__ __forceinline__ void a_ready(const Unit&) const {}
    __device__ __forceinline__ void done(const Unit&) const {}
};
__device__ __forceinline__ unsigned cvt_pk_bf16(float lo, float hi) { unsigned r; asm volatile("v_cvt_pk_bf16_f32 %0, %1, %2" : "=v"(r) : "v"(lo), "v"(hi)); return r; }
typedef float f32x2 __attribute__((ext_vector_type(2)));
typedef float f32x2 __attribute__((ext_vector_type(2)));
template <class Epi, class Sched, bool ALIGN_EPI = false, bool SP2 = false>
__device__ __forceinline__ void gemm_phase(PG8_LAS unsigned char* lds, const Gemm g, const Sched& S, const Epi& E) {
    int tid_ = threadIdx.x; asm volatile("" : "+v"(tid_));
    const int tid = tid_, wid = __builtin_amdgcn_readfirstlane(tid >> 6), lane = tid & 63, wr = wid >> 2, wc = wid & 3, fr = lane & 15, fq = lane >> 4;
    const int K = g.K, nt = K / BK;
    unsigned voffA[2], voffB[2];
#pragma unroll
    for (int i = 0; i < 2; ++i) { int R, C; stage_rc(tid * 16 + i * 8192, R, C); const int Rb = Epi::PERM ? ((R & ~31) + perm32(R & 31)) : R;
        voffA[i] = (unsigned)(R * K + C) * 2u; voffB[i] = (unsigned)(Rb * K + C) * 2u; }
    const size_t kstep = (size_t)(BK * 2);
    const size_t hstep = (size_t)HALF * K * 2;
    const size_t tstep = 2 * hstep;
    const unsigned ldsw = (unsigned)wid * 1024u;
    const int aoff = lds_byte(wr * 64 + fr, fq * 8), boff = lds_byte(wc * 32 + fr, fq * 8);
#define PG8_SA(b, h) (((b) * 2 + (h)) * HTB)
#define PG8_SB(b, h) ((4 + (b) * 2 + (h)) * HTB)
#define PG8_STAGE(bufoff, gbase, voff) do { _Pragma("unroll") for (int _i = 0; _i < 2; ++_i) \
        __builtin_amdgcn_global_load_lds((const unsigned*)((const char*)(gbase) + (voff)[_i]), (PG8_LAS unsigned*)(lds + (bufoff) + ldsw + _i * 8192), 16, 0, 0); } while (0)
#define PG8_LDA(dst, b, h) do { _Pragma("unroll") for (int m = 0; m < 4; ++m) _Pragma("unroll") for (int k = 0; k < 2; ++k) dst[m][k] = *(const PG8_LAS bf16x8*)(lds + PG8_SA(b, h) + aoff + m * 2048 + k * 1024); } while (0)
#define PG8_LDB(dst, b, h) do { _Pragma("unroll") for (int n = 0; n < 2; ++n) _Pragma("unroll") for (int k = 0; k < 2; ++k) dst[n][k] = *(const PG8_LAS bf16x8*)(lds + PG8_SB(b, h) + boff + n * 2048 + k * 1024); } while (0)
#define PG8_MMA(ai, bj, At, Bt) do { __builtin_amdgcn_s_setprio(1); _Pragma("unroll") for (int m = 0; m < 4; ++m) _Pragma("unroll") for (int n = 0; n < 2; ++n) _Pragma("unroll") for (int k = 0; k < 2; ++k) \
        acc[ai][bj][m][n] = __builtin_amdgcn_mfma_f32_16x16x32_bf16(Bt[n][k], At[m][k], acc[ai][bj][m][n], 0, 0, 0); __builtin_amdgcn_s_setprio(0); } while (0)
#define PG8_WAIT_V(n) asm volatile("s_waitcnt vmcnt(" #n ")" ::: "memory")
#define PG8_WAIT_L(n) asm volatile("s_waitcnt lgkmcnt(" #n ")" ::: "memory")
#define PG8_BAR __builtin_amdgcn_s_barrier()
#define PG8_SCHED __builtin_amdgcn_sched_barrier(0)
    Unit cur, nxt; int ui = 0;
    if (!S.next(0, cur)) return;
    f32x4 acc[2][2][4][2];
#pragma unroll
    for (int a = 0; a < 2; ++a)
#pragma unroll
        for (int b = 0; b < 2; ++b)
#pragma unroll
            for (int m = 0; m < 4; ++m)
#pragma unroll
                for (int n = 0; n < 2; ++n) acc[a][b][m][n] = (f32x4){0.f, 0.f, 0.f, 0.f};
    bf16x8 At[4][2], B0[2][2], B1[2][2];
    const char* cA = (const char*)g.A + S.a_off(cur.pm, K); const char* cB = (const char*)g.Bt + (size_t)cur.pn * tstep;
    S.a_ready(cur);
    if constexpr (SP2) {
        PG8_STAGE(PG8_SB(0, 0), cB, voffB); PG8_STAGE(PG8_SB(0, 1), cB + hstep, voffB); PG8_STAGE(PG8_SA(0, 0), cA, voffA); PG8_STAGE(PG8_SA(0, 1), cA + hstep, voffA);
        if (wr == 1) PG8_BAR;
        PG8_WAIT_V(2); PG8_BAR;
        PG8_STAGE(PG8_SB(1, 0), cB + kstep, voffB); PG8_STAGE(PG8_SA(1, 0), cA + kstep, voffA); PG8_STAGE(PG8_SB(1, 1), cB + hstep + kstep, voffB);
        PG8_WAIT_V(6); PG8_BAR;
    } else {
        PG8_STAGE(PG8_SB(0, 0), cB, voffB); PG8_STAGE(PG8_SA(0, 0), cA, voffA); PG8_STAGE(PG8_SB(0, 1), cB + hstep, voffB); PG8_STAGE(PG8_SA(0, 1), cA + hstep, voffA);
        if (wr == 1) PG8_BAR;
        PG8_WAIT_V(4); PG8_BAR;
        PG8_STAGE(PG8_SB(1, 0), cB + kstep, voffB); PG8_STAGE(PG8_SA(1, 0), cA + kstep, voffA); PG8_STAGE(PG8_SB(1, 1), cB + hstep + kstep, voffB);
        PG8_WAIT_V(6); PG8_BAR;
    }
    for (;;) {
        const bool has_next = S.next(ui + 1, nxt);
        const char* nA = has_next ? (const char*)g.A + S.a_off(nxt.pm, K) : cA; const char* nB = has_next ? (const char*)g.Bt + (size_t)nxt.pn * tstep : cB;
        for (int t = 0; t < nt; t += 2) {
            const bool last = (t == nt - 2);
            const char* a1 = cA + (size_t)(t + 1) * kstep;
            const char* a2 = last ? nA : cA + (size_t)(t + 2) * kstep; const char* b2 = last ? nB : cB + (size_t)(t + 2) * kstep;
            const char* a3 = a2 + kstep; const char* b3 = b2 + kstep;
            if (last && has_next) S.a_ready(nxt);
            if constexpr (SP2) {
            PG8_LDB(B0, 0, 0); PG8_LDB(B1, 0, 1); PG8_SCHED; PG8_LDA(At, 0, 0); PG8_STAGE(PG8_SA(1, 1), a1 + hstep, voffA);
            PG8_WAIT_V(8); PG8_WAIT_L(0); PG8_BAR; PG8_MMA(0, 0, At, B0); PG8_MMA(0, 1, At, B1); PG8_BAR; PG8_SCHED;
            PG8_LDA(At, 0, 1); PG8_STAGE(PG8_SB(0, 0), b2, voffB); PG8_STAGE(PG8_SB(0, 1), b2 + hstep, voffB); PG8_STAGE(PG8_SA(0, 0), a2, voffA);
            PG8_WAIT_V(8); PG8_WAIT_L(0); PG8_BAR; PG8_MMA(1, 0, At, B0); PG8_MMA(1, 1, At, B1); PG8_BAR; PG8_SCHED;
            PG8_LDB(B0, 1, 0); PG8_LDB(B1, 1, 1); PG8_SCHED; PG8_LDA(At, 1, 0); PG8_STAGE(PG8_SA(0, 1), a2 + hstep, voffA);
            PG8_WAIT_V(8); PG8_WAIT_L(0); PG8_BAR; PG8_MMA(0, 0, At, B0); PG8_MMA(0, 1, At, B1); PG8_BAR; PG8_SCHED;
            PG8_LDA(At, 1, 1); PG8_STAGE(PG8_SB(1, 0), b3, voffB); PG8_STAGE(PG8_SB(1, 1), b3 + hstep, voffB); PG8_STAGE(PG8_SA(1, 0), a3, voffA);
            PG8_WAIT_V(8); PG8_WAIT_L(0); PG8_BAR; PG8_MMA(1, 0, At, B0); PG8_MMA(1, 1, At, B1); PG8_BAR; PG8_SCHED;
            } else {
            PG8_LDB(B0, 0, 0); PG8_SCHED; PG8_LDA(At, 0, 0); PG8_STAGE(PG8_SA(1, 1), a1 + hstep, voffA);
            PG8_WAIT_L(8); PG8_BAR; PG8_WAIT_L(0); PG8_MMA(0, 0, At, B0); PG8_BAR; PG8_SCHED;
            PG8_LDB(B1, 0, 1); PG8_STAGE(PG8_SB(0, 0), b2, voffB);
            PG8_BAR; PG8_WAIT_L(0); PG8_MMA(0, 1, At, B1); PG8_BAR;
            PG8_LDA(At, 0, 1); PG8_STAGE(PG8_SA(0, 0), a2, voffA);
            PG8_BAR; PG8_WAIT_L(0); PG8_MMA(1, 0, At, B0); PG8_BAR; PG8_SCHED;
            PG8_STAGE(PG8_SB(0, 1), b2 + hstep, voffB);
            PG8_WAIT_V(6); PG8_BAR; PG8_MMA(1, 1, At, B1); PG8_BAR;
            PG8_LDB(B0, 1, 0); PG8_SCHED; PG8_LDA(At, 1, 0); PG8_STAGE(PG8_SA(0, 1), a2 + hstep, voffA);
            PG8_WAIT_L(8); PG8_BAR; PG8_WAIT_L(0); PG8_MMA(0, 0, At, B0); PG8_BAR; PG8_SCHED;
            PG8_LDB(B1, 1, 1); PG8_STAGE(PG8_SB(1, 0), b3, voffB);
            PG8_BAR; PG8_WAIT_L(0); PG8_MMA(0, 1, At, B1); PG8_BAR;
            PG8_LDA(At, 1, 1); PG8_STAGE(PG8_SA(1, 0), a3, voffA);
            PG8_BAR; PG8_WAIT_L(0); PG8_MMA(1, 0, At, B0); PG8_BAR; PG8_SCHED;
            PG8_STAGE(PG8_SB(1, 1), b3 + hstep, voffB);
            PG8_WAIT_V(6); PG8_BAR; PG8_MMA(1, 1, At, B1); PG8_BAR;
            }
        }
        if constexpr (ALIGN_EPI) { if (wr == 0) PG8_BAR; }
        if constexpr (!Epi::AFTER_DRAIN) { E(acc, cur, wr, wc, fr, fq); S.done(cur); }
        if (!has_next) break;
#pragma unroll
        for (int a = 0; a < 2; ++a)
#pragma unroll
            for (int b = 0; b < 2; ++b)
#pragma unroll
                for (int m = 0; m < 4; ++m)
#pragma unroll
                    for (int n = 0; n < 2; ++n) acc[a][b][m][n] = (f32x4){0.f, 0.f, 0.f, 0.f};
        cur = nxt; cA = nA; cB = nB; ++ui;
        if constexpr (ALIGN_EPI) { if (wr == 1) PG8_BAR; }
    }
    PG8_WAIT_V(0);
    if constexpr (!ALIGN_EPI) { if (wr == 0) PG8_BAR; }
    PG8_BAR;
    if constexpr (Epi::AFTER_DRAIN) { E.fused(acc, cur, wr, wc, fr, fq, lds, wid, lane); S.done(cur); }
#undef PG8_SA
#undef PG8_SB
#undef PG8_STAGE
#undef PG8_LDA
#undef PG8_LDB
#undef PG8_MMA
#undef PG8_WAIT_V
#undef PG8_WAIT_L
#undef PG8_BAR
#undef PG8_SCHED
}
}

using pg8::bf16_t; using pg8::bf16x8; using pg8::f32x4; using pg8::u32x4; using pg8::Unit; using pg8::cvt_pk_bf16;
#define LAS __attribute__((address_space(3)))
typedef float f32x16 __attribute__((ext_vector_type(16)));
typedef unsigned u32x2 __attribute__((ext_vector_type(2)));
constexpr int DM = 1024, MTOK = 131072, NPROMPT = 65536, SEQP = 4096, SEQS = 8192, DFF = 2816;
constexpr float EPSV = 1e-6f;
constexpr float QSCALE = 0.125f * 1.4426950408889634f;
constexpr size_t MiB = 1024 * 1024;
constexpr size_t WS_WQKP = 0, WS_WV = 3 * MiB, WS_WOUT = 4 * MiB, WS_WUP = 6 * MiB, WS_WDN = 17 * MiB, WS_COS = 23 * MiB, WS_SIN = 24 * MiB, WS_RSS = 25 * MiB, WS_QKG = 25 * MiB + 768 * 1024,
                 WS_XB = 26 * MiB, WS_Q = WS_XB, WS_K = WS_XB + 128 * MiB, WS_ACT = 282 * MiB, WS_VT = WS_ACT, WS_ZP = WS_ACT + 128 * MiB, WS_H = WS_ACT + 256 * MiB,
                 WS_END = WS_ACT + 704 * MiB;
constexpr int LDS_STAGE = 131072, LDS_EDGE = 8192, LDS_TOTAL = 147456;

struct Params {
    const float* in[19];
    float* out;
    unsigned char* ws;
};
enum { I_XP = 0, I_XS, I_N1G, I_WIN, I_QG, I_KG, I_LQ1, I_LK1, I_LQ2, I_LK2, I_SUBG, I_WPOOL, I_PSCALE, I_WOUT, I_N2G, I_WUP, I_CONVW, I_CONVB, I_WDOWN };

__device__ __forceinline__ bf16_t f2bf(float x) { unsigned u = __float_as_uint(x); u += 0x7fffu + ((u >> 16) & 1u); return (bf16_t)(u >> 16); }
__device__ __forceinline__ float bf2f(unsigned short b) { return __uint_as_float(((unsigned)b) << 16); }
__device__ __forceinline__ float bflo(unsigned w) { return __uint_as_float(w << 16); }
__device__ __forceinline__ float bfhi(unsigned w) { return __uint_as_float(w & 0xffff0000u); }
__device__ __forceinline__ u32x4 pack8(f32x4 a, f32x4 b) { u32x4 w; w.x = cvt_pk_bf16(a[0], a[1]); w.y = cvt_pk_bf16(a[2], a[3]); w.z = cvt_pk_bf16(b[0], b[1]); w.w = cvt_pk_bf16(b[2], b[3]); return w; }
__device__ __forceinline__ u32x2 pack4(f32x4 a) { u32x2 w; w.x = cvt_pk_bf16(a[0], a[1]); w.y = cvt_pk_bf16(a[2], a[3]); return w; }

struct EpiQKP {
    static constexpr bool PERM = true, AFTER_DRAIN = false;
    unsigned char* ws; const float *qkg  , *cosT, *sinT;
    __device__ __forceinline__ void operator()(f32x4 (&acc)[2][2][4][2], const Unit& u, int wr, int wc, int fr, int fq) const {
        const int kind = u.pn >> 1;
        bf16_t* base = (bf16_t*)(ws + (kind == 0 ? WS_Q : (kind == 1 ? WS_K : WS_ZP)));
        const int colbase = (u.pn & 1) * 256 + wc * 64, i0 = 8 * fq;
        if (kind < 2) {
            const float* g = qkg + kind * 64;
            const float osc = kind == 0 ? QSCALE : 1.0f;
            const f32x4 g00 = *(const f32x4*)(g + i0), g01 = *(const f32x4*)(g + i0 + 4), g10 = *(const f32x4*)(g + 32 + i0), g11 = *(const f32x4*)(g + 32 + i0 + 4);
#pragma unroll
            for (int ai = 0; ai < 2; ++ai)
#pragma unroll
                for (int m = 0; m < 4; ++m) {
                    const int row = u.pm * 256 + ai * 128 + wr * 64 + m * 16 + fr;
                    const int pos = row < NPROMPT ? (row & (SEQP - 1)) : (row & (SEQS - 1));
                    const f32x4 a00 = acc[ai][0][m][0], a01 = acc[ai][0][m][1], a10 = acc[ai][1][m][0], a11 = acc[ai][1][m][1];
                    f32x4 sq = a00 * a00 + a01 * a01 + a10 * a10 + a11 * a11;
                    float ss = (sq[0] + sq[1]) + (sq[2] + sq[3]);
                    ss += __shfl_xor(ss, 16); ss += __shfl_xor(ss, 32);
                    const float rstd = rsqrtf(ss * (1.0f / 64.0f) + EPSV) * osc;
                    const f32x4 cs0 = *(const f32x4*)(cosT + pos * 32 + i0), sn0 = *(const f32x4*)(sinT + pos * 32 + i0);
                    const f32x4 cs1 = *(const f32x4*)(cosT + pos * 32 + i0 + 4), sn1 = *(const f32x4*)(sinT + pos * 32 + i0 + 4);
                    const f32x4 y00 = a00 * rstd * g00, y01 = a01 * rstd * g01, y10 = a10 * rstd * g10, y11 = a11 * rstd * g11;
                    bf16_t* rp = base + (size_t)row * 512 + colbase + i0;
                    *(u32x4*)(rp) = pack8(y00 * cs0 - y10 * sn0, y01 * cs1 - y11 * sn1);
                    *(u32x4*)(rp + 32) = pack8(y10 * cs0 + y00 * sn0, y11 * cs1 + y01 * sn1);
                    asm volatile("" ::: "memory");
                }
        } else {
#pragma unroll
            for (int ai = 0; ai < 2; ++ai)
#pragma unroll
                for (int m = 0; m < 4; ++m) {
                    const int row = u.pm * 256 + ai * 128 + wr * 64 + m * 16 + fr;
                    bf16_t* rp = base + (size_t)row * 512 + colbase + i0;
#pragma unroll
                    for (int bj = 0; bj < 2; ++bj) *(u32x4*)(rp + 32 * bj) = pack8(acc[ai][bj][m][0], acc[ai][bj][m][1]);
                }
        }
    }
};
struct EpiVT {
    static constexpr bool PERM = true, AFTER_DRAIN = false;
    bf16_t* vT;
    __device__ __forceinline__ void operator()(f32x4 (&acc)[2][2][4][2], const Unit& u, int wr, int wc, int fr, int fq) const {
#pragma unroll
        for (int ai = 0; ai < 2; ++ai)
#pragma unroll
            for (int m = 0; m < 4; ++m) {
                const int row = u.pm * 256 + ai * 128 + wr * 64 + m * 16 + fr;
                bf16_t* rp = vT + (size_t)row * MTOK + (size_t)u.pn * 256 + wc * 32 + 16 * (fq >> 1) + 4 * (fq & 1);
#pragma unroll
                for (int bj = 0; bj < 2; ++bj)
#pragma unroll
                    for (int n = 0; n < 2; ++n) *(u32x2*)(rp + 128 * bj + 8 * n) = pack4(acc[ai][bj][m][n]);
            }
    }
};
struct EpiRes1 {
    static constexpr bool PERM = true, AFTER_DRAIN = false;
    const float *xp, *xs; float* out; bf16_t* xb; float* rss;
    __device__ __forceinline__ void operator()(f32x4 (&acc)[2][2][4][2], const Unit& u, int wr, int wc, int fr, int fq) const {
        const int col0 = u.pn * 256 + wc * 32 + 8 * fq;
#pragma unroll
        for (int ai = 0; ai < 2; ++ai)
#pragma unroll
            for (int m = 0; m < 4; ++m) {
                const int row = u.pm * 256 + ai * 128 + wr * 64 + m * 16 + fr;
                const float* xr = (row < NPROMPT ? xp + (size_t)row * DM : xs + (size_t)(row - NPROMPT) * DM) + col0;
                float* orow = out + (size_t)row * DM + col0; bf16_t* brow = xb + (size_t)row * DM + col0;
                float ss = 0.f;
#pragma unroll
                for (int bj = 0; bj < 2; ++bj) {
                    const f32x4 a = acc[ai][bj][m][0] + *(const f32x4*)(xr + 128 * bj), b = acc[ai][bj][m][1] + *(const f32x4*)(xr + 128 * bj + 4);
                    *(f32x4*)(orow + 128 * bj) = a; *(f32x4*)(orow + 128 * bj + 4) = b;
                    *(u32x4*)(brow + 128 * bj) = pack8(a, b);
                    ss += (a[0] * a[0] + a[1] * a[1]) + (a[2] * a[2] + a[3] * a[3]) + (b[0] * b[0] + b[1] * b[1]) + (b[2] * b[2] + b[3] * b[3]);
                }
                ss += __shfl_xor(ss, 16); ss += __shfl_xor(ss, 32);
                if (fq == 0) atomicAdd(rss + row, ss);
                asm volatile("" ::: "memory");
            }
    }
};
struct EpiRes2 {
    static constexpr bool PERM = true, AFTER_DRAIN = false;
    float* out;
    __device__ __forceinline__ void operator()(f32x4 (&acc)[2][2][4][2], const Unit& u, int wr, int wc, int fr, int fq) const {
        const int col0 = u.pn * 256 + wc * 32 + 8 * fq;
#pragma unroll
        for (int ai = 0; ai < 2; ++ai)
#pragma unroll
            for (int m = 0; m < 4; ++m) {
                const int row = u.pm * 256 + ai * 128 + wr * 64 + m * 16 + fr;
                float* orow = out + (size_t)row * DM + col0;
#pragma unroll
                for (int bj = 0; bj < 2; ++bj) {
                    const f32x4 a = acc[ai][bj][m][0] + *(const f32x4*)(orow + 128 * bj), b = acc[ai][bj][m][1] + *(const f32x4*)(orow + 128 * bj + 4);
                    *(f32x4*)(orow + 128 * bj) = a; *(f32x4*)(orow + 128 * bj + 4) = b;
                }
                asm volatile("" ::: "memory");
            }
    }
};
__device__ __forceinline__ float dpp_ror1(float v) { return __builtin_bit_cast(float, __builtin_amdgcn_update_dpp(0, __builtin_bit_cast(int, v), 0x121, 0xf, 0xf, false)); }
__device__ __forceinline__ float dpp_ror15(float v) { return __builtin_bit_cast(float, __builtin_amdgcn_update_dpp(0, __builtin_bit_cast(int, v), 0x12F, 0xf, 0xf, false)); }
struct EpiConvGate {
    static constexpr bool PERM = true, AFTER_DRAIN = false;
    const float *rss, *convw, *convb; bf16_t* act; LAS float* edge;
    __device__ __forceinline__ void operator()(f32x4 (&acc)[2][2][4][2], const Unit& u, int wr, int wc, int fr, int fq) const {
        const int tok0 = 254 * u.pm - 1;
        const int pcol = wc * 32 + 8 * fq;
#pragma unroll
        for (int ai = 0; ai < 2; ++ai)
#pragma unroll
            for (int m = 0; m < 4; ++m) {
                const int tok = tok0 + ai * 128 + wr * 64 + m * 16 + fr;
                const bool valid = (tok >= 0) && (tok < MTOK);
                float rs = 0.f; if (valid) rs = rsqrtf(rss[tok] * (1.0f / 1024.0f) + EPSV);
#pragma unroll
                for (int bj = 0; bj < 2; ++bj)
#pragma unroll
                    for (int n = 0; n < 2; ++n) { f32x4 x = acc[ai][bj][m][n] * rs;
#pragma unroll
                        for (int j = 0; j < 4; ++j) x[j] = valid ? x[j] : 0.f;
                        acc[ai][bj][m][n] = x; }
            }
#pragma unroll
        for (int ai = 0; ai < 2; ++ai) {
            const int blk = 2 * ai + wr;
            if (fr == 0) {
#pragma unroll
                for (int bj = 0; bj < 2; ++bj)
#pragma unroll
                    for (int n = 0; n < 2; ++n) *(LAS f32x4*)(edge + (blk * 2 + 0) * 256 + 128 * bj + pcol + 4 * n) = acc[ai][bj][0][n];
            }
            if (fr == 15) {
#pragma unroll
                for (int bj = 0; bj < 2; ++bj)
#pragma unroll
                    for (int n = 0; n < 2; ++n) *(LAS f32x4*)(edge + (blk * 2 + 1) * 256 + 128 * bj + pcol + 4 * n) = acc[ai][bj][3][n];
            }
        }
        asm volatile("s_waitcnt lgkmcnt(0)\n\ts_barrier" ::: "memory");
        const int fcol = u.pn * 128 + pcol;
#pragma unroll
        for (int n = 0; n < 2; ++n) {
            f32x4 w0[2], w1[2], w2[2], bb[2];
#pragma unroll
            for (int bj = 0; bj < 2; ++bj) { const int c = bj * DFF + fcol + 4 * n;
                w0[bj] = *(const f32x4*)(convw + c); w1[bj] = *(const f32x4*)(convw + 2 * DFF + c); w2[bj] = *(const f32x4*)(convw + 4 * DFF + c); bb[bj] = *(const f32x4*)(convb + c); }
#pragma unroll
            for (int ai = 0; ai < 2; ++ai) {
                const int blk = 2 * ai + wr;
                f32x4 pe[2], ne[2];
#pragma unroll
                for (int bj = 0; bj < 2; ++bj) {
                    pe[bj] = blk > 0 ? *(const LAS f32x4*)(edge + ((blk - 1) * 2 + 1) * 256 + 128 * bj + pcol + 4 * n) : (f32x4){0.f, 0.f, 0.f, 0.f};
                    ne[bj] = blk < 3 ? *(const LAS f32x4*)(edge + ((blk + 1) * 2 + 0) * 256 + 128 * bj + pcol + 4 * n) : (f32x4){0.f, 0.f, 0.f, 0.f};
                }
#pragma unroll
                for (int m = 0; m < 4; ++m) {
                    const int r = ai * 128 + wr * 64 + m * 16 + fr, tok = tok0 + r;
                    const int S1 = (tok < NPROMPT ? SEQP : SEQS) - 1, pos = tok & S1;
                    const bool isfirst = pos == 0, islast = pos == S1;
                    f32x4 cv[2];
#pragma unroll
                    for (int bj = 0; bj < 2; ++bj) {
                        const f32x4 cur = acc[ai][bj][m][n];
                        const f32x4 ups = m > 0 ? acc[ai][bj][m > 0 ? m - 1 : 0][n] : pe[bj];
                        const f32x4 dns = m < 3 ? acc[ai][bj][m < 3 ? m + 1 : 3][n] : ne[bj];
                        f32x4 prev, next;
#pragma unroll
                        for (int j = 0; j < 4; ++j) {
                            const float t1 = fr == 15 ? ups[j] : cur[j]; float pv = dpp_ror1(t1);
                            const float t2 = fr == 0 ? dns[j] : cur[j]; float nx = dpp_ror15(t2);
                            prev[j] = isfirst ? 0.f : pv; next[j] = islast ? 0.f : nx;
                        }
                        cv[bj] = w0[bj] * prev + w1[bj] * cur + w2[bj] * next + bb[bj];
                    }
                    f32x4 a;
#pragma unroll
                    for (int j = 0; j < 4; ++j) { const float g = cv[0][j]; const float sg = __builtin_amdgcn_rcpf(1.0f + __builtin_amdgcn_exp2f(-1.4426950408889634f * g)); a[j] = g * sg * cv[1][j]; }
                    if (r >= 1 && r <= 254 && tok < MTOK) *(u32x2*)(act + (size_t)tok * DFF + fcol + 4 * n) = pack4(a);
                    asm volatile("" ::: "memory");
                }
            }
        }
    }
};

__device__ __forceinline__ void p0_prologue(const Params& p, LAS unsigned char* lds) {
    int tid_ = threadIdx.x; asm volatile("" : "+v"(tid_));
    const int tid = tid_, G = gridDim.x, gt = blockIdx.x * 512 + tid, GT = G * 512, lane = tid & 63, wid = tid >> 6;
    unsigned char* ws = p.ws;
    bf16_t* WQKP = (bf16_t*)(ws + WS_WQKP); bf16_t* WV = (bf16_t*)(ws + WS_WV); bf16_t* WOUT = (bf16_t*)(ws + WS_WOUT); bf16_t* WUP = (bf16_t*)(ws + WS_WUP); bf16_t* WDN = (bf16_t*)(ws + WS_WDN);
    LAS float* tile = (LAS float*)lds;
    for (int t = blockIdx.x; t < 2752; t += G) {
        const float* src; int ld, k0, n0, kind;
        if (t < 512) { kind = 0; k0 = (t >> 5) * 64; n0 = (t & 31) * 64; src = p.in[I_WIN]; ld = 2048; }
        else if (t < 640) { const int u = t - 512; kind = 1; k0 = (u >> 4) * 64; n0 = (u & 15) * 64; src = p.in[I_WOUT]; ld = 1024; }
        else if (t < 2048) { const int u = t - 640; kind = 2; k0 = (u / 88) * 64; n0 = (u % 88) * 64; src = p.in[I_WUP]; ld = 5632; }
        else { const int u = t - 2048; kind = 3; k0 = (u >> 4) * 64; n0 = (u & 15) * 64; src = p.in[I_WDOWN]; ld = 1024; }
#pragma unroll
        for (int i = 0; i < 8; ++i) { const int e = tid + i * 512, kk = e >> 6, nn = e & 63;
            float v = src[(size_t)(k0 + kk) * ld + n0 + nn];
            if (kind == 1) v *= p.in[I_SUBG][(k0 + kk) & 127] * 0.8f;
            if (kind == 2) v *= p.in[I_N2G][k0 + kk];
            tile[kk * 65 + nn] = v; }
        __syncthreads();
#pragma unroll
        for (int i = 0; i < 8; ++i) { const int e = tid + i * 512, nn = e >> 6, kk = e & 63, n = n0 + nn; bf16_t* dst;
            if (kind == 0) {
                if (n < 1024 || n >= 1536) { const int L = n < 1024 ? n : n - 512; const int prow = (L & ~255) + ((L >> 5) & 1) * 128 + ((L >> 6) & 3) * 32 + (L & 31); dst = WQKP + (size_t)prow * 1024 + k0 + kk; }
                else dst = WV + (size_t)(n - 1024) * 1024 + k0 + kk;
            } else if (kind == 1) dst = WOUT + (size_t)n * 1024 + k0 + kk;
            else if (kind == 2) { const int f = n < DFF ? n : n - DFF; const int prow = (f >> 7) * 256 + (n < DFF ? 0 : 128) + (f & 127); dst = WUP + (size_t)prow * 1024 + k0 + kk; }
            else dst = WDN + (size_t)n * DFF + k0 + kk;
            *dst = f2bf(tile[kk * 65 + nn]); }
        __syncthreads();
    }
    for (int o = gt; o < 512 * 1024; o += GT) {
        const int n = o & 1023, gc = o >> 10, g = gc >> 7;
        const float* wp = p.in[I_WPOOL] + (size_t)gc * 128; const float* ps = p.in[I_PSCALE] + g * 128; const float* wo = p.in[I_WOUT] + (size_t)(512 + g * 128) * 1024 + n;
        float a = 0.f;
        for (int e = 0; e < 128; ++e) a += wp[e] * ps[e] * wo[(size_t)e * 1024];
        WOUT[(size_t)n * 1024 + 512 + gc] = f2bf(a);
    }
    float* cosT = (float*)(ws + WS_COS); float* sinT = (float*)(ws + WS_SIN);
    for (int o = gt; o < 8192 * 32; o += GT) {
        const int s = o >> 5, i = o & 31;
        const float inv = exp2f(-(float)i * (13.287712379549449f / 32.0f));
        const float ang = (float)s * inv;
        const double rev = (double)ang * 0.15915494309189535; const float fr = (float)(rev - __builtin_rint(rev));
        cosT[o] = __builtin_amdgcn_cosf(fr); sinT[o] = __builtin_amdgcn_sinf(fr);
    }
    float* rss = (float*)(ws + WS_RSS);
    for (int o = gt; o < MTOK; o += GT) rss[o] = 0.f;
    if (gt < 128) ((float*)(ws + WS_QKG))[gt] = gt < 64 ? p.in[I_QG][gt] : p.in[I_KG][gt - 64];
    bf16_t* H = (bf16_t*)(ws + WS_H);
    f32x4 g1[4];
#pragma unroll
    for (int i = 0; i < 4; ++i) g1[i] = *(const f32x4*)(p.in[I_N1G] + lane * 4 + 256 * i);
    for (int row = blockIdx.x * 8 + wid; row < MTOK; row += G * 8) {
        const float* xr = (row < NPROMPT ? p.in[I_XP] + (size_t)row * DM : p.in[I_XS] + (size_t)(row - NPROMPT) * DM) + lane * 4;
        f32x4 v[4]; float ss = 0.f;
#pragma unroll
        for (int i = 0; i < 4; ++i) { v[i] = *(const f32x4*)(xr + 256 * i); ss += (v[i][0] * v[i][0] + v[i][1] * v[i][1]) + (v[i][2] * v[i][2] + v[i][3] * v[i][3]); }
#pragma unroll
        for (int o = 1; o < 64; o <<= 1) ss += __shfl_xor(ss, o);
        const float rstd = rsqrtf(ss * (1.0f / 1024.0f) + EPSV);
        bf16_t* hr = H + (size_t)row * DM + lane * 4;
#pragma unroll
        for (int i = 0; i < 4; ++i) *(u32x2*)(hr + 256 * i) = pack4(v[i] * rstd * g1[i]);
    }
}

__device__ __forceinline__ void pool_phase(const bf16_t* zp, bf16_t* mixed) {
    const int GT = gridDim.x * 512; int tid_ = threadIdx.x; asm volatile("" : "+v"(tid_));
    for (int item = blockIdx.x * 512 + tid_; item < MTOK * 64; item += GT) {
        const int tok = item >> 6, ch = item & 63, c0 = ch * 8, g = ch >> 4, half = 1 << g;
        const int S = tok < NPROMPT ? SEQP : SEQS, pos = tok & (S - 1), base = tok - pos;
        const int lo = max(pos - half, 0), hi = min(pos + half - 1, S - 1);
        float s[8];
#pragma unroll
        for (int j = 0; j < 8; ++j) s[j] = 0.f;
        for (int r = lo; r <= hi; ++r) {
            const u32x4 w = *(const u32x4*)(zp + (size_t)(base + r) * 512 + c0);
            s[0] += bflo(w.x); s[1] += bfhi(w.x); s[2] += bflo(w.y); s[3] += bfhi(w.y); s[4] += bflo(w.z); s[5] += bfhi(w.z); s[6] += bflo(w.w); s[7] += bfhi(w.w);
        }
        const u32x4 w = *(const u32x4*)(zp + (size_t)tok * 512 + c0);
        const float ic = 1.0f / (float)(hi - lo + 1);
        u32x4 o;
        o.x = cvt_pk_bf16(s[0] * ic - bflo(w.x), s[1] * ic - bfhi(w.x)); o.y = cvt_pk_bf16(s[2] * ic - bflo(w.y), s[3] * ic - bfhi(w.y));
        o.z = cvt_pk_bf16(s[4] * ic - bflo(w.z), s[5] * ic - bfhi(w.z)); o.w = cvt_pk_bf16(s[6] * ic - bflo(w.w), s[7] * ic - bfhi(w.w));
        *(u32x4*)(mixed + (size_t)tok * DM + 512 + c0) = o;
    }
}

#define MFMA32(a, b, c) __builtin_amdgcn_mfma_f32_32x32x16_bf16((a), (b), (c), 0, 0, 0)
constexpr int KROW = 256, VROW = 128, KBUF = 64 * KROW, VBUF = 128 * VROW, ABUF = KBUF + VBUF, QROW = 272;
__device__ __forceinline__ bf16x8 packp(const f32x16& x, int s) {
    u32x4 w;
    w.x = cvt_pk_bf16(x[8 * s + 0], x[8 * s + 1]); w.y = cvt_pk_bf16(x[8 * s + 2], x[8 * s + 3]); w.z = cvt_pk_bf16(x[8 * s + 4], x[8 * s + 5]); w.w = cvt_pk_bf16(x[8 * s + 6], x[8 * s + 7]);
    return __builtin_bit_cast(bf16x8, w);
}
__device__ __forceinline__ void attn_phase(LAS unsigned char* lds, const bf16_t* q, const bf16_t* k, const bf16_t* vT, bf16_t* mixed, float lam) {
    int tid_ = threadIdx.x; asm volatile("" : "+v"(tid_));
    const int tid = tid_, lane = tid & 63, r32 = lane & 31, hi = lane >> 5, wid = __builtin_amdgcn_readfirstlane(tid >> 6), G = gridDim.x;
    unsigned koff[2], voff[2];
#pragma unroll
    for (int i = 0; i < 2; ++i) {
        const int kr = 4 * (2 * wid + i) + (lane >> 4), kc = (lane & 15) ^ (kr & 15); koff[i] = (unsigned)(kr * 512 + kc * 8) * 2u;
        const int vd = 8 * (2 * wid + i) + (lane >> 3), vc = (lane & 7) ^ ((vd >> 1) & 7); voff[i] = (unsigned)(vd * MTOK + vc * 8) * 2u;
    }
    const int kx = r32 & 15, vx = (r32 >> 1) & 7;
    const unsigned lds0 = (unsigned)(size_t)lds;
#define ATT_DMA1(sbase, voff_, ldsdst) do { unsigned keep_; asm volatile("s_mov_b32 %0, m0\n\ts_mov_b32 m0, %3\n\ts_nop 0\n\tglobal_load_lds_dwordx4 %1, %2\n\ts_mov_b32 m0, %0" : "=&s"(keep_) : "v"(voff_), "s"(sbase), "s"(ldsdst) : "memory"); } while (0)
#define ATT_DMA(buf, kp, vp) do { _Pragma("unroll") for (int _i = 0; _i < 2; ++_i) { \
        ATT_DMA1((kp), koff[_i], lds0 + (unsigned)((buf) + (2 * wid + _i) * 1024)); \
        ATT_DMA1((vp), voff[_i], lds0 + (unsigned)((buf) + KBUF + (2 * wid + _i) * 1024)); } } while (0)
    for (int U = blockIdx.x; U < 2048; U += G) {
        const int rnd = U >> 8, cc = U & 255, x = cc & 7, jj = cc >> 3;
        int S, tok0, h, qb;
        if (rnd < 4) { const int pair = 4 * x + rnd; S = SEQS; tok0 = NPROMPT + (pair >> 2) * SEQS; h = pair & 3; qb = jj; }
        else { const int pair = 8 * x + 2 * (rnd - 4) + (jj >> 4); S = SEQP; tok0 = (pair >> 2) * SEQP; h = pair & 3; qb = jj & 15; }
        const bf16_t* Kg = k + (size_t)tok0 * 512 + h * 128;
        const bf16_t* Vg = vT + (size_t)(h * 128) * MTOK + tok0;
        const int NT = S / 64;
        const size_t qrow = (size_t)tok0 + qb * 256 + wid * 32 + r32;
        ATT_DMA(0, Kg, Vg);
        LAS unsigned char* Qs = lds + 2 * ABUF + wid * (32 * QROW) + r32 * QROW + hi * 16;
#pragma unroll
        for (int m = 0; m < 2; ++m)
#pragma unroll
            for (int d0 = 0; d0 < 4; ++d0) *(LAS bf16x8*)(Qs + m * 128 + d0 * 32) = *(const bf16x8*)(q + qrow * 512 + h * 128 + m * 64 + d0 * 16 + hi * 8);
        f32x16 o[2][4];
#pragma unroll
        for (int m = 0; m < 2; ++m)
#pragma unroll
            for (int db = 0; db < 4; ++db)
#pragma unroll
                for (int i = 0; i < 16; ++i) o[m][db][i] = 0.f;
        float mu[2] = {-1e30f, -1e30f}, l[2] = {0.f, 0.f};
        asm volatile("s_waitcnt vmcnt(0)" ::: "memory");
        __syncthreads();
        for (int t = 0; t < NT; ++t) {
            const int cb = (t & 1) * ABUF, nb = ((t + 1) & 1) * ABUF;
            if (t + 1 < NT) ATT_DMA(nb, Kg + (size_t)(t + 1) * 64 * 512, Vg + (t + 1) * 64);
            const LAS unsigned char* Kb = lds + cb + r32 * KROW;
            const LAS unsigned char* Vb = lds + cb + KBUF + r32 * VROW;
#pragma unroll
            for (int m = 0; m < 2; ++m) {
                f32x16 s0, s1;
#pragma unroll
                for (int i = 0; i < 16; ++i) { s0[i] = 0.f; s1[i] = 0.f; }
#pragma unroll
                for (int d0 = 0; d0 < 4; ++d0) {
                    const int kpos = ((m * 8 + d0 * 2 + hi) ^ kx) * 16;
                    const bf16x8 k0 = *(const LAS bf16x8*)(Kb + kpos), k1 = *(const LAS bf16x8*)(Kb + 32 * KROW + kpos);
                    const bf16x8 qv = *(const LAS bf16x8*)(Qs + m * 128 + d0 * 32);
                    s0 = MFMA32(k0, qv, s0); s1 = MFMA32(k1, qv, s1);
                    if (d0 == 1) __builtin_amdgcn_sched_barrier(0);
                }
                __builtin_amdgcn_sched_barrier(0);
                float mx = fmaxf(s0[0], s1[0]);
#pragma unroll
                for (int i = 1; i < 16; ++i) mx = fmaxf(mx, fmaxf(s0[i], s1[i]));
                mx = fmaxf(mx, __shfl_xor(mx, 32));
                const bool need = mx > mu[m] + 8.0f;
                if (__builtin_amdgcn_ballot_w64(need) != 0ull) {
                    const float nm = need ? mx : mu[m];
                    const float alpha = __builtin_amdgcn_exp2f(mu[m] - nm);
                    mu[m] = nm; l[m] *= alpha;
#pragma unroll
                    for (int db = 0; db < 4; ++db)
#pragma unroll
                        for (int i = 0; i < 16; ++i) o[m][db][i] *= alpha;
                }
                const float mm = mu[m];
                float ls = 0.f;
#pragma unroll
                for (int i = 0; i < 16; ++i) { s0[i] = __builtin_amdgcn_exp2f(s0[i] - mm); s1[i] = __builtin_amdgcn_exp2f(s1[i] - mm); ls += s0[i] + s1[i]; }
                l[m] += ls;
                const bf16x8 p0 = packp(s0, 0), p1 = packp(s0, 1), p2 = packp(s1, 0), p3 = packp(s1, 1);
                __builtin_amdgcn_sched_barrier(0);
#pragma unroll
                for (int db = 0; db < 4; ++db) {
                    const LAS unsigned char* vb = Vb + db * 32 * VROW;
                    const bf16x8 v0 = *(const LAS bf16x8*)(vb + ((0 + hi) ^ vx) * 16), v1 = *(const LAS bf16x8*)(vb + ((2 + hi) ^ vx) * 16), v2 = *(const LAS bf16x8*)(vb + ((4 + hi) ^ vx) * 16), v3 = *(const LAS bf16x8*)(vb + ((6 + hi) ^ vx) * 16);
                    o[m][db] = MFMA32(v0, p0, o[m][db]); o[m][db] = MFMA32(v1, p1, o[m][db]); o[m][db] = MFMA32(v2, p2, o[m][db]); o[m][db] = MFMA32(v3, p3, o[m][db]);
                    __builtin_amdgcn_sched_barrier(0);
                }
            }
            asm volatile("s_waitcnt vmcnt(0)" ::: "memory");
            __syncthreads();
        }
        const float l0 = l[0] + __shfl_xor(l[0], 32), l1 = l[1] + __shfl_xor(l[1], 32);
        const float c0 = 1.0f / l0, c1 = lam / l1;
        float ss = 0.f;
#pragma unroll
        for (int db = 0; db < 4; ++db)
#pragma unroll
            for (int i = 0; i < 16; ++i) { const float v = o[0][db][i] * c0 - o[1][db][i] * c1; o[0][db][i] = v; ss += v * v; }
        ss += __shfl_xor(ss, 32);
        const float rstd = rsqrtf(ss * (1.0f / 128.0f) + EPSV);
        bf16_t* orow = mixed + qrow * DM + h * 128 + 4 * hi;
#pragma unroll
        for (int db = 0; db < 4; ++db)
#pragma unroll
            for (int i4 = 0; i4 < 4; ++i4) {
                u32x2 w; w.x = cvt_pk_bf16(o[0][db][4 * i4] * rstd, o[0][db][4 * i4 + 1] * rstd); w.y = cvt_pk_bf16(o[0][db][4 * i4 + 2] * rstd, o[0][db][4 * i4 + 3] * rstd);
                *(u32x2*)(orow + 32 * db + 8 * i4) = w;
            }
    }
}

__global__ void __launch_bounds__(512) fwd_megakernel(Params p) {
    extern __shared__ __attribute__((aligned(16))) unsigned char lds_raw[];
    LAS unsigned char* lds = (LAS unsigned char*)lds_raw;
    cg::grid_group grid = cg::this_grid();
    unsigned char* ws = p.ws;
    const int G = gridDim.x, c = blockIdx.x;
    bf16_t* WQKP = (bf16_t*)(ws + WS_WQKP); bf16_t* WV = (bf16_t*)(ws + WS_WV); bf16_t* WOUT = (bf16_t*)(ws + WS_WOUT); bf16_t* WUP = (bf16_t*)(ws + WS_WUP); bf16_t* WDN = (bf16_t*)(ws + WS_WDN);
    float* cosT = (float*)(ws + WS_COS); float* sinT = (float*)(ws + WS_SIN); float* rss = (float*)(ws + WS_RSS);
    bf16_t* Q = (bf16_t*)(ws + WS_Q); bf16_t* Kt = (bf16_t*)(ws + WS_K); bf16_t* VT = (bf16_t*)(ws + WS_VT); bf16_t* ZP = (bf16_t*)(ws + WS_ZP);
    bf16_t* H = (bf16_t*)(ws + WS_H); bf16_t* MIX = H; bf16_t* XB = (bf16_t*)(ws + WS_XB); bf16_t* ACT = (bf16_t*)(ws + WS_ACT);

#ifndef SKIP_P0
    p0_prologue(p, lds);
#endif
    grid.sync();
#ifndef SKIP_P1
    {
        pg8::Gemm g{H, WQKP, MTOK, 1536, DM}; pg8::StaticOrder S; S.init(MTOK, 1536, G, c);
        EpiQKP E{ws, (const float*)(ws + WS_QKG), cosT, sinT};
        pg8::gemm_phase<EpiQKP, pg8::StaticOrder, true, true>(lds, g, S, E);
    }
    {
        pg8::Gemm g{WV, H, 512, MTOK, DM}; pg8::StaticOrder S; S.init(512, MTOK, G, c);
        EpiVT E{VT};
        pg8::gemm_phase<EpiVT, pg8::StaticOrder, true, true>(lds, g, S, E);
    }
#endif
    grid.sync();
#ifndef SKIP_P2
    pool_phase(ZP, MIX);
    {
        float d1 = 0.f, d2 = 0.f;
        for (int i = 0; i < 64; ++i) { d1 += p.in[I_LQ1][i] * p.in[I_LK1][i]; d2 += p.in[I_LQ2][i] * p.in[I_LK2][i]; }
        const float lam = __expf(d1) - __expf(d2) + 0.2f;
        attn_phase(lds, Q, Kt, VT, MIX, lam);
    }
#endif
    grid.sync();
#ifndef SKIP_P3
    {
        pg8::Gemm g{MIX, WOUT, MTOK, DM, DM}; pg8::StaticOrder S; S.init(MTOK, DM, G, c);
        EpiRes1 E{p.in[I_XP], p.in[I_XS], p.out, XB, rss};
        pg8::gemm_phase<EpiRes1, pg8::StaticOrder, true, true>(lds, g, S, E);
    }
#endif
    grid.sync();
#ifndef SKIP_P4
    {
        pg8::Gemm g{XB, WUP, MTOK, 2 * DFF, DM}; pg8::StaticOrder S; S.init_tiles(517, 22, G, c, 1);
        EpiConvGate E{rss, p.in[I_CONVW], p.in[I_CONVB], ACT, (LAS float*)(lds + LDS_STAGE)};
        pg8::gemm_phase<EpiConvGate, pg8::StaticOrder, true, true>(lds, g, S, E);
    }
#endif
    grid.sync();
#ifndef SKIP_P5
    {
        pg8::Gemm g{ACT, WDN, MTOK, DM, DFF}; pg8::StaticOrder S; S.init(MTOK, DM, G, c);
        EpiRes2 E{p.out};
        pg8::gemm_phase<EpiRes2, pg8::StaticOrder, true, true>(lds, g, S, E);
    }
#endif
}

extern "C" void kernel_launch(void* const* d_in, const int* in_sizes, int n_in, void* d_out, int out_size, void* d_ws, size_t ws_size, hipStream_t stream) {
    static int grid_blocks = 0;
    if (grid_blocks == 0) {
        if (n_in != 19 || ws_size < WS_END) { fprintf(stderr, "kernel_launch: unexpected n_in %d / ws_size %zu (need %zu)\n", n_in, ws_size, (size_t)WS_END); grid_blocks = -1; return; }
        int dev = 0, cus = 0, per_cu = 0;
        (void)hipGetDevice(&dev);
        (void)hipDeviceGetAttribute(&cus, hipDeviceAttributeMultiprocessorCount, dev);
        if (hipFuncSetAttribute((const void*)fwd_megakernel, hipFuncAttributeMaxDynamicSharedMemorySize, LDS_TOTAL) != hipSuccess) { fprintf(stderr, "kernel_launch: hipFuncSetAttribute failed\n"); grid_blocks = -1; return; }
        if (hipOccupancyMaxActiveBlocksPerMultiprocessor(&per_cu, (const void*)fwd_megakernel, 512, LDS_TOTAL) != hipSuccess || per_cu < 1) { fprintf(stderr, "kernel_launch: occupancy query failed (%d)\n", per_cu); (void)hipGetLastError(); per_cu = 1; }
        grid_blocks = cus * per_cu;
    }
    if (grid_blocks < 0) return;
    Params p{};
    for (int i = 0; i < 19; ++i) p.in[i] = (const float*)d_in[i];
    p.out = (float*)d_out; p.ws = (unsigned char*)d_ws;
    void* args[] = {&p};
    hipError_t e = hipLaunchCooperativeKernel((const void*)fwd_megakernel, dim3(grid_blocks), dim3(512), args, LDS_TOTAL, stream);
    if (e != hipSuccess) fprintf(stderr, "cooperative launch failed: %s (grid %d)\n", hipGetErrorString(e), grid_blocks);
}
```

```cpp
#include <hip/hip_runtime.h>
#include <hip/hip_cooperative_groups.h>
#include <cstdio>
#include <cstdint>
namespace cg = cooperative_groups;

namespace pg8 {
#define PG8_LAS __attribute__((address_space(3)))
typedef unsigned short bf16_t;
typedef short bf16x8 __attribute__((ext_vector_type(8)));
typedef float f32x4 __attribute__((ext_vector_type(4)));
typedef unsigned u32x4 __attribute__((ext_vector_type(4)));
constexpr int BM = 256, BK = 64, HALF = 128, HTB = HALF * BK * 2  , STAGE_BYTES = 8 * HTB, NXCD = 8, WGM = 8;

__host__ __device__ __forceinline__ int lds_byte(int r, int c) { const int st = (r >> 4) * 2 + (c >> 5), rr = r & 15, cc = c & 31, ob = rr * 64 + cc * 2; return st * 1024 + (ob ^ (((ob >> 9) & 1) << 5)); }
__host__ __device__ __forceinline__ void stage_rc(int b, int& R, int& C) { const int st = b / 1024, sb = b % 1024, swz = sb ^ (((sb >> 9) & 1) << 5); R = (st >> 1) * 16 + swz / 64; C = (st & 1) * 32 + (swz % 64) / 2; }
__host__ __device__ __forceinline__ int perm32(int rho) { const int n = rho >> 4, i = rho & 15; return 8 * (i >> 2) + 4 * n + (i & 3); }

struct Unit { int pm, pn; };
struct Gemm { const bf16_t* A; const bf16_t* Bt; int M, N, K; };

struct StaticOrder {
    int nM, nN, nwg, G, c; int halo;
    __host__ __device__ void init_tiles(int nM_, int nN_, int G_, int c_, int halo_) { nM = nM_; nN = nN_; nwg = nM * nN; G = G_; c = c_; halo = halo_; }
    __device__ __forceinline__ long a_off(int pm, int K) const { return halo ? ((long)254 * pm - 1) * (long)K * 2 : (long)pm * 256 * (long)K * 2; }
    __host__ __device__ void init(int M, int N, int G_, int c_) { nM = M / BM; nN = N / BM; nwg = nM * nN; G = G_; c = c_; halo = 0; }
    __host__ __device__ bool next(int i, Unit& u) const {
        const long L = (long)i * G + c; if (L >= nwg) return false;
        int wgid = (int)L; { const int q = nwg / NXCD, r = nwg % NXCD, xcd = wgid % NXCD, off = wgid / NXCD; wgid = (xcd < r ? xcd * (q + 1) : r * (q + 1) + (xcd - r) * q) + off; }
        const int nig = WGM * nN, gid = wgid / nig, fm = gid * WGM, gsz = (nM - fm) < WGM ? (nM - fm) : WGM;
        u.pm = fm + ((wgid % nig) % gsz); u.pn = (wgid % nig) / gsz; return true;
    }
    __device__ __forceinline__ void a_ready(const Unit&) const {}
    __device__ __forceinline__ void done(const Unit&) const {}
};
__device__ __forceinline__ unsigned cvt_pk_bf16(float lo, float hi) { unsigned r; asm volatile("v_cvt_pk_bf16_f32 %0, %1, %2" : "=v"(r) : "v"(lo), "v"(hi)); return r; }
typedef float f32x2 __attribute__((ext_vector_type(2)));
typedef float f32x2 __attribute__((ext_vector_type(2)));
template <class Epi, class Sched, bool ALIGN_EPI = false, bool SP2 = false>
__device__ __forceinline__ void gemm_phase(PG8_LAS unsigned char* lds, const Gemm g, const Sched& S, const Epi& E, const int wave_s) {
    int tid_; asm volatile("v_mbcnt_lo_u32_b32 %0, -1, 0\n\tv_mbcnt_hi_u32_b32 %0, -1, %0" : "=v"(tid_)); tid_ += wave_s * 64;
    const int tid = tid_, wid = __builtin_amdgcn_readfirstlane(tid >> 6), lane = tid & 63, wr = wid >> 2, wc = wid & 3, fr = lane & 15, fq = lane >> 4;
    const int K = g.K, nt = K / BK;
    unsigned voffA[2], voffB[2];
#pragma unroll
    for (int i = 0; i < 2; ++i) { int R, C; stage_rc(tid * 16 + i * 8192, R, C); const int Rb = Epi::PERM ? ((R & ~31) + perm32(R & 31)) : R;
        voffA[i] = (unsigned)(R * K + C) * 2u; voffB[i] = (unsigned)(Rb * K + C) * 2u; }
    const size_t kstep = (size_t)(BK * 2);
    const size_t hstep = (size_t)HALF * K * 2;
    const size_t tstep = 2 * hstep;
    const unsigned ldsw = (unsigned)wid * 1024u;
    const int aoff = lds_byte(wr * 64 + fr, fq * 8), boff = lds_byte(wc * 32 + fr, fq * 8);
#define PG8_SA(b, h) (((b) * 2 + (h)) * HTB)
#define PG8_SB(b, h) ((4 + (b) * 2 + (h)) * HTB)
#define PG8_STAGE(bufoff, gbase, voff) do { _Pragma("unroll") for (int _i = 0; _i < 2; ++_i) \
        __builtin_amdgcn_global_load_lds((const unsigned*)((const char*)(gbase) + (voff)[_i]), (PG8_LAS unsigned*)(lds + (bufoff) + ldsw + _i * 8192), 16, 0, 0); } while (0)
#define PG8_LDA(dst, b, h) do { _Pragma("unroll") for (int m = 0; m < 4; ++m) _Pragma("unroll") for (int k = 0; k < 2; ++k) dst[m][k] = *(const PG8_LAS bf16x8*)(lds + PG8_SA(b, h) + aoff + m * 2048 + k * 1024); } while (0)
#define PG8_LDB(dst, b, h) do { _Pragma("unroll") for (int n = 0; n < 2; ++n) _Pragma("unroll") for (int k = 0; k < 2; ++k) dst[n][k] = *(const PG8_LAS bf16x8*)(lds + PG8_SB(b, h) + boff + n * 2048 + k * 1024); } while (0)
#define PG8_MMA(ai, bj, At, Bt) do { __builtin_amdgcn_s_setprio(1); _Pragma("unroll") for (int m = 0; m < 4; ++m) _Pragma("unroll") for (int n = 0; n < 2; ++n) _Pragma("unroll") for (int k = 0; k < 2; ++k) \
        acc[ai][bj][m][n] = __builtin_amdgcn_mfma_f32_16x16x32_bf16(Bt[n][k], At[m][k], acc[ai][bj][m][n], 0, 0, 0); __builtin_amdgcn_s_setprio(0); } while (0)
#define PG8_WAIT_V(n) asm volatile("s_waitcnt vmcnt(" #n ")" ::: "memory")
#define PG8_WAIT_L(n) asm volatile("s_waitcnt lgkmcnt(" #n ")" ::: "memory")
#define PG8_BAR __builtin_amdgcn_s_barrier()
#define PG8_SCHED __builtin_amdgcn_sched_barrier(0)
    Unit cur, nxt; int ui = 0;
    if (!S.next(0, cur)) return;
    f32x4 acc[2][2][4][2];
#pragma unroll
    for (int a = 0; a < 2; ++a)
#pragma unroll
        for (int b = 0; b < 2; ++b)
#pragma unroll
            for (int m = 0; m < 4; ++m)
#pragma unroll
                for (int n = 0; n < 2; ++n) acc[a][b][m][n] = (f32x4){0.f, 0.f, 0.f, 0.f};
    bf16x8 At[4][2], B0[2][2], B1[2][2];
    const char* cA = (const char*)g.A + S.a_off(cur.pm, K); const char* cB = (const char*)g.Bt + (size_t)cur.pn * tstep;
    S.a_ready(cur);
    if constexpr (SP2) {
        PG8_STAGE(PG8_SB(0, 0), cB, voffB); PG8_STAGE(PG8_SB(0, 1), cB + hstep, voffB); PG8_STAGE(PG8_SA(0, 0), cA, voffA); PG8_STAGE(PG8_SA(0, 1), cA + hstep, voffA);
        if (wr == 1) PG8_BAR;
        PG8_WAIT_V(2); PG8_BAR;
        PG8_STAGE(PG8_SB(1, 0), cB + kstep, voffB); PG8_STAGE(PG8_SA(1, 0), cA + kstep, voffA); PG8_STAGE(PG8_SB(1, 1), cB + hstep + kstep, voffB);
        PG8_WAIT_V(6); PG8_BAR;
    } else {
        PG8_STAGE(PG8_SB(0, 0), cB, voffB); PG8_STAGE(PG8_SA(0, 0), cA, voffA); PG8_STAGE(PG8_SB(0, 1), cB + hstep, voffB); PG8_STAGE(PG8_SA(0, 1), cA + hstep, voffA);
        if (wr == 1) PG8_BAR;
        PG8_WAIT_V(4); PG8_BAR;
        PG8_STAGE(PG8_SB(1, 0), cB + kstep, voffB); PG8_STAGE(PG8_SA(1, 0), cA + kstep, voffA); PG8_STAGE(PG8_SB(1, 1), cB + hstep + kstep, voffB);
        PG8_WAIT_V(6); PG8_BAR;
    }
    for (;;) {
        const bool has_next = S.next(ui + 1, nxt);
        const char* nA = has_next ? (const char*)g.A + S.a_off(nxt.pm, K) : cA; const char* nB = has_next ? (const char*)g.Bt + (size_t)nxt.pn * tstep : cB;
        for (int t = 0; t < nt; t += 2) {
            const bool last = (t == nt - 2);
            const char* a1 = cA + (size_t)(t + 1) * kstep;
            const char* a2 = last ? nA : cA + (size_t)(t + 2) * kstep; const char* b2 = last ? nB : cB + (size_t)(t + 2) * kstep;
            const char* a3 = a2 + kstep; const char* b3 = b2 + kstep;
            if (last && has_next) S.a_ready(nxt);
            if constexpr (SP2) {
            PG8_LDB(B0, 0, 0); PG8_LDB(B1, 0, 1); PG8_SCHED; PG8_LDA(At, 0, 0); PG8_STAGE(PG8_SA(1, 1), a1 + hstep, voffA);
            PG8_WAIT_V(8); PG8_WAIT_L(0); PG8_BAR; PG8_MMA(0, 0, At, B0); PG8_MMA(0, 1, At, B1); PG8_BAR; PG8_SCHED;
            PG8_LDA(At, 0, 1); PG8_STAGE(PG8_SB(0, 0), b2, voffB); PG8_STAGE(PG8_SB(0, 1), b2 + hstep, voffB); PG8_STAGE(PG8_SA(0, 0), a2, voffA);
            PG8_WAIT_V(8); PG8_WAIT_L(0); PG8_BAR; PG8_MMA(1, 0, At, B0); PG8_MMA(1, 1, At, B1); PG8_BAR; PG8_SCHED;
            PG8_LDB(B0, 1, 0); PG8_LDB(B1, 1, 1); PG8_SCHED; PG8_LDA(At, 1, 0); PG8_STAGE(PG8_SA(0, 1), a2 + hstep, voffA);
            PG8_WAIT_V(8); PG8_WAIT_L(0); PG8_BAR; PG8_MMA(0, 0, At, B0); PG8_MMA(0, 1, At, B1); PG8_BAR; PG8_SCHED;
            PG8_LDA(At, 1, 1); PG8_STAGE(PG8_SB(1, 0), b3, voffB); PG8_STAGE(PG8_SB(1, 1), b3 + hstep, voffB); PG8_STAGE(PG8_SA(1, 0), a3, voffA);
            PG8_WAIT_V(8); PG8_WAIT_L(0); PG8_BAR; PG8_MMA(1, 0, At, B0); PG8_MMA(1, 1, At, B1); PG8_BAR; PG8_SCHED;
            } else {
            PG8_LDB(B0, 0, 0); PG8_SCHED; PG8_LDA(At, 0, 0); PG8_STAGE(PG8_SA(1, 1), a1 + hstep, voffA);
            PG8_WAIT_L(8); PG8_BAR; PG8_WAIT_L(0); PG8_MMA(0, 0, At, B0); PG8_BAR; PG8_SCHED;
            PG8_LDB(B1, 0, 1); PG8_STAGE(PG8_SB(0, 0), b2, voffB);
            PG8_BAR; PG8_WAIT_L(0); PG8_MMA(0, 1, At, B1); PG8_BAR;
            PG8_LDA(At, 0, 1); PG8_STAGE(PG8_SA(0, 0), a2, voffA);
            PG8_BAR; PG8_WAIT_L(0); PG8_MMA(1, 0, At, B0); PG8_BAR; PG8_SCHED;
            PG8_STAGE(PG8_SB(0, 1), b2 + hstep, voffB);
            PG8_WAIT_V(6); PG8_BAR; PG8_MMA(1, 1, At, B1); PG8_BAR;
            PG8_LDB(B0, 1, 0); PG8_SCHED; PG8_LDA(At, 1, 0); PG8_STAGE(PG8_SA(0, 1), a2 + hstep, voffA);
            PG8_WAIT_L(8); PG8_BAR; PG8_WAIT_L(0); PG8_MMA(0, 0, At, B0); PG8_BAR; PG8_SCHED;
            PG8_LDB(B1, 1, 1); PG8_STAGE(PG8_SB(1, 0), b3, voffB);
            PG8_BAR; PG8_WAIT_L(0); PG8_MMA(0, 1, At, B1); PG8_BAR;
            PG8_LDA(At, 1, 1); PG8_STAGE(PG8_SA(1, 0), a3, voffA);
            PG8_BAR; PG8_WAIT_L(0); PG8_MMA(1, 0, At, B0); PG8_BAR; PG8_SCHED;
            PG8_STAGE(PG8_SB(1, 1), b3 + hstep, voffB);
            PG8_WAIT_V(6); PG8_BAR; PG8_MMA(1, 1, At, B1); PG8_BAR;
            }
        }
        if constexpr (ALIGN_EPI) { if (wr == 0) PG8_BAR; }
        if constexpr (!Epi::AFTER_DRAIN) { E(acc, cur, wr, wc, fr, fq); S.done(cur); }
        if (!has_next) break;
#pragma unroll
        for (int a = 0; a < 2; ++a)
#pragma unroll
            for (int b = 0; b < 2; ++b)
#pragma unroll
                for (int m = 0; m < 4; ++m)
#pragma unroll
                    for (int n = 0; n < 2; ++n) acc[a][b][m][n] = (f32x4){0.f, 0.f, 0.f, 0.f};
        cur = nxt; cA = nA; cB = nB; ++ui;
        if constexpr (ALIGN_EPI) { if (wr == 1) PG8_BAR; }
    }
    PG8_WAIT_V(0);
    if constexpr (!ALIGN_EPI) { if (wr == 0) PG8_BAR; }
    PG8_BAR;
    if constexpr (Epi::AFTER_DRAIN) { E.fused(acc, cur, wr, wc, fr, fq, lds, wid, lane); S.done(cur); }
#undef PG8_SA
#undef PG8_SB
#undef PG8_STAGE
#undef PG8_LDA
#undef PG8_LDB
#undef PG8_MMA
#undef PG8_WAIT_V
#undef PG8_WAIT_L
#undef PG8_BAR
#undef PG8_SCHED
}
}

using pg8::bf16_t; using pg8::bf16x8; using pg8::f32x4; using pg8::u32x4; using pg8::Unit; using pg8::cvt_pk_bf16;
#define LAS __attribute__((address_space(3)))
typedef float f32x16 __attribute__((ext_vector_type(16)));
typedef unsigned u32x2 __attribute__((ext_vector_type(2)));
constexpr int DM = 1024, MTOK = 131072, NPROMPT = 65536, SEQP = 4096, SEQS = 8192, DFF = 2816;
constexpr float EPSV = 1e-6f;
constexpr float QSCALE = 0.125f * 1.4426950408889634f;
constexpr size_t MiB = 1024 * 1024;
constexpr size_t WS_WQKP = 0, WS_WV = 3 * MiB, WS_WOUT = 4 * MiB, WS_WUP = 6 * MiB, WS_WDN = 17 * MiB, WS_COS = 23 * MiB, WS_SIN = 24 * MiB, WS_RSS = 25 * MiB, WS_QKG = 25 * MiB + 768 * 1024,
                 WS_XB = 26 * MiB, WS_Q = WS_XB, WS_K = WS_XB + 128 * MiB, WS_ACT = 282 * MiB, WS_VT = WS_ACT, WS_ZP = WS_ACT + 128 * MiB, WS_H = WS_ACT + 256 * MiB,
                 WS_END = WS_ACT + 704 * MiB;
constexpr int LDS_STAGE = 131072, LDS_EDGE = 8192, LDS_TOTAL = 147456;

struct Params {
    const float* in[19];
    float* out;
    unsigned char* ws;
};
enum { I_XP = 0, I_XS, I_N1G, I_WIN, I_QG, I_KG, I_LQ1, I_LK1, I_LQ2, I_LK2, I_SUBG, I_WPOOL, I_PSCALE, I_WOUT, I_N2G, I_WUP, I_CONVW, I_CONVB, I_WDOWN };

__device__ __forceinline__ int lane_id() { int l; asm volatile("v_mbcnt_lo_u32_b32 %0, -1, 0\n\tv_mbcnt_hi_u32_b32 %0, -1, %0" : "=v"(l)); return l; }
__device__ __forceinline__ bf16_t f2bf(float x) { unsigned u = __float_as_uint(x); u += 0x7fffu + ((u >> 16) & 1u); return (bf16_t)(u >> 16); }
__device__ __forceinline__ float bf2f(unsigned short b) { return __uint_as_float(((unsigned)b) << 16); }
__device__ __forceinline__ float bflo(unsigned w) { return __uint_as_float(w << 16); }
__device__ __forceinline__ float bfhi(unsigned w) { return __uint_as_float(w & 0xffff0000u); }
__device__ __forceinline__ u32x4 pack8(f32x4 a, f32x4 b) { u32x4 w; w.x = cvt_pk_bf16(a[0], a[1]); w.y = cvt_pk_bf16(a[2], a[3]); w.z = cvt_pk_bf16(b[0], b[1]); w.w = cvt_pk_bf16(b[2], b[3]); return w; }
__device__ __forceinline__ u32x2 pack4(f32x4 a) { u32x2 w; w.x = cvt_pk_bf16(a[0], a[1]); w.y = cvt_pk_bf16(a[2], a[3]); return w; }

struct EpiQKP {
    static constexpr bool PERM = true, AFTER_DRAIN = false;
    unsigned char* ws; const float *qkg  , *cosT, *sinT;
    __device__ __forceinline__ void operator()(f32x4 (&acc)[2][2][4][2], const Unit& u, int wr, int wc, int fr, int fq) const {
        const int kind = u.pn >> 1;
        bf16_t* base = (bf16_t*)(ws + (kind == 0 ? WS_Q : (kind == 1 ? WS_K : WS_ZP)));
        const int colbase = (u.pn & 1) * 256 + wc * 64, i0 = 8 * fq;
        if (kind < 2) {
            const float* g = qkg + kind * 64;
            const float osc = kind == 0 ? QSCALE : 1.0f;
            const f32x4 g00 = *(const f32x4*)(g + i0), g01 = *(const f32x4*)(g + i0 + 4), g10 = *(const f32x4*)(g + 32 + i0), g11 = *(const f32x4*)(g + 32 + i0 + 4);
#pragma unroll
            for (int ai = 0; ai < 2; ++ai)
#pragma unroll
                for (int m = 0; m < 4; ++m) {
                    const int row = u.pm * 256 + ai * 128 + wr * 64 + m * 16 + fr;
                    const int pos = row < NPROMPT ? (row & (SEQP - 1)) : (row & (SEQS - 1));
                    const f32x4 a00 = acc[ai][0][m][0], a01 = acc[ai][0][m][1], a10 = acc[ai][1][m][0], a11 = acc[ai][1][m][1];
                    f32x4 sq = a00 * a00 + a01 * a01 + a10 * a10 + a11 * a11;
                    float ss = (sq[0] + sq[1]) + (sq[2] + sq[3]);
                    ss += __shfl_xor(ss, 16); ss += __shfl_xor(ss, 32);
                    const float rstd = rsqrtf(ss * (1.0f / 64.0f) + EPSV) * osc;
                    const f32x4 cs0 = *(const f32x4*)(cosT + pos * 32 + i0), sn0 = *(const f32x4*)(sinT + pos * 32 + i0);
                    const f32x4 cs1 = *(const f32x4*)(cosT + pos * 32 + i0 + 4), sn1 = *(const f32x4*)(sinT + pos * 32 + i0 + 4);
                    const f32x4 y00 = a00 * rstd * g00, y01 = a01 * rstd * g01, y10 = a10 * rstd * g10, y11 = a11 * rstd * g11;
                    bf16_t* rp = base + (size_t)row * 512 + colbase + i0;
                    *(u32x4*)(rp) = pack8(y00 * cs0 - y10 * sn0, y01 * cs1 - y11 * sn1);
                    *(u32x4*)(rp + 32) = pack8(y10 * cs0 + y00 * sn0, y11 * cs1 + y01 * sn1);
                    asm volatile("" ::: "memory");
                }
        } else {
#pragma unroll
            for (int ai = 0; ai < 2; ++ai)
#pragma unroll
                for (int m = 0; m < 4; ++m) {
                    const int row = u.pm * 256 + ai * 128 + wr * 64 + m * 16 + fr;
                    bf16_t* rp = base + (size_t)row * 512 + colbase + i0;
#pragma unroll
                    for (int bj = 0; bj < 2; ++bj) *(u32x4*)(rp + 32 * bj) = pack8(acc[ai][bj][m][0], acc[ai][bj][m][1]);
                }
        }
    }
};
struct EpiVT {
    static constexpr bool PERM = true, AFTER_DRAIN = false;
    bf16_t* vT;
    __device__ __forceinline__ void operator()(f32x4 (&acc)[2][2][4][2], const Unit& u, int wr, int wc, int fr, int fq) const {
#pragma unroll
        for (int ai = 0; ai < 2; ++ai)
#pragma unroll
            for (int m = 0; m < 4; ++m) {
                const int row = u.pm * 256 + ai * 128 + wr * 64 + m * 16 + fr;
                bf16_t* rp = vT + (size_t)row * MTOK + (size_t)u.pn * 256 + wc * 32 + 16 * (fq >> 1) + 4 * (fq & 1);
#pragma unroll
                for (int bj = 0; bj < 2; ++bj)
#pragma unroll
                    for (int n = 0; n < 2; ++n) *(u32x2*)(rp + 128 * bj + 8 * n) = pack4(acc[ai][bj][m][n]);
            }
    }
};
struct EpiRes1 {
    static constexpr bool PERM = true, AFTER_DRAIN = false;
    const float *xp, *xs; float* out; bf16_t* xb; float* rss;
    __device__ __forceinline__ void operator()(f32x4 (&acc)[2][2][4][2], const Unit& u, int wr, int wc, int fr, int fq) const {
        const int col0 = u.pn * 256 + wc * 32 + 8 * fq;
#pragma unroll
        for (int ai = 0; ai < 2; ++ai)
#pragma unroll
            for (int m = 0; m < 4; ++m) {
                const int row = u.pm * 256 + ai * 128 + wr * 64 + m * 16 + fr;
                const float* xr = (row < NPROMPT ? xp + (size_t)row * DM : xs + (size_t)(row - NPROMPT) * DM) + col0;
                float* orow = out + (size_t)row * DM + col0; bf16_t* brow = xb + (size_t)row * DM + col0;
                float ss = 0.f;
#pragma unroll
                for (int bj = 0; bj < 2; ++bj) {
                    const f32x4 a = acc[ai][bj][m][0] + *(const f32x4*)(xr + 128 * bj), b = acc[ai][bj][m][1] + *(const f32x4*)(xr + 128 * bj + 4);
                    *(f32x4*)(orow + 128 * bj) = a; *(f32x4*)(orow + 128 * bj + 4) = b;
                    *(u32x4*)(brow + 128 * bj) = pack8(a, b);
                    ss += (a[0] * a[0] + a[1] * a[1]) + (a[2] * a[2] + a[3] * a[3]) + (b[0] * b[0] + b[1] * b[1]) + (b[2] * b[2] + b[3] * b[3]);
                }
                ss += __shfl_xor(ss, 16); ss += __shfl_xor(ss, 32);
                if (fq == 0) atomicAdd(rss + row, ss);
                asm volatile("" ::: "memory");
            }
    }
};
struct EpiRes2 {
    static constexpr bool PERM = true, AFTER_DRAIN = false;
    float* out;
    __device__ __forceinline__ void operator()(f32x4 (&acc)[2][2][4][2], const Unit& u, int wr, int wc, int fr, int fq) const {
        const int col0 = u.pn * 256 + wc * 32 + 8 * fq;
#pragma unroll
        for (int ai = 0; ai < 2; ++ai)
#pragma unroll
            for (int m = 0; m < 4; ++m) {
                const int row = u.pm * 256 + ai * 128 + wr * 64 + m * 16 + fr;
                float* orow = out + (size_t)row * DM + col0;
#pragma unroll
                for (int bj = 0; bj < 2; ++bj) {
                    const f32x4 a = acc[ai][bj][m][0] + *(const f32x4*)(orow + 128 * bj), b = acc[ai][bj][m][1] + *(const f32x4*)(orow + 128 * bj + 4);
                    *(f32x4*)(orow + 128 * bj) = a; *(f32x4*)(orow + 128 * bj + 4) = b;
                }
                asm volatile("" ::: "memory");
            }
    }
};
__device__ __forceinline__ float dpp_ror1(float v) { return __builtin_bit_cast(float, __builtin_amdgcn_update_dpp(0, __builtin_bit_cast(int, v), 0x121, 0xf, 0xf, false)); }
__device__ __forceinline__ float dpp_ror15(float v) { return __builtin_bit_cast(float, __builtin_amdgcn_update_dpp(0, __builtin_bit_cast(int, v), 0x12F, 0xf, 0xf, false)); }
struct EpiConvGate {
    static constexpr bool PERM = true, AFTER_DRAIN = false;
    const float *rss, *convw, *convb; bf16_t* act; LAS float* edge;
    __device__ __forceinline__ void operator()(f32x4 (&acc)[2][2][4][2], const Unit& u, int wr, int wc, int fr, int fq) const {
        const int tok0 = 254 * u.pm - 1;
        const int pcol = wc * 32 + 8 * fq;
#pragma unroll
        for (int ai = 0; ai < 2; ++ai)
#pragma unroll
            for (int m = 0; m < 4; ++m) {
                const int tok = tok0 + ai * 128 + wr * 64 + m * 16 + fr;
                const bool valid = (tok >= 0) && (tok < MTOK);
                float rs = 0.f; if (valid) rs = rsqrtf(rss[tok] * (1.0f / 1024.0f) + EPSV);
#pragma unroll
                for (int bj = 0; bj < 2; ++bj)
#pragma unroll
                    for (int n = 0; n < 2; ++n) { f32x4 x = acc[ai][bj][m][n] * rs;
#pragma unroll
                        for (int j = 0; j < 4; ++j) x[j] = valid ? x[j] : 0.f;
                        acc[ai][bj][m][n] = x; }
            }
#pragma unroll
        for (int ai = 0; ai < 2; ++ai) {
            const int blk = 2 * ai + wr;
            if (fr == 0) {
#pragma unroll
                for (int bj = 0; bj < 2; ++bj)
#pragma unroll
                    for (int n = 0; n < 2; ++n) *(LAS f32x4*)(edge + (blk * 2 + 0) * 256 + 128 * bj + pcol + 4 * n) = acc[ai][bj][0][n];
            }
            if (fr == 15) {
#pragma unroll
                for (int bj = 0; bj < 2; ++bj)
#pragma unroll
                    for (int n = 0; n < 2; ++n) *(LAS f32x4*)(edge + (blk * 2 + 1) * 256 + 128 * bj + pcol + 4 * n) = acc[ai][bj][3][n];
            }
        }
        asm volatile("s_waitcnt lgkmcnt(0)\n\ts_barrier" ::: "memory");
        const int fcol = u.pn * 128 + pcol;
#pragma unroll
        for (int n = 0; n < 2; ++n) {
            f32x4 w0[2], w1[2], w2[2], bb[2];
#pragma unroll
            for (int bj = 0; bj < 2; ++bj) { const int c = bj * DFF + fcol + 4 * n;
                w0[bj] = *(const f32x4*)(convw + c); w1[bj] = *(const f32x4*)(convw + 2 * DFF + c); w2[bj] = *(const f32x4*)(convw + 4 * DFF + c); bb[bj] = *(const f32x4*)(convb + c); }
#pragma unroll
            for (int ai = 0; ai < 2; ++ai) {
                const int blk = 2 * ai + wr;
                f32x4 pe[2], ne[2];
#pragma unroll
                for (int bj = 0; bj < 2; ++bj) {
                    pe[bj] = blk > 0 ? *(const LAS f32x4*)(edge + ((blk - 1) * 2 + 1) * 256 + 128 * bj + pcol + 4 * n) : (f32x4){0.f, 0.f, 0.f, 0.f};
                    ne[bj] = blk < 3 ? *(const LAS f32x4*)(edge + ((blk + 1) * 2 + 0) * 256 + 128 * bj + pcol + 4 * n) : (f32x4){0.f, 0.f, 0.f, 0.f};
                }
#pragma unroll
                for (int m = 0; m < 4; ++m) {
                    const int r = ai * 128 + wr * 64 + m * 16 + fr, tok = tok0 + r;
                    const int S1 = (tok < NPROMPT ? SEQP : SEQS) - 1, pos = tok & S1;
                    const bool isfirst = pos == 0, islast = pos == S1;
                    f32x4 cv[2];
#pragma unroll
                    for (int bj = 0; bj < 2; ++bj) {
                        const f32x4 cur = acc[ai][bj][m][n];
                        const f32x4 ups = m > 0 ? acc[ai][bj][m > 0 ? m - 1 : 0][n] : pe[bj];
                        const f32x4 dns = m < 3 ? acc[ai][bj][m < 3 ? m + 1 : 3][n] : ne[bj];
                        f32x4 prev, next;
#pragma unroll
                        for (int j = 0; j < 4; ++j) {
                            const float t1 = fr == 15 ? ups[j] : cur[j]; float pv = dpp_ror1(t1);
                            const float t2 = fr == 0 ? dns[j] : cur[j]; float nx = dpp_ror15(t2);
                            prev[j] = isfirst ? 0.f : pv; next[j] = islast ? 0.f : nx;
                        }
                        cv[bj] = w0[bj] * prev + w1[bj] * cur + w2[bj] * next + bb[bj];
                    }
                    f32x4 a;
#pragma unroll
                    for (int j = 0; j < 4; ++j) { const float g = cv[0][j]; const float sg = __builtin_amdgcn_rcpf(1.0f + __builtin_amdgcn_exp2f(-1.4426950408889634f * g)); a[j] = g * sg * cv[1][j]; }
                    if (r >= 1 && r <= 254 && tok < MTOK) *(u32x2*)(act + (size_t)tok * DFF + fcol + 4 * n) = pack4(a);
                    asm volatile("" ::: "memory");
                }
            }
        }
    }
};

__device__ __forceinline__ void p0_prologue(const Params& p, LAS unsigned char* lds, const int wave_s) {
    int tid_ = wave_s * 64 + lane_id(); asm volatile("" : "+v"(tid_));
    const int tid = tid_, G = gridDim.x, gt = blockIdx.x * 512 + tid, GT = G * 512, lane = tid & 63, wid = tid >> 6;
    unsigned char* ws = p.ws;
    bf16_t* WQKP = (bf16_t*)(ws + WS_WQKP); bf16_t* WV = (bf16_t*)(ws + WS_WV); bf16_t* WOUT = (bf16_t*)(ws + WS_WOUT); bf16_t* WUP = (bf16_t*)(ws + WS_WUP); bf16_t* WDN = (bf16_t*)(ws + WS_WDN);
    LAS float* tile = (LAS float*)lds;
    for (int t = blockIdx.x; t < 2752; t += G) {
        const float* src; int ld, k0, n0, kind;
        if (t < 512) { kind = 0; k0 = (t >> 5) * 64; n0 = (t & 31) * 64; src = p.in[I_WIN]; ld = 2048; }
        else if (t < 640) { const int u = t - 512; kind = 1; k0 = (u >> 4) * 64; n0 = (u & 15) * 64; src = p.in[I_WOUT]; ld = 1024; }
        else if (t < 2048) { const int u = t - 640; kind = 2; k0 = (u / 88) * 64; n0 = (u % 88) * 64; src = p.in[I_WUP]; ld = 5632; }
        else { const int u = t - 2048; kind = 3; k0 = (u >> 4) * 64; n0 = (u & 15) * 64; src = p.in[I_WDOWN]; ld = 1024; }
#pragma unroll
        for (int i = 0; i < 8; ++i) { const int e = tid + i * 512, kk = e >> 6, nn = e & 63;
            float v = src[(size_t)(k0 + kk) * ld + n0 + nn];
            if (kind == 1) v *= p.in[I_SUBG][(k0 + kk) & 127] * 0.8f;
            if (kind == 2) v *= p.in[I_N2G][k0 + kk];
            tile[kk * 65 + nn] = v; }
        __syncthreads();
#pragma unroll
        for (int i = 0; i < 8; ++i) { const int e = tid + i * 512, nn = e >> 6, kk = e & 63, n = n0 + nn; bf16_t* dst;
            if (kind == 0) {
                if (n < 1024 || n >= 1536) { const int L = n < 1024 ? n : n - 512; const int prow = (L & ~255) + ((L >> 5) & 1) * 128 + ((L >> 6) & 3) * 32 + (L & 31); dst = WQKP + (size_t)prow * 1024 + k0 + kk; }
                else dst = WV + (size_t)(n - 1024) * 1024 + k0 + kk;
            } else if (kind == 1) dst = WOUT + (size_t)n * 1024 + k0 + kk;
            else if (kind == 2) { const int f = n < DFF ? n : n - DFF; const int prow = (f >> 7) * 256 + (n < DFF ? 0 : 128) + (f & 127); dst = WUP + (size_t)prow * 1024 + k0 + kk; }
            else dst = WDN + (size_t)n * DFF + k0 + kk;
            *dst = f2bf(tile[kk * 65 + nn]); }
        __syncthreads();
    }
    for (int o = gt; o < 512 * 1024; o += GT) {
        const int n = o & 1023, gc = o >> 10, g = gc >> 7;
        const float* wp = p.in[I_WPOOL] + (size_t)gc * 128; const float* ps = p.in[I_PSCALE] + g * 128; const float* wo = p.in[I_WOUT] + (size_t)(512 + g * 128) * 1024 + n;
        float a = 0.f;
        for (int e = 0; e < 128; ++e) a += wp[e] * ps[e] * wo[(size_t)e * 1024];
        WOUT[(size_t)n * 1024 + 512 + gc] = f2bf(a);
    }
    float* cosT = (float*)(ws + WS_COS); float* sinT = (float*)(ws + WS_SIN);
    for (int o = gt; o < 8192 * 32; o += GT) {
        const int s = o >> 5, i = o & 31;
        const float inv = exp2f(-(float)i * (13.287712379549449f / 32.0f));
        const float ang = (float)s * inv;
        const double rev = (double)ang * 0.15915494309189535; const float fr = (float)(rev - __builtin_rint(rev));
        cosT[o] = __builtin_amdgcn_cosf(fr); sinT[o] = __builtin_amdgcn_sinf(fr);
    }
    float* rss = (float*)(ws + WS_RSS);
    for (int o = gt; o < MTOK; o += GT) rss[o] = 0.f;
    if (gt < 128) ((float*)(ws + WS_QKG))[gt] = gt < 64 ? p.in[I_QG][gt] : p.in[I_KG][gt - 64];
    bf16_t* H = (bf16_t*)(ws + WS_H);
    f32x4 g1[4];
#pragma unroll
    for (int i = 0; i < 4; ++i) g1[i] = *(const f32x4*)(p.in[I_N1G] + lane * 4 + 256 * i);
    for (int row = blockIdx.x * 8 + wid; row < MTOK; row += G * 8) {
        const float* xr = (row < NPROMPT ? p.in[I_XP] + (size_t)row * DM : p.in[I_XS] + (size_t)(row - NPROMPT) * DM) + lane * 4;
        f32x4 v[4]; float ss = 0.f;
#pragma unroll
        for (int i = 0; i < 4; ++i) { v[i] = *(const f32x4*)(xr + 256 * i); ss += (v[i][0] * v[i][0] + v[i][1] * v[i][1]) + (v[i][2] * v[i][2] + v[i][3] * v[i][3]); }
#pragma unroll
        for (int o = 1; o < 64; o <<= 1) ss += __shfl_xor(ss, o);
        const float rstd = rsqrtf(ss * (1.0f / 1024.0f) + EPSV);
        bf16_t* hr = H + (size_t)row * DM + lane * 4;
#pragma unroll
        for (int i = 0; i < 4; ++i) *(u32x2*)(hr + 256 * i) = pack4(v[i] * rstd * g1[i]);
    }
}

__device__ __forceinline__ void pool_phase(const bf16_t* zp, bf16_t* mixed, const int wave_s) {
    const int GT = gridDim.x * 512; int tid_ = wave_s * 64 + lane_id(); asm volatile("" : "+v"(tid_));
    for (int item = blockIdx.x * 512 + tid_; item < MTOK * 64; item += GT) {
        const int tok = item >> 6, ch = item & 63, c0 = ch * 8, g = ch >> 4, half = 1 << g;
        const int S = tok < NPROMPT ? SEQP : SEQS, pos = tok & (S - 1), base = tok - pos;
        const int lo = max(pos - half, 0), hi = min(pos + half - 1, S - 1);
        float s[8];
#pragma unroll
        for (int j = 0; j < 8; ++j) s[j] = 0.f;
        for (int r = lo; r <= hi; ++r) {
            const u32x4 w = *(const u32x4*)(zp + (size_t)(base + r) * 512 + c0);
            s[0] += bflo(w.x); s[1] += bfhi(w.x); s[2] += bflo(w.y); s[3] += bfhi(w.y); s[4] += bflo(w.z); s[5] += bfhi(w.z); s[6] += bflo(w.w); s[7] += bfhi(w.w);
        }
        const u32x4 w = *(const u32x4*)(zp + (size_t)tok * 512 + c0);
        const float ic = 1.0f / (float)(hi - lo + 1);
        u32x4 o;
        o.x = cvt_pk_bf16(s[0] * ic - bflo(w.x), s[1] * ic - bfhi(w.x)); o.y = cvt_pk_bf16(s[2] * ic - bflo(w.y), s[3] * ic - bfhi(w.y));
        o.z = cvt_pk_bf16(s[4] * ic - bflo(w.z), s[5] * ic - bfhi(w.z)); o.w = cvt_pk_bf16(s[6] * ic - bflo(w.w), s[7] * ic - bfhi(w.w));
        *(u32x4*)(mixed + (size_t)tok * DM + 512 + c0) = o;
    }
}

#define MFMA32(a, b, c) __builtin_amdgcn_mfma_f32_32x32x16_bf16((a), (b), (c), 0, 0, 0)
constexpr int KROW = 256, VROW = 128, KBUF = 64 * KROW, VBUF = 128 * VROW, ABUF = KBUF + VBUF, QROW = 272;
__device__ __forceinline__ bf16x8 packp(const f32x16& x, int s) {
    u32x4 w;
    w.x = cvt_pk_bf16(x[8 * s + 0], x[8 * s + 1]); w.y = cvt_pk_bf16(x[8 * s + 2], x[8 * s + 3]); w.z = cvt_pk_bf16(x[8 * s + 4], x[8 * s + 5]); w.w = cvt_pk_bf16(x[8 * s + 6], x[8 * s + 7]);
    return __builtin_bit_cast(bf16x8, w);
}
__device__ __forceinline__ void attn_phase_online(LAS unsigned char* lds, const bf16_t* q, const bf16_t* k, const bf16_t* vT, bf16_t* mixed, float lam, const int wave_s) {
    int tid_ = wave_s * 64 + lane_id(); asm volatile("" : "+v"(tid_));
    const int tid = tid_, lane = tid & 63, r32 = lane & 31, hi = lane >> 5, wid = __builtin_amdgcn_readfirstlane(tid >> 6), G = gridDim.x;
    unsigned koff[2], voff[2];
#pragma unroll
    for (int i = 0; i < 2; ++i) {
        const int kr = 4 * (2 * wid + i) + (lane >> 4), kc = (lane & 15) ^ (kr & 15); koff[i] = (unsigned)(kr * 512 + kc * 8) * 2u;
        const int vd = 8 * (2 * wid + i) + (lane >> 3), vc = (lane & 7) ^ ((vd >> 1) & 7); voff[i] = (unsigned)(vd * MTOK + vc * 8) * 2u;
    }
    const int kx = r32 & 15, vx = (r32 >> 1) & 7;
    const unsigned lds0 = (unsigned)(size_t)lds;
#define ATT_DMA1(sbase, voff_, ldsdst) do { unsigned keep_; asm volatile("s_mov_b32 %0, m0\n\ts_mov_b32 m0, %3\n\ts_nop 0\n\tglobal_load_lds_dwordx4 %1, %2\n\ts_mov_b32 m0, %0" : "=&s"(keep_) : "v"(voff_), "s"(sbase), "s"(ldsdst) : "memory"); } while (0)
#define ATT_DMA(buf, kp, vp) do { _Pragma("unroll") for (int _i = 0; _i < 2; ++_i) { \
        ATT_DMA1((kp), koff[_i], lds0 + (unsigned)((buf) + (2 * wid + _i) * 1024)); \
        ATT_DMA1((vp), voff[_i], lds0 + (unsigned)((buf) + KBUF + (2 * wid + _i) * 1024)); } } while (0)
    for (int U = blockIdx.x; U < 2048; U += G) {
        const int rnd = U >> 8, cc = U & 255, x = cc & 7, jj = cc >> 3;
        int S, tok0, h, qb;
        if (rnd < 4) { const int pair = 4 * x + rnd; S = SEQS; tok0 = NPROMPT + (pair >> 2) * SEQS; h = pair & 3; qb = jj; }
        else { const int pair = 8 * x + 2 * (rnd - 4) + (jj >> 4); S = SEQP; tok0 = (pair >> 2) * SEQP; h = pair & 3; qb = jj & 15; }
        const bf16_t* Kg = k + (size_t)tok0 * 512 + h * 128;
        const bf16_t* Vg = vT + (size_t)(h * 128) * MTOK + tok0;
        const int NT = S / 64;
        const size_t qrow = (size_t)tok0 + qb * 256 + wid * 32 + r32;
        ATT_DMA(0, Kg, Vg);
        LAS unsigned char* Qs = lds + 2 * ABUF + wid * (32 * QROW) + r32 * QROW + hi * 16;
#pragma unroll
        for (int m = 0; m < 2; ++m)
#pragma unroll
            for (int d0 = 0; d0 < 4; ++d0) *(LAS bf16x8*)(Qs + m * 128 + d0 * 32) = *(const bf16x8*)(q + qrow * 512 + h * 128 + m * 64 + d0 * 16 + hi * 8);
        f32x16 o[2][4];
#pragma unroll
        for (int m = 0; m < 2; ++m)
#pragma unroll
            for (int db = 0; db < 4; ++db)
#pragma unroll
                for (int i = 0; i < 16; ++i) o[m][db][i] = 0.f;
        float mu[2] = {-1e30f, -1e30f}, l[2] = {0.f, 0.f};
        asm volatile("s_waitcnt vmcnt(0)" ::: "memory");
        __syncthreads();
        for (int t = 0; t < NT; ++t) {
            const int cb = (t & 1) * ABUF, nb = ((t + 1) & 1) * ABUF;
            if (t + 1 < NT) ATT_DMA(nb, Kg + (size_t)(t + 1) * 64 * 512, Vg + (t + 1) * 64);
            const LAS unsigned char* Kb = lds + cb + r32 * KROW;
            const LAS unsigned char* Vb = lds + cb + KBUF + r32 * VROW;
#pragma unroll
            for (int m = 0; m < 2; ++m) {
                f32x16 s0, s1;
#pragma unroll
                for (int i = 0; i < 16; ++i) { s0[i] = 0.f; s1[i] = 0.f; }
#pragma unroll
                for (int d0 = 0; d0 < 4; ++d0) {
                    const int kpos = ((m * 8 + d0 * 2 + hi) ^ kx) * 16;
                    const bf16x8 k0 = *(const LAS bf16x8*)(Kb + kpos), k1 = *(const LAS bf16x8*)(Kb + 32 * KROW + kpos);
                    const bf16x8 qv = *(const LAS bf16x8*)(Qs + m * 128 + d0 * 32);
                    s0 = MFMA32(k0, qv, s0); s1 = MFMA32(k1, qv, s1);
                    if (d0 == 1) __builtin_amdgcn_sched_barrier(0);
                }
                __builtin_amdgcn_sched_barrier(0);
                float mx = fmaxf(s0[0], s1[0]);
#pragma unroll
                for (int i = 1; i < 16; ++i) mx = fmaxf(mx, fmaxf(s0[i], s1[i]));
                mx = fmaxf(mx, __shfl_xor(mx, 32));
                const bool need = mx > mu[m] + 8.0f;
                if (__builtin_amdgcn_ballot_w64(need) != 0ull) {
                    const float nm = need ? mx : mu[m];
                    const float alpha = __builtin_amdgcn_exp2f(mu[m] - nm);
                    mu[m] = nm; l[m] *= alpha;
#pragma unroll
                    for (int db = 0; db < 4; ++db)
#pragma unroll
                        for (int i = 0; i < 16; ++i) o[m][db][i] *= alpha;
                }
                const float mm = mu[m];
                float ls = 0.f;
#pragma unroll
                for (int i = 0; i < 16; ++i) { s0[i] = __builtin_amdgcn_exp2f(s0[i] - mm); s1[i] = __builtin_amdgcn_exp2f(s1[i] - mm); ls += s0[i] + s1[i]; }
                l[m] += ls;
                const bf16x8 p0 = packp(s0, 0), p1 = packp(s0, 1), p2 = packp(s1, 0), p3 = packp(s1, 1);
                __builtin_amdgcn_sched_barrier(0);
#pragma unroll
                for (int db = 0; db < 4; ++db) {
                    const LAS unsigned char* vb = Vb + db * 32 * VROW;
                    const bf16x8 v0 = *(const LAS bf16x8*)(vb + ((0 + hi) ^ vx) * 16), v1 = *(const LAS bf16x8*)(vb + ((2 + hi) ^ vx) * 16), v2 = *(const LAS bf16x8*)(vb + ((4 + hi) ^ vx) * 16), v3 = *(const LAS bf16x8*)(vb + ((6 + hi) ^ vx) * 16);
                    o[m][db] = MFMA32(v0, p0, o[m][db]); o[m][db] = MFMA32(v1, p1, o[m][db]); o[m][db] = MFMA32(v2, p2, o[m][db]); o[m][db] = MFMA32(v3, p3, o[m][db]);
                    __builtin_amdgcn_sched_barrier(0);
                }
            }
            asm volatile("s_waitcnt vmcnt(0)" ::: "memory");
            __syncthreads();
        }
        const float l0 = l[0] + __shfl_xor(l[0], 32), l1 = l[1] + __shfl_xor(l[1], 32);
        const float c0 = 1.0f / l0, c1 = lam / l1;
        float ss = 0.f;
#pragma unroll
        for (int db = 0; db < 4; ++db)
#pragma unroll
            for (int i = 0; i < 16; ++i) { const float v = o[0][db][i] * c0 - o[1][db][i] * c1; o[0][db][i] = v; ss += v * v; }
        ss += __shfl_xor(ss, 32);
        const float rstd = rsqrtf(ss * (1.0f / 128.0f) + EPSV);
        bf16_t* orow = mixed + qrow * DM + h * 128 + 4 * hi;
#pragma unroll
        for (int db = 0; db < 4; ++db)
#pragma unroll
            for (int i4 = 0; i4 < 4; ++i4) {
                u32x2 w; w.x = cvt_pk_bf16(o[0][db][4 * i4] * rstd, o[0][db][4 * i4 + 1] * rstd); w.y = cvt_pk_bf16(o[0][db][4 * i4 + 2] * rstd, o[0][db][4 * i4 + 3] * rstd);
                *(u32x2*)(orow + 32 * db + 8 * i4) = w;
            }
    }
}


__device__ __forceinline__ void attn_phase_fast(LAS unsigned char* lds, const bf16_t* q, const bf16_t* k, const bf16_t* vT, bf16_t* mixed, float lam, const int wave_s) {
    int tid_ = wave_s * 64 + lane_id(); asm volatile("" : "+v"(tid_));
    const int wid = __builtin_amdgcn_readfirstlane(tid_ >> 6), G = gridDim.x;
    const unsigned lds0 = (unsigned)(size_t)lds;
    for (int U = blockIdx.x; U < 2048; U += G) {
        int lane_ = tid_ & 63; asm volatile("" : "+v"(lane_));
        const int lane = lane_, r32 = lane & 31, hi = lane >> 5;
        unsigned koff[2], voff[2];
#pragma unroll
        for (int i = 0; i < 2; ++i) {
            const int kr = 4 * (2 * wid + i) + (lane >> 4), kc = (lane & 15) ^ (kr & 15); koff[i] = (unsigned)(kr * 512 + kc * 8) * 2u;
            const int vd = 8 * (2 * wid + i) + (lane >> 3), vc = (lane & 7) ^ ((vd >> 1) & 7); voff[i] = (unsigned)(vd * MTOK + vc * 8) * 2u;
        }
        const int kx = r32 & 15, vx = (r32 >> 1) & 7;
        const int rnd = U >> 8, cc = U & 255, x = cc & 7, jj = cc >> 3;
        int S, tok0, h, qb;
        if (rnd < 4) { const int pair = 4 * x + rnd; S = SEQS; tok0 = NPROMPT + (pair >> 2) * SEQS; h = pair & 3; qb = jj; }
        else { const int pair = 8 * x + 2 * (rnd - 4) + (jj >> 4); S = SEQP; tok0 = (pair >> 2) * SEQP; h = pair & 3; qb = jj & 15; }
        const bf16_t* Kg = k + (size_t)tok0 * 512 + h * 128;
        const bf16_t* Vg = vT + (size_t)(h * 128) * MTOK + tok0;
        const int NT = S / 64;
        const size_t qrow = (size_t)tok0 + qb * 256 + wid * 32 + r32;
        ATT_DMA(0, Kg, Vg);
        LAS unsigned char* Qs = lds + 2 * ABUF + wid * (32 * QROW) + r32 * QROW + hi * 16;
#pragma unroll
        for (int m = 0; m < 2; ++m)
#pragma unroll
            for (int d0 = 0; d0 < 4; ++d0) *(LAS bf16x8*)(Qs + m * 128 + d0 * 32) = *(const bf16x8*)(q + qrow * 512 + h * 128 + m * 64 + d0 * 16 + hi * 8);
        f32x16 o[2][4];
#pragma unroll
        for (int m = 0; m < 2; ++m)
#pragma unroll
            for (int db = 0; db < 4; ++db)
#pragma unroll
                for (int i = 0; i < 16; ++i) o[m][db][i] = 0.f;
        float l[2] = {0.f, 0.f};
        asm volatile("s_waitcnt vmcnt(0)" ::: "memory");
        __syncthreads();
        for (int t = 0; t < NT; ++t) {
            const int cb = (t & 1) * ABUF, nb = ((t + 1) & 1) * ABUF;
            int ln = lane; asm volatile("" : "+v"(ln));
            const int r32 = ln & 31, hi = ln >> 5, kx = r32 & 15, vx = (r32 >> 1) & 7;
            if (t + 1 < NT) {
                unsigned koff[2], voff[2];
#pragma unroll
                for (int i = 0; i < 2; ++i) {
                    const int kr = 4 * (2 * wid + i) + (ln >> 4), kc = (ln & 15) ^ (kr & 15); koff[i] = (unsigned)(kr * 512 + kc * 8) * 2u;
                    const int vd = 8 * (2 * wid + i) + (ln >> 3), vc = (ln & 7) ^ ((vd >> 1) & 7); voff[i] = (unsigned)(vd * MTOK + vc * 8) * 2u;
                }
                ATT_DMA(nb, Kg + (size_t)(t + 1) * 64 * 512, Vg + (t + 1) * 64);
            }
            const LAS unsigned char* Qs = lds + 2 * ABUF + wid * (32 * QROW) + r32 * QROW + hi * 16;
            int kxh = (kx >> 1) << 5, vxh = (vx >> 1) << 5, kq = cb + r32 * KROW + ((hi ^ (kx & 1)) << 4), vq = cb + KBUF + r32 * VROW + ((hi ^ (vx & 1)) << 4);
            asm volatile("" : "+v"(kxh), "+v"(vxh), "+v"(kq), "+v"(vq));
            const LAS unsigned char* Kb = lds + kq;
            const LAS unsigned char* Vb = lds + vq;
#pragma unroll
            for (int m = 0; m < 2; ++m) {
                f32x16 s0, s1;
#pragma unroll
                for (int i = 0; i < 16; ++i) { s0[i] = 0.f; s1[i] = 0.f; }
#pragma unroll
                for (int d0 = 0; d0 < 4; ++d0) {
                    const int kpos = ((m * 4 + d0) << 5) ^ kxh;
                    const bf16x8 k0 = *(const LAS bf16x8*)(Kb + kpos), k1 = *(const LAS bf16x8*)(Kb + 32 * KROW + kpos);
                    const bf16x8 qv = *(const LAS bf16x8*)(Qs + m * 128 + d0 * 32);
                    s0 = MFMA32(k0, qv, s0); s1 = MFMA32(k1, qv, s1);
                    if (d0 == 1) __builtin_amdgcn_sched_barrier(0);
                }
                __builtin_amdgcn_sched_barrier(0);
                float ls = 0.f, ls2 = 0.f;
#pragma unroll
                for (int i = 0; i < 16; ++i) { float e0 = __builtin_amdgcn_exp2f(s0[i]), e1 = __builtin_amdgcn_exp2f(s1[i]); asm volatile("" : "+v"(e0), "+v"(e1)); s0[i] = e0; s1[i] = e1; ls += e0; ls2 += e1; }
                ls += ls2;
                l[m] += ls;
                const bf16x8 p0 = packp(s0, 0), p1 = packp(s0, 1), p2 = packp(s1, 0), p3 = packp(s1, 1);
                __builtin_amdgcn_sched_barrier(0);
#pragma unroll
                for (int db = 0; db < 4; ++db) {
                    const LAS unsigned char* vb = Vb + db * 32 * VROW;
                    const bf16x8 v0 = *(const LAS bf16x8*)(vb + (0 ^ vxh)), v1 = *(const LAS bf16x8*)(vb + (32 ^ vxh)), v2 = *(const LAS bf16x8*)(vb + (64 ^ vxh)), v3 = *(const LAS bf16x8*)(vb + (96 ^ vxh));
                    o[m][db] = MFMA32(v0, p0, o[m][db]); o[m][db] = MFMA32(v1, p1, o[m][db]); o[m][db] = MFMA32(v2, p2, o[m][db]); o[m][db] = MFMA32(v3, p3, o[m][db]);
                    __builtin_amdgcn_sched_barrier(0);
                }
            }
            asm volatile("s_waitcnt vmcnt(0)" ::: "memory");
            __syncthreads();
        }
        const float l0 = l[0] + __shfl_xor(l[0], 32), l1 = l[1] + __shfl_xor(l[1], 32);
        const float c0 = 1.0f / l0, c1 = lam / l1;
        float ss = 0.f;
#pragma unroll
        for (int db = 0; db < 4; ++db)
#pragma unroll
            for (int i = 0; i < 16; ++i) { const float v = o[0][db][i] * c0 - o[1][db][i] * c1; o[0][db][i] = v; ss += v * v; }
        ss += __shfl_xor(ss, 32);
        const float rstd = rsqrtf(ss * (1.0f / 128.0f) + EPSV);
        int lane2 = lane_id(); asm volatile("" : "+v"(lane2));
        bf16_t* orow = mixed + ((size_t)tok0 + qb * 256 + wid * 32 + (lane2 & 31)) * DM + h * 128 + 4 * (lane2 >> 5);
#pragma unroll
        for (int db = 0; db < 4; ++db)
#pragma unroll
            for (int i4 = 0; i4 < 4; ++i4) {
                u32x2 w; w.x = cvt_pk_bf16(o[0][db][4 * i4] * rstd, o[0][db][4 * i4 + 1] * rstd); w.y = cvt_pk_bf16(o[0][db][4 * i4 + 2] * rstd, o[0][db][4 * i4 + 3] * rstd);
                *(u32x2*)(orow + 32 * db + 8 * i4) = w;
            }
    }
}


__global__ void __launch_bounds__(512) fwd_megakernel(Params p) {
    extern __shared__ __attribute__((aligned(16))) unsigned char lds_raw[];
    LAS unsigned char* lds = (LAS unsigned char*)lds_raw;
    cg::grid_group grid = cg::this_grid();
    unsigned char* ws = p.ws;
    const int G = gridDim.x, c = blockIdx.x;
    const int wave_s = __builtin_amdgcn_readfirstlane((int)threadIdx.x >> 6);
    bf16_t* WQKP = (bf16_t*)(ws + WS_WQKP); bf16_t* WV = (bf16_t*)(ws + WS_WV); bf16_t* WOUT = (bf16_t*)(ws + WS_WOUT); bf16_t* WUP = (bf16_t*)(ws + WS_WUP); bf16_t* WDN = (bf16_t*)(ws + WS_WDN);
    float* cosT = (float*)(ws + WS_COS); float* sinT = (float*)(ws + WS_SIN); float* rss = (float*)(ws + WS_RSS);
    bf16_t* Q = (bf16_t*)(ws + WS_Q); bf16_t* Kt = (bf16_t*)(ws + WS_K); bf16_t* VT = (bf16_t*)(ws + WS_VT); bf16_t* ZP = (bf16_t*)(ws + WS_ZP);
    bf16_t* H = (bf16_t*)(ws + WS_H); bf16_t* MIX = H; bf16_t* XB = (bf16_t*)(ws + WS_XB); bf16_t* ACT = (bf16_t*)(ws + WS_ACT);

#ifndef SKIP_P0
    p0_prologue(p, lds, wave_s);
#endif
    grid.sync();
#ifndef SKIP_P1
    {
        pg8::Gemm g{H, WQKP, MTOK, 1536, DM}; pg8::StaticOrder S; S.init(MTOK, 1536, G, c);
        EpiQKP E{ws, (const float*)(ws + WS_QKG), cosT, sinT};
        pg8::gemm_phase<EpiQKP, pg8::StaticOrder, true, true>(lds, g, S, E, wave_s);
    }
    {
        pg8::Gemm g{WV, H, 512, MTOK, DM}; pg8::StaticOrder S; S.init(512, MTOK, G, c);
        EpiVT E{VT};
        pg8::gemm_phase<EpiVT, pg8::StaticOrder, true, true>(lds, g, S, E, wave_s);
    }
#endif
    grid.sync();
#ifndef SKIP_P2
    pool_phase(ZP, MIX, wave_s);
    {
        float d1 = 0.f, d2 = 0.f;
        for (int i = 0; i < 64; ++i) { d1 += p.in[I_LQ1][i] * p.in[I_LK1][i]; d2 += p.in[I_LQ2][i] * p.in[I_LK2][i]; }
        const float lam = __builtin_bit_cast(float, __builtin_amdgcn_readfirstlane(__builtin_bit_cast(int, __expf(d1) - __expf(d2) + 0.2f)));
        float gq = 0.f, gk = 0.f;
        for (int i = 0; i < 64; ++i) { gq = fmaxf(gq, fabsf(p.in[I_QG][i])); gk = fmaxf(gk, fabsf(p.in[I_KG][i])); }
        const float bound = 64.0f * QSCALE * gq * gk;
        if (bound < 100.0f) attn_phase_fast(lds, Q, Kt, VT, MIX, lam, wave_s);
        else attn_phase_online(lds, Q, Kt, VT, MIX, lam, wave_s);
    }
#endif
    grid.sync();
#ifndef SKIP_P3
    {
        pg8::Gemm g{MIX, WOUT, MTOK, DM, DM}; pg8::StaticOrder S; S.init(MTOK, DM, G, c);
        EpiRes1 E{p.in[I_XP], p.in[I_XS], p.out, XB, rss};
        pg8::gemm_phase<EpiRes1, pg8::StaticOrder, true, true>(lds, g, S, E, wave_s);
    }
#endif
    grid.sync();
#ifndef SKIP_P4
    {
        pg8::Gemm g{XB, WUP, MTOK, 2 * DFF, DM}; pg8::StaticOrder S; S.init_tiles(517, 22, G, c, 1);
        EpiConvGate E{rss, p.in[I_CONVW], p.in[I_CONVB], ACT, (LAS float*)(lds + LDS_STAGE)};
        pg8::gemm_phase<EpiConvGate, pg8::StaticOrder, true, true>(lds, g, S, E, wave_s);
    }
#endif
    grid.sync();
#ifndef SKIP_P5
    {
        pg8::Gemm g{ACT, WDN, MTOK, DM, DFF}; pg8::StaticOrder S; S.init(MTOK, DM, G, c);
        EpiRes2 E{p.out};
        pg8::gemm_phase<EpiRes2, pg8::StaticOrder, true, true>(lds, g, S, E, wave_s);
    }
#endif
}

extern "C" void kernel_launch(void* const* d_in, const int* in_sizes, int n_in, void* d_out, int out_size, void* d_ws, size_t ws_size, hipStream_t stream) {
    static int grid_blocks = 0;
    if (grid_blocks == 0) {
        if (n_in != 19 || ws_size < WS_END) { fprintf(stderr, "kernel_launch: unexpected n_in %d / ws_size %zu (need %zu)\n", n_in, ws_size, (size_t)WS_END); grid_blocks = -1; return; }
        int dev = 0, cus = 0, per_cu = 0;
        (void)hipGetDevice(&dev);
        (void)hipDeviceGetAttribute(&cus, hipDeviceAttributeMultiprocessorCount, dev);
        if (hipFuncSetAttribute((const void*)fwd_megakernel, hipFuncAttributeMaxDynamicSharedMemorySize, LDS_TOTAL) != hipSuccess) { fprintf(stderr, "kernel_launch: hipFuncSetAttribute failed\n"); grid_blocks = -1; return; }
        if (hipOccupancyMaxActiveBlocksPerMultiprocessor(&per_cu, (const void*)fwd_megakernel, 512, LDS_TOTAL) != hipSuccess || per_cu < 1) { fprintf(stderr, "kernel_launch: occupancy query failed (%d)\n", per_cu); (void)hipGetLastError(); per_cu = 1; }
        grid_blocks = cus * per_cu;
    }
    if (grid_blocks < 0) return;
    Params p{};
    for (int i = 0; i < 19; ++i) p.in[i] = (const float*)d_in[i];
    p.out = (float*)d_out; p.ws = (unsigned char*)d_ws;
    void* args[] = {&p};
    hipError_t e = hipLaunchCooperativeKernel((const void*)fwd_megakernel, dim3(grid_blocks), dim3(512), args, LDS_TOTAL, stream);
    if (e != hipSuccess) fprintf(stderr, "cooperative launch failed: %s (grid %d)\n", hipGetErrorString(e), grid_blocks);
}
```

```cpp
#include <hip/hip_runtime.h>
#include <hip/hip_cooperative_groups.h>
#include <cstdio>
#include <cstdint>
namespace cg = cooperative_groups;

namespace pg8 {
#define PG8_LAS __attribute__((address_space(3)))
typedef unsigned short bf16_t;
typedef short bf16x8 __attribute__((ext_vector_type(8)));
typedef float f32x4 __attribute__((ext_vector_type(4)));
typedef unsigned u32x4 __attribute__((ext_vector_type(4)));
constexpr int BM = 256, BK = 64, HALF = 128, HTB = HALF * BK * 2  , STAGE_BYTES = 8 * HTB, NXCD = 8, WGM = 8;

__host__ __device__ __forceinline__ int lds_byte(int r, int c) { const int st = (r >> 4) * 2 + (c >> 5), rr = r & 15, cc = c & 31, ob = rr * 64 + cc * 2; return st * 1024 + (ob ^ (((ob >> 9) & 1) << 5)); }
__host__ __device__ __forceinline__ void stage_rc(int b, int& R, int& C) { const int st = b / 1024, sb = b % 1024, swz = sb ^ (((sb >> 9) & 1) << 5); R = (st >> 1) * 16 + swz / 64; C = (st & 1) * 32 + (swz % 64) / 2; }
__host__ __device__ __forceinline__ int perm32(int rho) { const int n = rho >> 4, i = rho & 15; return 8 * (i >> 2) + 4 * n + (i & 3); }

struct Unit { int pm, pn; };
struct Gemm { const bf16_t* A; const bf16_t* Bt; int M, N, K; };

struct StaticOrder {
    int nM, nN, nwg, G, c; int halo;
    __host__ __device__ void init_tiles(int nM_, int nN_, int G_, int c_, int halo_) { nM = nM_; nN = nN_; nwg = nM * nN; G = G_; c = c_; halo = halo_; }
    __device__ __forceinline__ long a_off(int pm, int K) const { return halo ? ((long)254 * pm - 1) * (long)K * 2 : (long)pm * 256 * (long)K * 2; }
    __host__ __device__ void init(int M, int N, int G_, int c_) { nM = M / BM; nN = N / BM; nwg = nM * nN; G = G_; c = c_; halo = 0; }
    __host__ __device__ bool next(int i, Unit& u) const {
        const long L = (long)i * G + c; if (L >= nwg) return false;
        int wgid = (int)L; { const int q = nwg / NXCD, r = nwg % NXCD, xcd = wgid % NXCD, off = wgid / NXCD; wgid = (xcd < r ? xcd * (q + 1) : r * (q + 1) + (xcd - r) * q) + off; }
        const int nig = WGM * nN, gid = wgid / nig, fm = gid * WGM, gsz = (nM - fm) < WGM ? (nM - fm) : WGM;
        u.pm = fm + ((wgid % nig) % gsz); u.pn = (wgid % nig) / gsz; return true;
    }
    __device__ __forceinline__ void a_ready(const Unit&) const {}
    __device__ __forceinline__ void done(const Unit&) const {}
};
__device__ __forceinline__ unsigned cvt_pk_bf16(float lo, float hi) { unsigned r; asm volatile("v_cvt_pk_bf16_f32 %0, %1, %2" : "=v"(r) : "v"(lo), "v"(hi)); return r; }
typedef float f32x2 __attribute__((ext_vector_type(2)));
typedef float f32x2 __attribute__((ext_vector_type(2)));
template <class Epi, class Sched, bool ALIGN_EPI = false, bool SP2 = false>
__device__ __forceinline__ void gemm_phase(PG8_LAS unsigned char* lds, const Gemm g, const Sched& S, const Epi& E, const int wave_s) {
    int tid_; asm volatile("v_mbcnt_lo_u32_b32 %0, -1, 0\n\tv_mbcnt_hi_u32_b32 %0, -1, %0" : "=v"(tid_)); tid_ += wave_s * 64;
    const int tid = tid_, wid = __builtin_amdgcn_readfirstlane(tid >> 6), lane = tid & 63, wr = wid >> 2, wc = wid & 3, fr = lane & 15, fq = lane >> 4;
    const int K = g.K, nt = K / BK;
    unsigned voffA[2], voffB[2];
#pragma unroll
    for (int i = 0; i < 2; ++i) { int R, C; stage_rc(tid * 16 + i * 8192, R, C); const int Rb = Epi::PERM ? ((R & ~31) + perm32(R & 31)) : R;
        voffA[i] = (unsigned)(R * K + C) * 2u; voffB[i] = (unsigned)(Rb * K + C) * 2u; }
    const size_t kstep = (size_t)(BK * 2);
    const size_t hstep = (size_t)HALF * K * 2;
    const size_t tstep = 2 * hstep;
    const unsigned ldsw = (unsigned)wid * 1024u;
    const int aoff = lds_byte(wr * 64 + fr, fq * 8), boff = lds_byte(wc * 32 + fr, fq * 8);
#define PG8_SA(b, h) (((b) * 2 + (h)) * HTB)
#define PG8_SB(b, h) ((4 + (b) * 2 + (h)) * HTB)
#define PG8_STAGE(bufoff, gbase, voff) do { _Pragma("unroll") for (int _i = 0; _i < 2; ++_i) \
        __builtin_amdgcn_global_load_lds((const unsigned*)((const char*)(gbase) + (voff)[_i]), (PG8_LAS unsigned*)(lds + (bufoff) + ldsw + _i * 8192), 16, 0, 0); } while (0)
#define PG8_LDA(dst, b, h) do { _Pragma("unroll") for (int m = 0; m < 4; ++m) _Pragma("unroll") for (int k = 0; k < 2; ++k) dst[m][k] = *(const PG8_LAS bf16x8*)(lds + PG8_SA(b, h) + aoff + m * 2048 + k * 1024); } while (0)
#define PG8_LDB(dst, b, h) do { _Pragma("unroll") for (int n = 0; n < 2; ++n) _Pragma("unroll") for (int k = 0; k < 2; ++k) dst[n][k] = *(const PG8_LAS bf16x8*)(lds + PG8_SB(b, h) + boff + n * 2048 + k * 1024); } while (0)
#define PG8_MMA(ai, bj, At, Bt) do { __builtin_amdgcn_s_setprio(1); _Pragma("unroll") for (int m = 0; m < 4; ++m) _Pragma("unroll") for (int n = 0; n < 2; ++n) _Pragma("unroll") for (int k = 0; k < 2; ++k) \
        acc[ai][bj][m][n] = __builtin_amdgcn_mfma_f32_16x16x32_bf16(Bt[n][k], At[m][k], acc[ai][bj][m][n], 0, 0, 0); __builtin_amdgcn_s_setprio(0); } while (0)
#define PG8_WAIT_V(n) asm volatile("s_waitcnt vmcnt(" #n ")" ::: "memory")
#define PG8_WAIT_L(n) asm volatile("s_waitcnt lgkmcnt(" #n ")" ::: "memory")
#define PG8_BAR __builtin_amdgcn_s_barrier()
#define PG8_SCHED __builtin_amdgcn_sched_barrier(0)
    Unit cur, nxt; int ui = 0;
    if (!S.next(0, cur)) return;
    f32x4 acc[2][2][4][2];
#pragma unroll
    for (int a = 0; a < 2; ++a)
#pragma unroll
        for (int b = 0; b < 2; ++b)
#pragma unroll
            for (int m = 0; m < 4; ++m)
#pragma unroll
                for (int n = 0; n < 2; ++n) acc[a][b][m][n] = (f32x4){0.f, 0.f, 0.f, 0.f};
    bf16x8 At[4][2], B0[2][2], B1[2][2];
    const char* cA = (const char*)g.A + S.a_off(cur.pm, K); const char* cB = (const char*)g.Bt + (size_t)cur.pn * tstep;
    S.a_ready(cur);
    if constexpr (SP2) {
        PG8_STAGE(PG8_SB(0, 0), cB, voffB); PG8_STAGE(PG8_SB(0, 1), cB + hstep, voffB); PG8_STAGE(PG8_SA(0, 0), cA, voffA); PG8_STAGE(PG8_SA(0, 1), cA + hstep, voffA);
        if (wr == 1) PG8_BAR;
        PG8_WAIT_V(2); PG8_BAR;
        PG8_STAGE(PG8_SB(1, 0), cB + kstep, voffB); PG8_STAGE(PG8_SA(1, 0), cA + kstep, voffA); PG8_STAGE(PG8_SB(1, 1), cB + hstep + kstep, voffB);
        PG8_WAIT_V(6); PG8_BAR;
    } else {
        PG8_STAGE(PG8_SB(0, 0), cB, voffB); PG8_STAGE(PG8_SA(0, 0), cA, voffA); PG8_STAGE(PG8_SB(0, 1), cB + hstep, voffB); PG8_STAGE(PG8_SA(0, 1), cA + hstep, voffA);
        if (wr == 1) PG8_BAR;
        PG8_WAIT_V(4); PG8_BAR;
        PG8_STAGE(PG8_SB(1, 0), cB + kstep, voffB); PG8_STAGE(PG8_SA(1, 0), cA + kstep, voffA); PG8_STAGE(PG8_SB(1, 1), cB + hstep + kstep, voffB);
        PG8_WAIT_V(6); PG8_BAR;
    }
    for (;;) {
        const bool has_next = S.next(ui + 1, nxt);
        const char* nA = has_next ? (const char*)g.A + S.a_off(nxt.pm, K) : cA; const char* nB = has_next ? (const char*)g.Bt + (size_t)nxt.pn * tstep : cB;
        for (int t = 0; t < nt; t += 2) {
            const bool last = (t == nt - 2);
            const char* a1 = cA + (size_t)(t + 1) * kstep;
            const char* a2 = last ? nA : cA + (size_t)(t + 2) * kstep; const char* b2 = last ? nB : cB + (size_t)(t + 2) * kstep;
            const char* a3 = a2 + kstep; const char* b3 = b2 + kstep;
            if (last && has_next) S.a_ready(nxt);
            if constexpr (SP2) {
            PG8_LDB(B0, 0, 0); PG8_LDB(B1, 0, 1); PG8_SCHED; PG8_LDA(At, 0, 0); PG8_STAGE(PG8_SA(1, 1), a1 + hstep, voffA);
            PG8_WAIT_V(8); PG8_WAIT_L(0); PG8_BAR; PG8_MMA(0, 0, At, B0); PG8_MMA(0, 1, At, B1); PG8_BAR; PG8_SCHED;
            PG8_LDA(At, 0, 1); PG8_STAGE(PG8_SB(0, 0), b2, voffB); PG8_STAGE(PG8_SB(0, 1), b2 + hstep, voffB); PG8_STAGE(PG8_SA(0, 0), a2, voffA);
            PG8_WAIT_V(8); PG8_WAIT_L(0); PG8_BAR; PG8_MMA(1, 0, At, B0); PG8_MMA(1, 1, At, B1); PG8_BAR; PG8_SCHED;
            PG8_LDB(B0, 1, 0); PG8_LDB(B1, 1, 1); PG8_SCHED; PG8_LDA(At, 1, 0); PG8_STAGE(PG8_SA(0, 1), a2 + hstep, voffA);
            PG8_WAIT_V(8); PG8_WAIT_L(0); PG8_BAR; PG8_MMA(0, 0, At, B0); PG8_MMA(0, 1, At, B1); PG8_BAR; PG8_SCHED;
            PG8_LDA(At, 1, 1); PG8_STAGE(PG8_SB(1, 0), b3, voffB); PG8_STAGE(PG8_SB(1, 1), b3 + hstep, voffB); PG8_STAGE(PG8_SA(1, 0), a3, voffA);
            PG8_WAIT_V(8); PG8_WAIT_L(0); PG8_BAR; PG8_MMA(1, 0, At, B0); PG8_MMA(1, 1, At, B1); PG8_BAR; PG8_SCHED;
            } else {
            PG8_LDB(B0, 0, 0); PG8_SCHED; PG8_LDA(At, 0, 0); PG8_STAGE(PG8_SA(1, 1), a1 + hstep, voffA);
            PG8_WAIT_L(8); PG8_BAR; PG8_WAIT_L(0); PG8_MMA(0, 0, At, B0); PG8_BAR; PG8_SCHED;
            PG8_LDB(B1, 0, 1); PG8_STAGE(PG8_SB(0, 0), b2, voffB);
            PG8_BAR; PG8_WAIT_L(0); PG8_MMA(0, 1, At, B1); PG8_BAR;
            PG8_LDA(At, 0, 1); PG8_STAGE(PG8_SA(0, 0), a2, voffA);
            PG8_BAR; PG8_WAIT_L(0); PG8_MMA(1, 0, At, B0); PG8_BAR; PG8_SCHED;
            PG8_STAGE(PG8_SB(0, 1), b2 + hstep, voffB);
            PG8_WAIT_V(6); PG8_BAR; PG8_MMA(1, 1, At, B1); PG8_BAR;
            PG8_LDB(B0, 1, 0); PG8_SCHED; PG8_LDA(At, 1, 0); PG8_STAGE(PG8_SA(0, 1), a2 + hstep, voffA);
            PG8_WAIT_L(8); PG8_BAR; PG8_WAIT_L(0); PG8_MMA(0, 0, At, B0); PG8_BAR; PG8_SCHED;
            PG8_LDB(B1, 1, 1); PG8_STAGE(PG8_SB(1, 0), b3, voffB);
            PG8_BAR; PG8_WAIT_L(0); PG8_MMA(0, 1, At, B1); PG8_BAR;
            PG8_LDA(At, 1, 1); PG8_STAGE(PG8_SA(1, 0), a3, voffA);
            PG8_BAR; PG8_WAIT_L(0); PG8_MMA(1, 0, At, B0); PG8_BAR; PG8_SCHED;
            PG8_STAGE(PG8_SB(1, 1), b3 + hstep, voffB);
            PG8_WAIT_V(6); PG8_BAR; PG8_MMA(1, 1, At, B1); PG8_BAR;
            }
        }
        if constexpr (ALIGN_EPI) { if (wr == 0) PG8_BAR; }
        if constexpr (!Epi::AFTER_DRAIN) { E(acc, cur, wr, wc, fr, fq); S.done(cur); }
        if (!has_next) break;
#pragma unroll
        for (int a = 0; a < 2; ++a)
#pragma unroll
            for (int b = 0; b < 2; ++b)
#pragma unroll
                for (int m = 0; m < 4; ++m)
#pragma unroll
                    for (int n = 0; n < 2; ++n) acc[a][b][m][n] = (f32x4){0.f, 0.f, 0.f, 0.f};
        cur = nxt; cA = nA; cB = nB; ++ui;
        if constexpr (ALIGN_EPI) { if (wr == 1) PG8_BAR; }
    }
    PG8_WAIT_V(0);
    if constexpr (!ALIGN_EPI) { if (wr == 0) PG8_BAR; }
    PG8_BAR;
    if constexpr (Epi::AFTER_DRAIN) { E.fused(acc, cur, wr, wc, fr, fq, lds, wid, lane); S.done(cur); }
#undef PG8_SA
#undef PG8_SB
#undef PG8_STAGE
#undef PG8_LDA
#undef PG8_LDB
#undef PG8_MMA
#undef PG8_WAIT_V
#undef PG8_WAIT_L
#undef PG8_BAR
#undef PG8_SCHED
}
}

using pg8::bf16_t; using pg8::bf16x8; using pg8::f32x4; using pg8::u32x4; using pg8::Unit; using pg8::cvt_pk_bf16;
#define LAS __attribute__((address_space(3)))
typedef float f32x16 __attribute__((ext_vector_type(16)));
typedef unsigned u32x2 __attribute__((ext_vector_type(2)));
constexpr int DM = 1024, MTOK = 131072, NPROMPT = 65536, SEQP = 4096, SEQS = 8192, DFF = 2816;
constexpr float EPSV = 1e-6f;
constexpr float QSCALE = 0.125f * 1.4426950408889634f;
constexpr size_t MiB = 1024 * 1024;
constexpr size_t WS_WQKP = 0, WS_WV = 3 * MiB, WS_WOUT = 4 * MiB, WS_WUP = 6 * MiB, WS_WDN = 17 * MiB, WS_COS = 23 * MiB, WS_SIN = 24 * MiB, WS_RSS = 25 * MiB, WS_QKG = 25 * MiB + 768 * 1024,
                 WS_XB = 26 * MiB, WS_Q = WS_XB, WS_K = WS_XB + 128 * MiB, WS_ACT = 282 * MiB, WS_VT = WS_ACT, WS_ZP = WS_ACT + 128 * MiB, WS_H = WS_ACT + 256 * MiB,
                 WS_END = WS_ACT + 704 * MiB;
constexpr int LDS_STAGE = 131072, LDS_EDGE = 8192, LDS_TOTAL = 147456;

struct Params {
    const float* in[19];
    float* out;
    unsigned char* ws;
};
enum { I_XP = 0, I_XS, I_N1G, I_WIN, I_QG, I_KG, I_LQ1, I_LK1, I_LQ2, I_LK2, I_SUBG, I_WPOOL, I_PSCALE, I_WOUT, I_N2G, I_WUP, I_CONVW, I_CONVB, I_WDOWN };

__device__ __forceinline__ int lane_id() { int l; asm volatile("v_mbcnt_lo_u32_b32 %0, -1, 0\n\tv_mbcnt_hi_u32_b32 %0, -1, %0" : "=v"(l)); return l; }
__device__ __forceinline__ bf16_t f2bf(float x) { unsigned u = __float_as_uint(x); u += 0x7fffu + ((u >> 16) & 1u); return (bf16_t)(u >> 16); }
__device__ __forceinline__ float bf2f(unsigned short b) { return __uint_as_float(((unsigned)b) << 16); }
__device__ __forceinline__ float bflo(unsigned w) { return __uint_as_float(w << 16); }
__device__ __forceinline__ float bfhi(unsigned w) { return __uint_as_float(w & 0xffff0000u); }
__device__ __forceinline__ u32x4 pack8(f32x4 a, f32x4 b) { u32x4 w; w.x = cvt_pk_bf16(a[0], a[1]); w.y = cvt_pk_bf16(a[2], a[3]); w.z = cvt_pk_bf16(b[0], b[1]); w.w = cvt_pk_bf16(b[2], b[3]); return w; }
__device__ __forceinline__ u32x2 pack4(f32x4 a) { u32x2 w; w.x = cvt_pk_bf16(a[0], a[1]); w.y = cvt_pk_bf16(a[2], a[3]); return w; }

struct EpiQKP {
    static constexpr bool PERM = true, AFTER_DRAIN = false;
    unsigned char* ws; const float *qkg  , *cosT, *sinT;
    __device__ __forceinline__ void operator()(f32x4 (&acc)[2][2][4][2], const Unit& u, int wr, int wc, int fr, int fq) const {
        const int kind = u.pn >> 1;
        bf16_t* base = (bf16_t*)(ws + (kind == 0 ? WS_Q : (kind == 1 ? WS_K : WS_ZP)));
        const int colbase = (u.pn & 1) * 256 + wc * 64, i0 = 8 * fq;
        if (kind < 2) {
            const float* g = qkg + kind * 64;
            const float osc = kind == 0 ? QSCALE : 1.0f;
            const f32x4 g00 = *(const f32x4*)(g + i0), g01 = *(const f32x4*)(g + i0 + 4), g10 = *(const f32x4*)(g + 32 + i0), g11 = *(const f32x4*)(g + 32 + i0 + 4);
#pragma unroll
            for (int ai = 0; ai < 2; ++ai)
#pragma unroll
                for (int m = 0; m < 4; ++m) {
                    const int row = u.pm * 256 + ai * 128 + wr * 64 + m * 16 + fr;
                    const int pos = row < NPROMPT ? (row & (SEQP - 1)) : (row & (SEQS - 1));
                    const f32x4 a00 = acc[ai][0][m][0], a01 = acc[ai][0][m][1], a10 = acc[ai][1][m][0], a11 = acc[ai][1][m][1];
                    f32x4 sq = a00 * a00 + a01 * a01 + a10 * a10 + a11 * a11;
                    float ss = (sq[0] + sq[1]) + (sq[2] + sq[3]);
                    ss += __shfl_xor(ss, 16); ss += __shfl_xor(ss, 32);
                    const float rstd = rsqrtf(ss * (1.0f / 64.0f) + EPSV) * osc;
                    const f32x4 cs0 = *(const f32x4*)(cosT + pos * 32 + i0), sn0 = *(const f32x4*)(sinT + pos * 32 + i0);
                    const f32x4 cs1 = *(const f32x4*)(cosT + pos * 32 + i0 + 4), sn1 = *(const f32x4*)(sinT + pos * 32 + i0 + 4);
                    const f32x4 y00 = a00 * rstd * g00, y01 = a01 * rstd * g01, y10 = a10 * rstd * g10, y11 = a11 * rstd * g11;
                    bf16_t* rp = base + (size_t)row * 512 + colbase + i0;
                    *(u32x4*)(rp) = pack8(y00 * cs0 - y10 * sn0, y01 * cs1 - y11 * sn1);
                    *(u32x4*)(rp + 32) = pack8(y10 * cs0 + y00 * sn0, y11 * cs1 + y01 * sn1);
                    asm volatile("" ::: "memory");
                }
        } else {
#pragma unroll
            for (int ai = 0; ai < 2; ++ai)
#pragma unroll
                for (int m = 0; m < 4; ++m) {
                    const int row = u.pm * 256 + ai * 128 + wr * 64 + m * 16 + fr;
                    bf16_t* rp = base + (size_t)row * 512 + colbase + i0;
#pragma unroll
                    for (int bj = 0; bj < 2; ++bj) *(u32x4*)(rp + 32 * bj) = pack8(acc[ai][bj][m][0], acc[ai][bj][m][1]);
                }
        }
    }
};
struct EpiVT {
    static constexpr bool PERM = true, AFTER_DRAIN = false;
    bf16_t* vT;
    __device__ __forceinline__ void operator()(f32x4 (&acc)[2][2][4][2], const Unit& u, int wr, int wc, int fr, int fq) const {
#pragma unroll
        for (int ai = 0; ai < 2; ++ai)
#pragma unroll
            for (int m = 0; m < 4; ++m) {
                const int row = u.pm * 256 + ai * 128 + wr * 64 + m * 16 + fr;
                bf16_t* rp = vT + (size_t)row * MTOK + (size_t)u.pn * 256 + wc * 32 + 16 * (fq >> 1) + 4 * (fq & 1);
#pragma unroll
                for (int bj = 0; bj < 2; ++bj)
#pragma unroll
                    for (int n = 0; n < 2; ++n) *(u32x2*)(rp + 128 * bj + 8 * n) = pack4(acc[ai][bj][m][n]);
            }
    }
};
struct EpiRes1 {
    static constexpr bool PERM = true, AFTER_DRAIN = false;
    const float *xp, *xs; bf16_t* xb; float* rss;
    __device__ __forceinline__ void operator()(f32x4 (&acc)[2][2][4][2], const Unit& u, int wr, int wc, int fr, int fq) const {
        const int col0 = u.pn * 256 + wc * 32 + 8 * fq;
#pragma unroll
        for (int ai = 0; ai < 2; ++ai)
#pragma unroll
            for (int m = 0; m < 4; ++m) {
                const int row = u.pm * 256 + ai * 128 + wr * 64 + m * 16 + fr;
                const float* xr = (row < NPROMPT ? xp + (size_t)row * DM : xs + (size_t)(row - NPROMPT) * DM) + col0;
                bf16_t* brow = xb + (size_t)row * DM + col0;
                float ss = 0.f;
#pragma unroll
                for (int bj = 0; bj < 2; ++bj) {
                    const f32x4 a = acc[ai][bj][m][0] + *(const f32x4*)(xr + 128 * bj), b = acc[ai][bj][m][1] + *(const f32x4*)(xr + 128 * bj + 4);
                    *(u32x4*)(brow + 128 * bj) = pack8(a, b);
                    ss += (a[0] * a[0] + a[1] * a[1]) + (a[2] * a[2] + a[3] * a[3]) + (b[0] * b[0] + b[1] * b[1]) + (b[2] * b[2] + b[3] * b[3]);
                }
                ss += __shfl_xor(ss, 16); ss += __shfl_xor(ss, 32);
                if (fq == 0) atomicAdd(rss + row, ss);
                asm volatile("" ::: "memory");
            }
    }
};
struct EpiRes2 {
    static constexpr bool PERM = true, AFTER_DRAIN = false;
    const bf16_t* xb; float* out;
    __device__ __forceinline__ void operator()(f32x4 (&acc)[2][2][4][2], const Unit& u, int wr, int wc, int fr, int fq) const {
        const int col0 = u.pn * 256 + wc * 32 + 8 * fq;
#pragma unroll
        for (int ai = 0; ai < 2; ++ai)
#pragma unroll
            for (int m = 0; m < 4; ++m) {
                const int row = u.pm * 256 + ai * 128 + wr * 64 + m * 16 + fr;
                float* orow = out + (size_t)row * DM + col0; const bf16_t* brow = xb + (size_t)row * DM + col0;
#pragma unroll
                for (int bj = 0; bj < 2; ++bj) {
                    const u32x4 w = *(const u32x4*)(brow + 128 * bj);
                    const f32x4 a = acc[ai][bj][m][0] + (f32x4){bflo(w.x), bfhi(w.x), bflo(w.y), bfhi(w.y)}, b = acc[ai][bj][m][1] + (f32x4){bflo(w.z), bfhi(w.z), bflo(w.w), bfhi(w.w)};
                    *(f32x4*)(orow + 128 * bj) = a; *(f32x4*)(orow + 128 * bj + 4) = b;
                }
                asm volatile("" ::: "memory");
            }
    }
};
__device__ __forceinline__ float dpp_ror1(float v) { return __builtin_bit_cast(float, __builtin_amdgcn_update_dpp(0, __builtin_bit_cast(int, v), 0x121, 0xf, 0xf, false)); }
__device__ __forceinline__ float dpp_ror15(float v) { return __builtin_bit_cast(float, __builtin_amdgcn_update_dpp(0, __builtin_bit_cast(int, v), 0x12F, 0xf, 0xf, false)); }
struct EpiConvGate {
    static constexpr bool PERM = true, AFTER_DRAIN = false;
    const float *rss, *convw, *convb; bf16_t* act; LAS float* edge;
    __device__ __forceinline__ void operator()(f32x4 (&acc)[2][2][4][2], const Unit& u, int wr, int wc, int fr, int fq) const {
        const int tok0 = 254 * u.pm - 1;
        const int pcol = wc * 32 + 8 * fq;
#pragma unroll
        for (int ai = 0; ai < 2; ++ai)
#pragma unroll
            for (int m = 0; m < 4; ++m) {
                const int tok = tok0 + ai * 128 + wr * 64 + m * 16 + fr;
                const bool valid = (tok >= 0) && (tok < MTOK);
                float rs = 0.f; if (valid) rs = rsqrtf(rss[tok] * (1.0f / 1024.0f) + EPSV);
#pragma unroll
                for (int bj = 0; bj < 2; ++bj)
#pragma unroll
                    for (int n = 0; n < 2; ++n) { f32x4 x = acc[ai][bj][m][n] * rs;
#pragma unroll
                        for (int j = 0; j < 4; ++j) x[j] = valid ? x[j] : 0.f;
                        acc[ai][bj][m][n] = x; }
            }
#pragma unroll
        for (int ai = 0; ai < 2; ++ai) {
            const int blk = 2 * ai + wr;
            if (fr == 0) {
#pragma unroll
                for (int bj = 0; bj < 2; ++bj)
#pragma unroll
                    for (int n = 0; n < 2; ++n) *(LAS f32x4*)(edge + (blk * 2 + 0) * 256 + 128 * bj + pcol + 4 * n) = acc[ai][bj][0][n];
            }
            if (fr == 15) {
#pragma unroll
                for (int bj = 0; bj < 2; ++bj)
#pragma unroll
                    for (int n = 0; n < 2; ++n) *(LAS f32x4*)(edge + (blk * 2 + 1) * 256 + 128 * bj + pcol + 4 * n) = acc[ai][bj][3][n];
            }
        }
        asm volatile("s_waitcnt lgkmcnt(0)\n\ts_barrier" ::: "memory");
        const int fcol = u.pn * 128 + pcol;
#pragma unroll
        for (int n = 0; n < 2; ++n) {
            f32x4 w0[2], w1[2], w2[2], bb[2];
#pragma unroll
            for (int bj = 0; bj < 2; ++bj) { const int c = bj * DFF + fcol + 4 * n;
                w0[bj] = *(const f32x4*)(convw + c); w1[bj] = *(const f32x4*)(convw + 2 * DFF + c); w2[bj] = *(const f32x4*)(convw + 4 * DFF + c); bb[bj] = *(const f32x4*)(convb + c); }
#pragma unroll
            for (int ai = 0; ai < 2; ++ai) {
                const int blk = 2 * ai + wr;
                f32x4 pe[2], ne[2];
#pragma unroll
                for (int bj = 0; bj < 2; ++bj) {
                    pe[bj] = blk > 0 ? *(const LAS f32x4*)(edge + ((blk - 1) * 2 + 1) * 256 + 128 * bj + pcol + 4 * n) : (f32x4){0.f, 0.f, 0.f, 0.f};
                    ne[bj] = blk < 3 ? *(const LAS f32x4*)(edge + ((blk + 1) * 2 + 0) * 256 + 128 * bj + pcol + 4 * n) : (f32x4){0.f, 0.f, 0.f, 0.f};
                }
#pragma unroll
                for (int m = 0; m < 4; ++m) {
                    const int r = ai * 128 + wr * 64 + m * 16 + fr, tok = tok0 + r;
                    const int S1 = (tok < NPROMPT ? SEQP : SEQS) - 1, pos = tok & S1;
                    const bool isfirst = pos == 0, islast = pos == S1;
                    f32x4 cv[2];
#pragma unroll
                    for (int bj = 0; bj < 2; ++bj) {
                        const f32x4 cur = acc[ai][bj][m][n];
                        const f32x4 ups = m > 0 ? acc[ai][bj][m > 0 ? m - 1 : 0][n] : pe[bj];
                        const f32x4 dns = m < 3 ? acc[ai][bj][m < 3 ? m + 1 : 3][n] : ne[bj];
                        f32x4 prev, next;
#pragma unroll
                        for (int j = 0; j < 4; ++j) {
                            const float t1 = fr == 15 ? ups[j] : cur[j]; float pv = dpp_ror1(t1);
                            const float t2 = fr == 0 ? dns[j] : cur[j]; float nx = dpp_ror15(t2);
                            prev[j] = isfirst ? 0.f : pv; next[j] = islast ? 0.f : nx;
                        }
                        cv[bj] = w0[bj] * prev + w1[bj] * cur + w2[bj] * next + bb[bj];
                    }
                    f32x4 a;
#pragma unroll
                    for (int j = 0; j < 4; ++j) { const float g = cv[0][j]; const float sg = __builtin_amdgcn_rcpf(1.0f + __builtin_amdgcn_exp2f(-1.4426950408889634f * g)); a[j] = g * sg * cv[1][j]; }
                    if (r >= 1 && r <= 254 && tok < MTOK) *(u32x2*)(act + (size_t)tok * DFF + fcol + 4 * n) = pack4(a);
                    asm volatile("" ::: "memory");
                }
            }
        }
    }
};

__device__ __forceinline__ void p0_prologue(const Params& p, LAS unsigned char* lds, const int wave_s) {
    int tid_ = wave_s * 64 + lane_id(); asm volatile("" : "+v"(tid_));
    const int tid = tid_, G = gridDim.x, gt = blockIdx.x * 512 + tid, GT = G * 512, lane = tid & 63, wid = tid >> 6;
    unsigned char* ws = p.ws;
    bf16_t* WQKP = (bf16_t*)(ws + WS_WQKP); bf16_t* WV = (bf16_t*)(ws + WS_WV); bf16_t* WOUT = (bf16_t*)(ws + WS_WOUT); bf16_t* WUP = (bf16_t*)(ws + WS_WUP); bf16_t* WDN = (bf16_t*)(ws + WS_WDN);
    LAS float* tile = (LAS float*)lds;
    for (int t = blockIdx.x; t < 2752; t += G) {
        const float* src; int ld, k0, n0, kind;
        if (t < 512) { kind = 0; k0 = (t >> 5) * 64; n0 = (t & 31) * 64; src = p.in[I_WIN]; ld = 2048; }
        else if (t < 640) { const int u = t - 512; kind = 1; k0 = (u >> 4) * 64; n0 = (u & 15) * 64; src = p.in[I_WOUT]; ld = 1024; }
        else if (t < 2048) { const int u = t - 640; kind = 2; k0 = (u / 88) * 64; n0 = (u % 88) * 64; src = p.in[I_WUP]; ld = 5632; }
        else { const int u = t - 2048; kind = 3; k0 = (u >> 4) * 64; n0 = (u & 15) * 64; src = p.in[I_WDOWN]; ld = 1024; }
#pragma unroll
        for (int i = 0; i < 8; ++i) { const int e = tid + i * 512, kk = e >> 6, nn = e & 63;
            float v = src[(size_t)(k0 + kk) * ld + n0 + nn];
            if (kind == 1) v *= p.in[I_SUBG][(k0 + kk) & 127] * 0.8f;
            if (kind == 2) v *= p.in[I_N2G][k0 + kk];
            tile[kk * 65 + nn] = v; }
        __syncthreads();
#pragma unroll
        for (int i = 0; i < 8; ++i) { const int e = tid + i * 512, nn = e >> 6, kk = e & 63, n = n0 + nn; bf16_t* dst;
            if (kind == 0) {
                if (n < 1024 || n >= 1536) { const int L = n < 1024 ? n : n - 512; const int prow = (L & ~255) + ((L >> 5) & 1) * 128 + ((L >> 6) & 3) * 32 + (L & 31); dst = WQKP + (size_t)prow * 1024 + k0 + kk; }
                else dst = WV + (size_t)(n - 1024) * 1024 + k0 + kk;
            } else if (kind == 1) dst = WOUT + (size_t)n * 1024 + k0 + kk;
            else if (kind == 2) { const int f = n < DFF ? n : n - DFF; const int prow = (f >> 7) * 256 + (n < DFF ? 0 : 128) + (f & 127); dst = WUP + (size_t)prow * 1024 + k0 + kk; }
            else dst = WDN + (size_t)n * DFF + k0 + kk;
            *dst = f2bf(tile[kk * 65 + nn]); }
        __syncthreads();
    }
    for (int o = gt; o < 512 * 1024; o += GT) {
        const int n = o & 1023, gc = o >> 10, g = gc >> 7;
        const float* wp = p.in[I_WPOOL] + (size_t)gc * 128; const float* ps = p.in[I_PSCALE] + g * 128; const float* wo = p.in[I_WOUT] + (size_t)(512 + g * 128) * 1024 + n;
        float a = 0.f;
        for (int e = 0; e < 128; ++e) a += wp[e] * ps[e] * wo[(size_t)e * 1024];
        WOUT[(size_t)n * 1024 + 512 + gc] = f2bf(a);
    }
    float* cosT = (float*)(ws + WS_COS); float* sinT = (float*)(ws + WS_SIN);
    for (int o = gt; o < 8192 * 32; o += GT) {
        const int s = o >> 5, i = o & 31;
        const float inv = exp2f(-(float)i * (13.287712379549449f / 32.0f));
        const float ang = (float)s * inv;
        const double rev = (double)ang * 0.15915494309189535; const float fr = (float)(rev - __builtin_rint(rev));
        cosT[o] = __builtin_amdgcn_cosf(fr); sinT[o] = __builtin_amdgcn_sinf(fr);
    }
    float* rss = (float*)(ws + WS_RSS);
    for (int o = gt; o < MTOK; o += GT) rss[o] = 0.f;
    if (gt < 128) ((float*)(ws + WS_QKG))[gt] = gt < 64 ? p.in[I_QG][gt] : p.in[I_KG][gt - 64];
    bf16_t* H = (bf16_t*)(ws + WS_H);
    f32x4 g1[4];
#pragma unroll
    for (int i = 0; i < 4; ++i) g1[i] = *(const f32x4*)(p.in[I_N1G] + lane * 4 + 256 * i);
    for (int row = blockIdx.x * 8 + wid; row < MTOK; row += G * 8) {
        const float* xr = (row < NPROMPT ? p.in[I_XP] + (size_t)row * DM : p.in[I_XS] + (size_t)(row - NPROMPT) * DM) + lane * 4;
        f32x4 v[4]; float ss = 0.f;
#pragma unroll
        for (int i = 0; i < 4; ++i) { v[i] = *(const f32x4*)(xr + 256 * i); ss += (v[i][0] * v[i][0] + v[i][1] * v[i][1]) + (v[i][2] * v[i][2] + v[i][3] * v[i][3]); }
#pragma unroll
        for (int o = 1; o < 64; o <<= 1) ss += __shfl_xor(ss, o);
        const float rstd = rsqrtf(ss * (1.0f / 1024.0f) + EPSV);
        bf16_t* hr = H + (size_t)row * DM + lane * 4;
#pragma unroll
        for (int i = 0; i < 4; ++i) *(u32x2*)(hr + 256 * i) = pack4(v[i] * rstd * g1[i]);
    }
}

__device__ __forceinline__ void pool_phase(const bf16_t* zp, bf16_t* mixed, const int wave_s) {
    const int GT = gridDim.x * 512; int tid_ = wave_s * 64 + lane_id(); asm volatile("" : "+v"(tid_));
    for (int item = blockIdx.x * 512 + tid_; item < MTOK * 64; item += GT) {
        const int tok = item >> 6, ch = item & 63, c0 = ch * 8, g = ch >> 4, half = 1 << g;
        const int S = tok < NPROMPT ? SEQP : SEQS, pos = tok & (S - 1), base = tok - pos;
        const int lo = max(pos - half, 0), hi = min(pos + half - 1, S - 1);
        float s[8];
#pragma unroll
        for (int j = 0; j < 8; ++j) s[j] = 0.f;
        for (int r = lo; r <= hi; ++r) {
            const u32x4 w = *(const u32x4*)(zp + (size_t)(base + r) * 512 + c0);
            s[0] += bflo(w.x); s[1] += bfhi(w.x); s[2] += bflo(w.y); s[3] += bfhi(w.y); s[4] += bflo(w.z); s[5] += bfhi(w.z); s[6] += bflo(w.w); s[7] += bfhi(w.w);
        }
        const u32x4 w = *(const u32x4*)(zp + (size_t)tok * 512 + c0);
        const float ic = 1.0f / (float)(hi - lo + 1);
        u32x4 o;
        o.x = cvt_pk_bf16(s[0] * ic - bflo(w.x), s[1] * ic - bfhi(w.x)); o.y = cvt_pk_bf16(s[2] * ic - bflo(w.y), s[3] * ic - bfhi(w.y));
        o.z = cvt_pk_bf16(s[4] * ic - bflo(w.z), s[5] * ic - bfhi(w.z)); o.w = cvt_pk_bf16(s[6] * ic - bflo(w.w), s[7] * ic - bfhi(w.w));
        *(u32x4*)(mixed + (size_t)tok * DM + 512 + c0) = o;
    }
}

#define MFMA32(a, b, c) __builtin_amdgcn_mfma_f32_32x32x16_bf16((a), (b), (c), 0, 0, 0)
constexpr int KROW = 256, VROW = 128, KBUF = 64 * KROW, VBUF = 128 * VROW, ABUF = KBUF + VBUF, QROW = 272;
__device__ __forceinline__ bf16x8 packp(const f32x16& x, int s) {
    u32x4 w;
    w.x = cvt_pk_bf16(x[8 * s + 0], x[8 * s + 1]); w.y = cvt_pk_bf16(x[8 * s + 2], x[8 * s + 3]); w.z = cvt_pk_bf16(x[8 * s + 4], x[8 * s + 5]); w.w = cvt_pk_bf16(x[8 * s + 6], x[8 * s + 7]);
    return __builtin_bit_cast(bf16x8, w);
}
__device__ __forceinline__ void attn_phase_online(LAS unsigned char* lds, const bf16_t* q, const bf16_t* k, const bf16_t* vT, bf16_t* mixed, float lam, const int wave_s) {
    int tid_ = wave_s * 64 + lane_id(); asm volatile("" : "+v"(tid_));
    const int tid = tid_, lane = tid & 63, r32 = lane & 31, hi = lane >> 5, wid = __builtin_amdgcn_readfirstlane(tid >> 6), G = gridDim.x;
    unsigned koff[2], voff[2];
#pragma unroll
    for (int i = 0; i < 2; ++i) {
        const int kr = 4 * (2 * wid + i) + (lane >> 4), kc = (lane & 15) ^ (kr & 15); koff[i] = (unsigned)(kr * 512 + kc * 8) * 2u;
        const int vd = 8 * (2 * wid + i) + (lane >> 3), vc = (lane & 7) ^ ((vd >> 1) & 7); voff[i] = (unsigned)(vd * MTOK + vc * 8) * 2u;
    }
    const int kx = r32 & 15, vx = (r32 >> 1) & 7;
    const unsigned lds0 = (unsigned)(size_t)lds;
#define ATT_DMA1(sbase, voff_, ldsdst) do { unsigned keep_; asm volatile("s_mov_b32 %0, m0\n\ts_mov_b32 m0, %3\n\ts_nop 0\n\tglobal_load_lds_dwordx4 %1, %2\n\ts_mov_b32 m0, %0" : "=&s"(keep_) : "v"(voff_), "s"(sbase), "s"(ldsdst) : "memory"); } while (0)
#define ATT_DMA(buf, kp, vp) do { _Pragma("unroll") for (int _i = 0; _i < 2; ++_i) { \
        ATT_DMA1((kp), koff[_i], lds0 + (unsigned)((buf) + (2 * wid + _i) * 1024)); \
        ATT_DMA1((vp), voff[_i], lds0 + (unsigned)((buf) + KBUF + (2 * wid + _i) * 1024)); } } while (0)
    for (int U = blockIdx.x; U < 2048; U += G) {
        const int rnd = U >> 8, cc = U & 255, x = cc & 7, jj = cc >> 3;
        int S, tok0, h, qb;
        if (rnd < 4) { const int pair = 4 * x + rnd; S = SEQS; tok0 = NPROMPT + (pair >> 2) * SEQS; h = pair & 3; qb = jj; }
        else { const int pair = 8 * x + 2 * (rnd - 4) + (jj >> 4); S = SEQP; tok0 = (pair >> 2) * SEQP; h = pair & 3; qb = jj & 15; }
        const bf16_t* Kg = k + (size_t)tok0 * 512 + h * 128;
        const bf16_t* Vg = vT + (size_t)(h * 128) * MTOK + tok0;
        const int NT = S / 64;
        const size_t qrow = (size_t)tok0 + qb * 256 + wid * 32 + r32;
        ATT_DMA(0, Kg, Vg);
        LAS unsigned char* Qs = lds + 2 * ABUF + wid * (32 * QROW) + r32 * QROW + hi * 16;
#pragma unroll
        for (int m = 0; m < 2; ++m)
#pragma unroll
            for (int d0 = 0; d0 < 4; ++d0) *(LAS bf16x8*)(Qs + m * 128 + d0 * 32) = *(const bf16x8*)(q + qrow * 512 + h * 128 + m * 64 + d0 * 16 + hi * 8);
        f32x16 o[2][4];
#pragma unroll
        for (int m = 0; m < 2; ++m)
#pragma unroll
            for (int db = 0; db < 4; ++db)
#pragma unroll
                for (int i = 0; i < 16; ++i) o[m][db][i] = 0.f;
        float mu[2] = {-1e30f, -1e30f}, l[2] = {0.f, 0.f};
        asm volatile("s_waitcnt vmcnt(0)" ::: "memory");
        __syncthreads();
        for (int t = 0; t < NT; ++t) {
            const int cb = (t & 1) * ABUF, nb = ((t + 1) & 1) * ABUF;
            if (t + 1 < NT) ATT_DMA(nb, Kg + (size_t)(t + 1) * 64 * 512, Vg + (t + 1) * 64);
            const LAS unsigned char* Kb = lds + cb + r32 * KROW;
            const LAS unsigned char* Vb = lds + cb + KBUF + r32 * VROW;
#pragma unroll
            for (int m = 0; m < 2; ++m) {
                f32x16 s0, s1;
#pragma unroll
                for (int i = 0; i < 16; ++i) { s0[i] = 0.f; s1[i] = 0.f; }
#pragma unroll
                for (int d0 = 0; d0 < 4; ++d0) {
                    const int kpos = ((m * 8 + d0 * 2 + hi) ^ kx) * 16;
                    const bf16x8 k0 = *(const LAS bf16x8*)(Kb + kpos), k1 = *(const LAS bf16x8*)(Kb + 32 * KROW + kpos);
                    const bf16x8 qv = *(const LAS bf16x8*)(Qs + m * 128 + d0 * 32);
                    s0 = MFMA32(k0, qv, s0); s1 = MFMA32(k1, qv, s1);
                    if (d0 == 1) __builtin_amdgcn_sched_barrier(0);
                }
                __builtin_amdgcn_sched_barrier(0);
                float mx = fmaxf(s0[0], s1[0]);
#pragma unroll
                for (int i = 1; i < 16; ++i) mx = fmaxf(mx, fmaxf(s0[i], s1[i]));
                mx = fmaxf(mx, __shfl_xor(mx, 32));
                const bool need = mx > mu[m] + 8.0f;
                if (__builtin_amdgcn_ballot_w64(need) != 0ull) {
                    const float nm = need ? mx : mu[m];
                    const float alpha = __builtin_amdgcn_exp2f(mu[m] - nm);
                    mu[m] = nm; l[m] *= alpha;
#pragma unroll
                    for (int db = 0; db < 4; ++db)
#pragma unroll
                        for (int i = 0; i < 16; ++i) o[m][db][i] *= alpha;
                }
                const float mm = mu[m];
                float ls = 0.f;
#pragma unroll
                for (int i = 0; i < 16; ++i) { s0[i] = __builtin_amdgcn_exp2f(s0[i] - mm); s1[i] = __builtin_amdgcn_exp2f(s1[i] - mm); ls += s0[i] + s1[i]; }
                l[m] += ls;
                const bf16x8 p0 = packp(s0, 0), p1 = packp(s0, 1), p2 = packp(s1, 0), p3 = packp(s1, 1);
                __builtin_amdgcn_sched_barrier(0);
#pragma unroll
                for (int db = 0; db < 4; ++db) {
                    const LAS unsigned char* vb = Vb + db * 32 * VROW;
                    const bf16x8 v0 = *(const LAS bf16x8*)(vb + ((0 + hi) ^ vx) * 16), v1 = *(const LAS bf16x8*)(vb + ((2 + hi) ^ vx) * 16), v2 = *(const LAS bf16x8*)(vb + ((4 + hi) ^ vx) * 16), v3 = *(const LAS bf16x8*)(vb + ((6 + hi) ^ vx) * 16);
                    o[m][db] = MFMA32(v0, p0, o[m][db]); o[m][db] = MFMA32(v1, p1, o[m][db]); o[m][db] = MFMA32(v2, p2, o[m][db]); o[m][db] = MFMA32(v3, p3, o[m][db]);
                    __builtin_amdgcn_sched_barrier(0);
                }
            }
            asm volatile("s_waitcnt vmcnt(0)" ::: "memory");
            __syncthreads();
        }
        const float l0 = l[0] + __shfl_xor(l[0], 32), l1 = l[1] + __shfl_xor(l[1], 32);
        const float c0 = 1.0f / l0, c1 = lam / l1;
        float ss = 0.f;
#pragma unroll
        for (int db = 0; db < 4; ++db)
#pragma unroll
            for (int i = 0; i < 16; ++i) { const float v = o[0][db][i] * c0 - o[1][db][i] * c1; o[0][db][i] = v; ss += v * v; }
        ss += __shfl_xor(ss, 32);
        const float rstd = rsqrtf(ss * (1.0f / 128.0f) + EPSV);
        bf16_t* orow = mixed + qrow * DM + h * 128 + 4 * hi;
#pragma unroll
        for (int db = 0; db < 4; ++db)
#pragma unroll
            for (int i4 = 0; i4 < 4; ++i4) {
                u32x2 w; w.x = cvt_pk_bf16(o[0][db][4 * i4] * rstd, o[0][db][4 * i4 + 1] * rstd); w.y = cvt_pk_bf16(o[0][db][4 * i4 + 2] * rstd, o[0][db][4 * i4 + 3] * rstd);
                *(u32x2*)(orow + 32 * db + 8 * i4) = w;
            }
    }
}


__device__ __forceinline__ void attn_phase_fast(LAS unsigned char* lds, const bf16_t* q, const bf16_t* k, const bf16_t* vT, bf16_t* mixed, float lam, const int wave_s) {
    int tid_ = wave_s * 64 + lane_id(); asm volatile("" : "+v"(tid_));
    const int wid = __builtin_amdgcn_readfirstlane(tid_ >> 6), G = gridDim.x;
    const unsigned lds0 = (unsigned)(size_t)lds;
    if (wid >= 4) __builtin_amdgcn_s_setprio(1);
    for (int U = blockIdx.x; U < 2048; U += G) {
        int lane_ = tid_ & 63; asm volatile("" : "+v"(lane_));
        const int lane = lane_, r32 = lane & 31, hi = lane >> 5;
        unsigned koff[2], voff[2];
#pragma unroll
        for (int i = 0; i < 2; ++i) {
            const int kr = 4 * (2 * wid + i) + (lane >> 4), kc = (lane & 15) ^ (kr & 15); koff[i] = (unsigned)(kr * 512 + kc * 8) * 2u;
            const int vd = 8 * (2 * wid + i) + (lane >> 3), vc = (lane & 7) ^ ((vd >> 1) & 7); voff[i] = (unsigned)(vd * MTOK + vc * 8) * 2u;
        }
        const int kx = r32 & 15, vx = (r32 >> 1) & 7;
        const int rnd = U >> 8, cc = U & 255, x = cc & 7, jj = cc >> 3;
        int S, tok0, h, qb;
        if (rnd < 4) { const int pair = 4 * x + rnd; S = SEQS; tok0 = NPROMPT + (pair >> 2) * SEQS; h = pair & 3; qb = jj; }
        else { const int pair = 8 * x + 2 * (rnd - 4) + (jj >> 4); S = SEQP; tok0 = (pair >> 2) * SEQP; h = pair & 3; qb = jj & 15; }
        const bf16_t* Kg = k + (size_t)tok0 * 512 + h * 128;
        const bf16_t* Vg = vT + (size_t)(h * 128) * MTOK + tok0;
        const int NT = S / 64;
        const size_t qrow = (size_t)tok0 + qb * 256 + wid * 32 + r32;
        ATT_DMA(0, Kg, Vg);
        LAS unsigned char* Qs = lds + 2 * ABUF + wid * (32 * QROW) + r32 * QROW + hi * 16;
#pragma unroll
        for (int m = 0; m < 2; ++m)
#pragma unroll
            for (int d0 = 0; d0 < 4; ++d0) *(LAS bf16x8*)(Qs + m * 128 + d0 * 32) = *(const bf16x8*)(q + qrow * 512 + h * 128 + m * 64 + d0 * 16 + hi * 8);
        f32x16 o[2][4];
#pragma unroll
        for (int m = 0; m < 2; ++m)
#pragma unroll
            for (int db = 0; db < 4; ++db)
#pragma unroll
                for (int i = 0; i < 16; ++i) o[m][db][i] = 0.f;
        float l[2] = {0.f, 0.f};
        asm volatile("s_waitcnt vmcnt(0)" ::: "memory");
        __syncthreads();
        for (int t = 0; t < NT; ++t) {
            const int cb = (t & 1) * ABUF, nb = ((t + 1) & 1) * ABUF;
            int ln = lane; asm volatile("" : "+v"(ln));
            const int r32 = ln & 31, hi = ln >> 5, kx = r32 & 15, vx = (r32 >> 1) & 7;
            if (t + 1 < NT) {
                unsigned koff[2], voff[2];
#pragma unroll
                for (int i = 0; i < 2; ++i) {
                    const int kr = 4 * (2 * wid + i) + (ln >> 4), kc = (ln & 15) ^ (kr & 15); koff[i] = (unsigned)(kr * 512 + kc * 8) * 2u;
                    const int vd = 8 * (2 * wid + i) + (ln >> 3), vc = (ln & 7) ^ ((vd >> 1) & 7); voff[i] = (unsigned)(vd * MTOK + vc * 8) * 2u;
                }
                ATT_DMA(nb, Kg + (size_t)(t + 1) * 64 * 512, Vg + (t + 1) * 64);
            }
            const LAS unsigned char* Qs = lds + 2 * ABUF + wid * (32 * QROW) + r32 * QROW + hi * 16;
            int kxh = (kx >> 1) << 5, vxh = (vx >> 1) << 5, kq = cb + r32 * KROW + ((hi ^ (kx & 1)) << 4), vq = cb + KBUF + r32 * VROW + ((hi ^ (vx & 1)) << 4);
            asm volatile("" : "+v"(kxh), "+v"(vxh), "+v"(kq), "+v"(vq));
            const LAS unsigned char* Kb = lds + kq;
            const LAS unsigned char* Vb = lds + vq;
#pragma unroll
            for (int m = 0; m < 2; ++m) {
                f32x16 s0, s1;
#pragma unroll
                for (int i = 0; i < 16; ++i) { s0[i] = 0.f; s1[i] = 0.f; }
#pragma unroll
                for (int d0 = 0; d0 < 4; ++d0) {
                    const int kpos = ((m * 4 + d0) << 5) ^ kxh;
                    const bf16x8 k0 = *(const LAS bf16x8*)(Kb + kpos), k1 = *(const LAS bf16x8*)(Kb + 32 * KROW + kpos);
                    const bf16x8 qv = *(const LAS bf16x8*)(Qs + m * 128 + d0 * 32);
                    s0 = MFMA32(k0, qv, s0); s1 = MFMA32(k1, qv, s1);
                    if (d0 == 1) __builtin_amdgcn_sched_barrier(0);
                }
                __builtin_amdgcn_sched_barrier(0);
                float ls = 0.f, ls2 = 0.f;
#pragma unroll
                for (int i = 0; i < 16; ++i) { float e0 = __builtin_amdgcn_exp2f(s0[i]), e1 = __builtin_amdgcn_exp2f(s1[i]); asm volatile("" : "+v"(e0), "+v"(e1)); s0[i] = e0; s1[i] = e1; ls += e0; ls2 += e1; }
                ls += ls2;
                l[m] += ls;
                const bf16x8 p0 = packp(s0, 0), p1 = packp(s0, 1), p2 = packp(s1, 0), p3 = packp(s1, 1);
                __builtin_amdgcn_sched_barrier(0);
#pragma unroll
                for (int db = 0; db < 4; ++db) {
                    const LAS unsigned char* vb = Vb + db * 32 * VROW;
                    const bf16x8 v0 = *(const LAS bf16x8*)(vb + (0 ^ vxh)), v1 = *(const LAS bf16x8*)(vb + (32 ^ vxh)), v2 = *(const LAS bf16x8*)(vb + (64 ^ vxh)), v3 = *(const LAS bf16x8*)(vb + (96 ^ vxh));
                    o[m][db] = MFMA32(v0, p0, o[m][db]); o[m][db] = MFMA32(v1, p1, o[m][db]); o[m][db] = MFMA32(v2, p2, o[m][db]); o[m][db] = MFMA32(v3, p3, o[m][db]);
                    __builtin_amdgcn_sched_barrier(0);
                }
            }
            asm volatile("s_waitcnt vmcnt(0)" ::: "memory");
            __syncthreads();
        }
        const float l0 = l[0] + __shfl_xor(l[0], 32), l1 = l[1] + __shfl_xor(l[1], 32);
        const float c0 = 1.0f / l0, c1 = lam / l1;
        float ss = 0.f;
#pragma unroll
        for (int db = 0; db < 4; ++db)
#pragma unroll
            for (int i = 0; i < 16; ++i) { const float v = o[0][db][i] * c0 - o[1][db][i] * c1; o[0][db][i] = v; ss += v * v; }
        ss += __shfl_xor(ss, 32);
        const float rstd = rsqrtf(ss * (1.0f / 128.0f) + EPSV);
        int lane2 = lane_id(); asm volatile("" : "+v"(lane2));
        bf16_t* orow = mixed + ((size_t)tok0 + qb * 256 + wid * 32 + (lane2 & 31)) * DM + h * 128 + 4 * (lane2 >> 5);
#pragma unroll
        for (int db = 0; db < 4; ++db)
#pragma unroll
            for (int i4 = 0; i4 < 4; ++i4) {
                u32x2 w; w.x = cvt_pk_bf16(o[0][db][4 * i4] * rstd, o[0][db][4 * i4 + 1] * rstd); w.y = cvt_pk_bf16(o[0][db][4 * i4 + 2] * rstd, o[0][db][4 * i4 + 3] * rstd);
                *(u32x2*)(orow + 32 * db + 8 * i4) = w;
            }
    }
    __builtin_amdgcn_s_setprio(0);
}


__global__ void __launch_bounds__(512) fwd_megakernel(Params p) {
    extern __shared__ __attribute__((aligned(16))) unsigned char lds_raw[];
    LAS unsigned char* lds = (LAS unsigned char*)lds_raw;
    cg::grid_group grid = cg::this_grid();
    unsigned char* ws = p.ws;
    const int G = gridDim.x, c = blockIdx.x;
    const int wave_s = __builtin_amdgcn_readfirstlane((int)threadIdx.x >> 6);
    bf16_t* WQKP = (bf16_t*)(ws + WS_WQKP); bf16_t* WV = (bf16_t*)(ws + WS_WV); bf16_t* WOUT = (bf16_t*)(ws + WS_WOUT); bf16_t* WUP = (bf16_t*)(ws + WS_WUP); bf16_t* WDN = (bf16_t*)(ws + WS_WDN);
    float* cosT = (float*)(ws + WS_COS); float* sinT = (float*)(ws + WS_SIN); float* rss = (float*)(ws + WS_RSS);
    bf16_t* Q = (bf16_t*)(ws + WS_Q); bf16_t* Kt = (bf16_t*)(ws + WS_K); bf16_t* VT = (bf16_t*)(ws + WS_VT); bf16_t* ZP = (bf16_t*)(ws + WS_ZP);
    bf16_t* H = (bf16_t*)(ws + WS_H); bf16_t* MIX = H; bf16_t* XB = (bf16_t*)(ws + WS_XB); bf16_t* ACT = (bf16_t*)(ws + WS_ACT);

#ifndef SKIP_P0
    p0_prologue(p, lds, wave_s);
#endif
    grid.sync();
#ifndef SKIP_P1
    {
        pg8::Gemm g{H, WQKP, MTOK, 1536, DM}; pg8::StaticOrder S; S.init(MTOK, 1536, G, c);
        EpiQKP E{ws, (const float*)(ws + WS_QKG), cosT, sinT};
        pg8::gemm_phase<EpiQKP, pg8::StaticOrder, true, true>(lds, g, S, E, wave_s);
    }
    {
        pg8::Gemm g{WV, H, 512, MTOK, DM}; pg8::StaticOrder S; S.init(512, MTOK, G, c);
        EpiVT E{VT};
        pg8::gemm_phase<EpiVT, pg8::StaticOrder, true, true>(lds, g, S, E, wave_s);
    }
#endif
    grid.sync();
#ifndef SKIP_P2
    pool_phase(ZP, MIX, wave_s);
    {
        float d1 = 0.f, d2 = 0.f;
        for (int i = 0; i < 64; ++i) { d1 += p.in[I_LQ1][i] * p.in[I_LK1][i]; d2 += p.in[I_LQ2][i] * p.in[I_LK2][i]; }
        const float lam = __builtin_bit_cast(float, __builtin_amdgcn_readfirstlane(__builtin_bit_cast(int, __expf(d1) - __expf(d2) + 0.2f)));
        float gq = 0.f, gk = 0.f;
        for (int i = 0; i < 64; ++i) { gq = fmaxf(gq, fabsf(p.in[I_QG][i])); gk = fmaxf(gk, fabsf(p.in[I_KG][i])); }
        const float bound = 64.0f * QSCALE * gq * gk;
        if (bound < 100.0f) attn_phase_fast(lds, Q, Kt, VT, MIX, lam, wave_s);
        else attn_phase_online(lds, Q, Kt, VT, MIX, lam, wave_s);
    }
#endif
    grid.sync();
#ifndef SKIP_P3
    {
        pg8::Gemm g{MIX, WOUT, MTOK, DM, DM}; pg8::StaticOrder S; S.init(MTOK, DM, G, c);
        EpiRes1 E{p.in[I_XP], p.in[I_XS], XB, rss};
        pg8::gemm_phase<EpiRes1, pg8::StaticOrder, true, true>(lds, g, S, E, wave_s);
    }
#endif
    grid.sync();
#ifndef SKIP_P4
    {
        pg8::Gemm g{XB, WUP, MTOK, 2 * DFF, DM}; pg8::StaticOrder S; S.init_tiles(517, 22, G, c, 1);
        EpiConvGate E{rss, p.in[I_CONVW], p.in[I_CONVB], ACT, (LAS float*)(lds + LDS_STAGE)};
        pg8::gemm_phase<EpiConvGate, pg8::StaticOrder, true, true>(lds, g, S, E, wave_s);
    }
#endif
    grid.sync();
#ifndef SKIP_P5
    {
        pg8::Gemm g{ACT, WDN, MTOK, DM, DFF}; pg8::StaticOrder S; S.init(MTOK, DM, G, c);
        EpiRes2 E{XB, p.out};
        pg8::gemm_phase<EpiRes2, pg8::StaticOrder, true, true>(lds, g, S, E, wave_s);
    }
#endif
}

extern "C" void kernel_launch(void* const* d_in, const int* in_sizes, int n_in, void* d_out, int out_size, void* d_ws, size_t ws_size, hipStream_t stream) {
    static int grid_blocks = 0;
    if (grid_blocks == 0) {
        if (n_in != 19 || ws_size < WS_END) { fprintf(stderr, "kernel_launch: unexpected n_in %d / ws_size %zu (need %zu)\n", n_in, ws_size, (size_t)WS_END); grid_blocks = -1; return; }
        int dev = 0, cus = 0, per_cu = 0;
        (void)hipGetDevice(&dev);
        (void)hipDeviceGetAttribute(&cus, hipDeviceAttributeMultiprocessorCount, dev);
        if (hipFuncSetAttribute((const void*)fwd_megakernel, hipFuncAttributeMaxDynamicSharedMemorySize, LDS_TOTAL) != hipSuccess) { fprintf(stderr, "kernel_launch: hipFuncSetAttribute failed\n"); grid_blocks = -1; return; }
        if (hipOccupancyMaxActiveBlocksPerMultiprocessor(&per_cu, (const void*)fwd_megakernel, 512, LDS_TOTAL) != hipSuccess || per_cu < 1) { fprintf(stderr, "kernel_launch: occupancy query failed (%d)\n", per_cu); (void)hipGetLastError(); per_cu = 1; }
        grid_blocks = cus * per_cu;
    }
    if (grid_blocks < 0) return;
    Params p{};
    for (int i = 0; i < 19; ++i) p.in[i] = (const float*)d_in[i];
    p.out = (float*)d_out; p.ws = (unsigned char*)d_ws;
    void* args[] = {&p};
    hipError_t e = hipLaunchCooperativeKernel((const void*)fwd_megakernel, dim3(grid_blocks), dim3(512), args, LDS_TOTAL, stream);
    if (e != hipSuccess) fprintf(stderr, "cooperative launch failed: %s (grid %d)\n", hipGetErrorString(e), grid_blocks);
}
```

```cpp
#include <hip/hip_runtime.h>
#include <hip/hip_cooperative_groups.h>
#include <cstdio>
#include <cstdint>
namespace cg = cooperative_groups;

namespace pg8 {
#define PG8_LAS __attribute__((address_space(3)))
typedef unsigned short bf16_t;
typedef short bf16x8 __attribute__((ext_vector_type(8)));
typedef float f32x4 __attribute__((ext_vector_type(4)));
typedef unsigned u32x4 __attribute__((ext_vector_type(4)));
constexpr int BM = 256, BK = 64, HALF = 128, HTB = HALF * BK * 2  , STAGE_BYTES = 8 * HTB, NXCD = 8, WGM = 8;

__host__ __device__ __forceinline__ int lds_byte(int r, int c) { const int st = (r >> 4) * 2 + (c >> 5), rr = r & 15, cc = c & 31, ob = rr * 64 + cc * 2; return st * 1024 + (ob ^ (((ob >> 9) & 1) << 5)); }
__host__ __device__ __forceinline__ void stage_rc(int b, int& R, int& C) { const int st = b / 1024, sb = b % 1024, swz = sb ^ (((sb >> 9) & 1) << 5); R = (st >> 1) * 16 + swz / 64; C = (st & 1) * 32 + (swz % 64) / 2; }
__host__ __device__ __forceinline__ int perm32(int rho) { const int n = rho >> 4, i = rho & 15; return 8 * (i >> 2) + 4 * n + (i & 3); }

struct Unit { int pm, pn; };
struct Gemm { const bf16_t* A; const bf16_t* Bt; int M, N, K; };

struct StaticOrder {
    int nM, nN, nwg, G, c; int halo;
    __host__ __device__ void init_tiles(int nM_, int nN_, int G_, int c_, int halo_) { nM = nM_; nN = nN_; nwg = nM * nN; G = G_; c = c_; halo = halo_; }
    __device__ __forceinline__ long a_off(int pm, int K) const { return halo ? ((long)254 * pm - 1) * (long)K * 2 : (long)pm * 256 * (long)K * 2; }
    __host__ __device__ void init(int M, int N, int G_, int c_) { nM = M / BM; nN = N / BM; nwg = nM * nN; G = G_; c = c_; halo = 0; }
    __host__ __device__ bool next(int i, Unit& u) const {
        const long L = (long)i * G + c; if (L >= nwg) return false;
        int wgid = (int)L; { const int q = nwg / NXCD, r = nwg % NXCD, xcd = wgid % NXCD, off = wgid / NXCD; wgid = (xcd < r ? xcd * (q + 1) : r * (q + 1) + (xcd - r) * q) + off; }
        const int nig = WGM * nN, gid = wgid / nig, fm = gid * WGM, gsz = (nM - fm) < WGM ? (nM - fm) : WGM;
        u.pm = fm + ((wgid % nig) % gsz); u.pn = (wgid % nig) / gsz; return true;
    }
    __device__ __forceinline__ void a_ready(const Unit&) const {}
    __device__ __forceinline__ void done(const Unit&) const {}
};
__device__ __forceinline__ unsigned cvt_pk_bf16(float lo, float hi) { unsigned r; asm volatile("v_cvt_pk_bf16_f32 %0, %1, %2" : "=v"(r) : "v"(lo), "v"(hi)); return r; }
typedef float f32x2 __attribute__((ext_vector_type(2)));
typedef float f32x2 __attribute__((ext_vector_type(2)));
template <class Epi, class Sched, bool ALIGN_EPI = false, bool SP2 = false>
__device__ __forceinline__ void gemm_phase(PG8_LAS unsigned char* lds, const Gemm g, const Sched& S, const Epi& E, const int wave_s) {
    int tid_; asm volatile("v_mbcnt_lo_u32_b32 %0, -1, 0\n\tv_mbcnt_hi_u32_b32 %0, -1, %0" : "=v"(tid_)); tid_ += wave_s * 64;
    const int tid = tid_, wid = __builtin_amdgcn_readfirstlane(tid >> 6), lane = tid & 63, wr = wid >> 2, wc = wid & 3, fr = lane & 15, fq = lane >> 4;
    const int K = g.K, nt = K / BK;
    unsigned voffA[2], voffB[2];
#pragma unroll
    for (int i = 0; i < 2; ++i) { int R, C; stage_rc(tid * 16 + i * 8192, R, C); const int Rb = Epi::PERM ? ((R & ~31) + perm32(R & 31)) : R;
        voffA[i] = (unsigned)(R * K + C) * 2u; voffB[i] = (unsigned)(Rb * K + C) * 2u; }
    const size_t kstep = (size_t)(BK * 2);
    const size_t hstep = (size_t)HALF * K * 2;
    const size_t tstep = 2 * hstep;
    const unsigned ldsw = (unsigned)wid * 1024u;
    const int aoff = lds_byte(wr * 64 + fr, fq * 8), boff = lds_byte(wc * 32 + fr, fq * 8);
#define PG8_SA(b, h) (((b) * 2 + (h)) * HTB)
#define PG8_SB(b, h) ((4 + (b) * 2 + (h)) * HTB)
#define PG8_STAGE(bufoff, gbase, voff) do { _Pragma("unroll") for (int _i = 0; _i < 2; ++_i) \
        __builtin_amdgcn_global_load_lds((const unsigned*)((const char*)(gbase) + (voff)[_i]), (PG8_LAS unsigned*)(lds + (bufoff) + ldsw + _i * 8192), 16, 0, 0); } while (0)
#define PG8_LDA(dst, b, h) do { _Pragma("unroll") for (int m = 0; m < 4; ++m) _Pragma("unroll") for (int k = 0; k < 2; ++k) dst[m][k] = *(const PG8_LAS bf16x8*)(lds + PG8_SA(b, h) + aoff + m * 2048 + k * 1024); } while (0)
#define PG8_LDB(dst, b, h) do { _Pragma("unroll") for (int n = 0; n < 2; ++n) _Pragma("unroll") for (int k = 0; k < 2; ++k) dst[n][k] = *(const PG8_LAS bf16x8*)(lds + PG8_SB(b, h) + boff + n * 2048 + k * 1024); } while (0)
#define PG8_MMA(ai, bj, At, Bt) do { __builtin_amdgcn_s_setprio(1); _Pragma("unroll") for (int m = 0; m < 4; ++m) _Pragma("unroll") for (int n = 0; n < 2; ++n) _Pragma("unroll") for (int k = 0; k < 2; ++k) \
        acc[ai][bj][m][n] = __builtin_amdgcn_mfma_f32_16x16x32_bf16(Bt[n][k], At[m][k], acc[ai][bj][m][n], 0, 0, 0); __builtin_amdgcn_s_setprio(0); } while (0)
#define PG8_WAIT_V(n) asm volatile("s_waitcnt vmcnt(" #n ")" ::: "memory")
#define PG8_WAIT_L(n) asm volatile("s_waitcnt lgkmcnt(" #n ")" ::: "memory")
#define PG8_BAR __builtin_amdgcn_s_barrier()
#define PG8_SCHED __builtin_amdgcn_sched_barrier(0)
    Unit cur, nxt; int ui = 0;
    if (!S.next(0, cur)) return;
    f32x4 acc[2][2][4][2];
#pragma unroll
    for (int a = 0; a < 2; ++a)
#pragma unroll
        for (int b = 0; b < 2; ++b)
#pragma unroll
            for (int m = 0; m < 4; ++m)
#pragma unroll
                for (int n = 0; n < 2; ++n) acc[a][b][m][n] = (f32x4){0.f, 0.f, 0.f, 0.f};
    bf16x8 At[4][2], B0[2][2], B1[2][2];
    const char* cA = (const char*)g.A + S.a_off(cur.pm, K); const char* cB = (const char*)g.Bt + (size_t)cur.pn * tstep;
    S.a_ready(cur);
    if constexpr (SP2) {
        PG8_STAGE(PG8_SB(0, 0), cB, voffB); PG8_STAGE(PG8_SB(0, 1), cB + hstep, voffB); PG8_STAGE(PG8_SA(0, 0), cA, voffA); PG8_STAGE(PG8_SA(0, 1), cA + hstep, voffA);
        if (wr == 1) PG8_BAR;
        PG8_WAIT_V(2); PG8_BAR;
        PG8_STAGE(PG8_SB(1, 0), cB + kstep, voffB); PG8_STAGE(PG8_SA(1, 0), cA + kstep, voffA); PG8_STAGE(PG8_SB(1, 1), cB + hstep + kstep, voffB);
        PG8_WAIT_V(6); PG8_BAR;
    } else {
        PG8_STAGE(PG8_SB(0, 0), cB, voffB); PG8_STAGE(PG8_SA(0, 0), cA, voffA); PG8_STAGE(PG8_SB(0, 1), cB + hstep, voffB); PG8_STAGE(PG8_SA(0, 1), cA + hstep, voffA);
        if (wr == 1) PG8_BAR;
        PG8_WAIT_V(4); PG8_BAR;
        PG8_STAGE(PG8_SB(1, 0), cB + kstep, voffB); PG8_STAGE(PG8_SA(1, 0), cA + kstep, voffA); PG8_STAGE(PG8_SB(1, 1), cB + hstep + kstep, voffB);
        PG8_WAIT_V(6); PG8_BAR;
    }
    for (;;) {
        const bool has_next = S.next(ui + 1, nxt);
        const char* nA = has_next ? (const char*)g.A + S.a_off(nxt.pm, K) : cA; const char* nB = has_next ? (const char*)g.Bt + (size_t)nxt.pn * tstep : cB;
        for (int t = 0; t < nt; t += 2) {
            const bool last = (t == nt - 2);
            const char* a1 = cA + (size_t)(t + 1) * kstep;
            const char* a2 = last ? nA : cA + (size_t)(t + 2) * kstep; const char* b2 = last ? nB : cB + (size_t)(t + 2) * kstep;
            const char* a3 = a2 + kstep; const char* b3 = b2 + kstep;
            if (last && has_next) S.a_ready(nxt);
            if constexpr (SP2) {
            PG8_LDB(B0, 0, 0); PG8_LDB(B1, 0, 1); PG8_SCHED; PG8_LDA(At, 0, 0); PG8_STAGE(PG8_SA(1, 1), a1 + hstep, voffA);
            PG8_WAIT_V(8); PG8_WAIT_L(0); PG8_BAR; PG8_MMA(0, 0, At, B0); PG8_MMA(0, 1, At, B1); PG8_BAR; PG8_SCHED;
            PG8_LDA(At, 0, 1); PG8_STAGE(PG8_SB(0, 0), b2, voffB); PG8_STAGE(PG8_SB(0, 1), b2 + hstep, voffB); PG8_STAGE(PG8_SA(0, 0), a2, voffA);
            PG8_WAIT_V(8); PG8_WAIT_L(0); PG8_BAR; PG8_MMA(1, 0, At, B0); PG8_MMA(1, 1, At, B1); PG8_BAR; PG8_SCHED;
            PG8_LDB(B0, 1, 0); PG8_LDB(B1, 1, 1); PG8_SCHED; PG8_LDA(At, 1, 0); PG8_STAGE(PG8_SA(0, 1), a2 + hstep, voffA);
            PG8_WAIT_V(8); PG8_WAIT_L(0); PG8_BAR; PG8_MMA(0, 0, At, B0); PG8_MMA(0, 1, At, B1); PG8_BAR; PG8_SCHED;
            PG8_LDA(At, 1, 1); PG8_STAGE(PG8_SB(1, 0), b3, voffB); PG8_STAGE(PG8_SB(1, 1), b3 + hstep, voffB); PG8_STAGE(PG8_SA(1, 0), a3, voffA);
            PG8_WAIT_V(8); PG8_WAIT_L(0); PG8_BAR; PG8_MMA(1, 0, At, B0); PG8_MMA(1, 1, At, B1); PG8_BAR; PG8_SCHED;
            } else {
            PG8_LDB(B0, 0, 0); PG8_SCHED; PG8_LDA(At, 0, 0); PG8_STAGE(PG8_SA(1, 1), a1 + hstep, voffA);
            PG8_WAIT_L(8); PG8_BAR; PG8_WAIT_L(0); PG8_MMA(0, 0, At, B0); PG8_BAR; PG8_SCHED;
            PG8_LDB(B1, 0, 1); PG8_STAGE(PG8_SB(0, 0), b2, voffB);
            PG8_BAR; PG8_WAIT_L(0); PG8_MMA(0, 1, At, B1); PG8_BAR;
            PG8_LDA(At, 0, 1); PG8_STAGE(PG8_SA(0, 0), a2, voffA);
            PG8_BAR; PG8_WAIT_L(0); PG8_MMA(1, 0, At, B0); PG8_BAR; PG8_SCHED;
            PG8_STAGE(PG8_SB(0, 1), b2 + hstep, voffB);
            PG8_WAIT_V(6); PG8_BAR; PG8_MMA(1, 1, At, B1); PG8_BAR;
            PG8_LDB(B0, 1, 0); PG8_SCHED; PG8_LDA(At, 1, 0); PG8_STAGE(PG8_SA(0, 1), a2 + hstep, voffA);
            PG8_WAIT_L(8); PG8_BAR; PG8_WAIT_L(0); PG8_MMA(0, 0, At, B0); PG8_BAR; PG8_SCHED;
            PG8_LDB(B1, 1, 1); PG8_STAGE(PG8_SB(1, 0), b3, voffB);
            PG8_BAR; PG8_WAIT_L(0); PG8_MMA(0, 1, At, B1); PG8_BAR;
            PG8_LDA(At, 1, 1); PG8_STAGE(PG8_SA(1, 0), a3, voffA);
            PG8_BAR; PG8_WAIT_L(0); PG8_MMA(1, 0, At, B0); PG8_BAR; PG8_SCHED;
            PG8_STAGE(PG8_SB(1, 1), b3 + hstep, voffB);
            PG8_WAIT_V(6); PG8_BAR; PG8_MMA(1, 1, At, B1); PG8_BAR;
            }
        }
        if constexpr (ALIGN_EPI) { if (wr == 0) PG8_BAR; }
        if constexpr (!Epi::AFTER_DRAIN) { E(acc, cur, wr, wc, fr, fq); S.done(cur); }
        if (!has_next) break;
#pragma unroll
        for (int a = 0; a < 2; ++a)
#pragma unroll
            for (int b = 0; b < 2; ++b)
#pragma unroll
                for (int m = 0; m < 4; ++m)
#pragma unroll
                    for (int n = 0; n < 2; ++n) acc[a][b][m][n] = (f32x4){0.f, 0.f, 0.f, 0.f};
        cur = nxt; cA = nA; cB = nB; ++ui;
        if constexpr (ALIGN_EPI) { if (wr == 1) PG8_BAR; }
    }
    PG8_WAIT_V(0);
    if constexpr (!ALIGN_EPI) { if (wr == 0) PG8_BAR; }
    PG8_BAR;
    if constexpr (Epi::AFTER_DRAIN) { E.fused(acc, cur, wr, wc, fr, fq, lds, wid, lane); S.done(cur); }
#undef PG8_SA
#undef PG8_SB
#undef PG8_STAGE
#undef PG8_LDA
#undef PG8_LDB
#undef PG8_MMA
#undef PG8_WAIT_V
#undef PG8_WAIT_L
#undef PG8_BAR
#undef PG8_SCHED
}
}

using pg8::bf16_t; using pg8::bf16x8; using pg8::f32x4; using pg8::u32x4; using pg8::Unit; using pg8::cvt_pk_bf16;
#define LAS __attribute__((address_space(3)))
typedef float f32x16 __attribute__((ext_vector_type(16)));
typedef unsigned u32x2 __attribute__((ext_vector_type(2)));
constexpr int DM = 1024, MTOK = 131072, NPROMPT = 65536, SEQP = 4096, SEQS = 8192, DFF = 2816;
constexpr float EPSV = 1e-6f;
constexpr float QSCALE = 0.125f * 1.4426950408889634f;
constexpr size_t MiB = 1024 * 1024;
constexpr size_t WS_WQKP = 0, WS_WV = 3 * MiB, WS_WOUT = 4 * MiB, WS_WUP = 6 * MiB, WS_WDN = 17 * MiB, WS_COS = 23 * MiB, WS_SIN = 24 * MiB, WS_RSS = 25 * MiB, WS_QKG = 25 * MiB + 768 * 1024,
                 WS_XB = 26 * MiB, WS_Q = WS_XB, WS_K = WS_XB + 128 * MiB, WS_ACT = 282 * MiB, WS_VT = WS_ACT, WS_ZP = WS_ACT + 128 * MiB, WS_H = WS_ACT + 256 * MiB,
                 WS_END = WS_ACT + 704 * MiB;
constexpr int LDS_STAGE = 131072, LDS_EDGE = 8192, LDS_TOTAL = 147456;

struct Params {
    const float* in[19];
    float* out;
    unsigned char* ws;
};
enum { I_XP = 0, I_XS, I_N1G, I_WIN, I_QG, I_KG, I_LQ1, I_LK1, I_LQ2, I_LK2, I_SUBG, I_WPOOL, I_PSCALE, I_WOUT, I_N2G, I_WUP, I_CONVW, I_CONVB, I_WDOWN };

__device__ __forceinline__ int lane_id() { int l; asm volatile("v_mbcnt_lo_u32_b32 %0, -1, 0\n\tv_mbcnt_hi_u32_b32 %0, -1, %0" : "=v"(l)); return l; }
__device__ __forceinline__ bf16_t f2bf(float x) { unsigned u = __float_as_uint(x); u += 0x7fffu + ((u >> 16) & 1u); return (bf16_t)(u >> 16); }
__device__ __forceinline__ float bf2f(unsigned short b) { return __uint_as_float(((unsigned)b) << 16); }
__device__ __forceinline__ float bflo(unsigned w) { return __uint_as_float(w << 16); }
__device__ __forceinline__ float bfhi(unsigned w) { return __uint_as_float(w & 0xffff0000u); }
__device__ __forceinline__ u32x4 pack8(f32x4 a, f32x4 b) { u32x4 w; w.x = cvt_pk_bf16(a[0], a[1]); w.y = cvt_pk_bf16(a[2], a[3]); w.z = cvt_pk_bf16(b[0], b[1]); w.w = cvt_pk_bf16(b[2], b[3]); return w; }
__device__ __forceinline__ u32x2 pack4(f32x4 a) { u32x2 w; w.x = cvt_pk_bf16(a[0], a[1]); w.y = cvt_pk_bf16(a[2], a[3]); return w; }

struct EpiQKP {
    static constexpr bool PERM = true, AFTER_DRAIN = false;
    unsigned char* ws; const float *qkg  , *cosT, *sinT;
    __device__ __forceinline__ void operator()(f32x4 (&acc)[2][2][4][2], const Unit& u, int wr, int wc, int fr, int fq) const {
        const int kind = u.pn >> 1;
        bf16_t* base = (bf16_t*)(ws + (kind == 0 ? WS_Q : (kind == 1 ? WS_K : WS_ZP)));
        const int colbase = (u.pn & 1) * 256 + wc * 64, i0 = 8 * fq;
        if (kind < 2) {
            const float* g = qkg + kind * 64;
            const float osc = kind == 0 ? QSCALE : 1.0f;
            const f32x4 g00 = *(const f32x4*)(g + i0), g01 = *(const f32x4*)(g + i0 + 4), g10 = *(const f32x4*)(g + 32 + i0), g11 = *(const f32x4*)(g + 32 + i0 + 4);
#pragma unroll
            for (int ai = 0; ai < 2; ++ai)
#pragma unroll
                for (int m = 0; m < 4; ++m) {
                    const int row = u.pm * 256 + ai * 128 + wr * 64 + m * 16 + fr;
                    const int pos = row < NPROMPT ? (row & (SEQP - 1)) : (row & (SEQS - 1));
                    const f32x4 a00 = acc[ai][0][m][0], a01 = acc[ai][0][m][1], a10 = acc[ai][1][m][0], a11 = acc[ai][1][m][1];
                    f32x4 sq = a00 * a00 + a01 * a01 + a10 * a10 + a11 * a11;
                    float ss = (sq[0] + sq[1]) + (sq[2] + sq[3]);
                    ss += __shfl_xor(ss, 16); ss += __shfl_xor(ss, 32);
                    const float rstd = rsqrtf(ss * (1.0f / 64.0f) + EPSV) * osc;
                    const f32x4 cs0 = *(const f32x4*)(cosT + pos * 32 + i0), sn0 = *(const f32x4*)(sinT + pos * 32 + i0);
                    const f32x4 cs1 = *(const f32x4*)(cosT + pos * 32 + i0 + 4), sn1 = *(const f32x4*)(sinT + pos * 32 + i0 + 4);
                    const f32x4 y00 = a00 * rstd * g00, y01 = a01 * rstd * g01, y10 = a10 * rstd * g10, y11 = a11 * rstd * g11;
                    bf16_t* rp = base + (size_t)row * 512 + colbase + i0;
                    *(u32x4*)(rp) = pack8(y00 * cs0 - y10 * sn0, y01 * cs1 - y11 * sn1);
                    *(u32x4*)(rp + 32) = pack8(y10 * cs0 + y00 * sn0, y11 * cs1 + y01 * sn1);
                    asm volatile("" ::: "memory");
                }
        } else {
#pragma unroll
            for (int ai = 0; ai < 2; ++ai)
#pragma unroll
                for (int m = 0; m < 4; ++m) {
                    const int row = u.pm * 256 + ai * 128 + wr * 64 + m * 16 + fr;
                    bf16_t* rp = base + (size_t)row * 512 + colbase + i0;
#pragma unroll
                    for (int bj = 0; bj < 2; ++bj) *(u32x4*)(rp + 32 * bj) = pack8(acc[ai][bj][m][0], acc[ai][bj][m][1]);
                }
        }
    }
};
struct EpiVT {
    static constexpr bool PERM = true, AFTER_DRAIN = false;
    bf16_t* vT;
    __device__ __forceinline__ void operator()(f32x4 (&acc)[2][2][4][2], const Unit& u, int wr, int wc, int fr, int fq) const {
#pragma unroll
        for (int ai = 0; ai < 2; ++ai)
#pragma unroll
            for (int m = 0; m < 4; ++m) {
                const int row = u.pm * 256 + ai * 128 + wr * 64 + m * 16 + fr;
                bf16_t* rp = vT + (size_t)row * MTOK + (size_t)u.pn * 256 + wc * 32 + 16 * (fq >> 1) + 4 * (fq & 1);
#pragma unroll
                for (int bj = 0; bj < 2; ++bj)
#pragma unroll
                    for (int n = 0; n < 2; ++n) *(u32x2*)(rp + 128 * bj + 8 * n) = pack4(acc[ai][bj][m][n]);
            }
    }
};
struct EpiRes1 {
    static constexpr bool PERM = true, AFTER_DRAIN = false;
    const float *xp, *xs; bf16_t* xb; float* rss;
    __device__ __forceinline__ void operator()(f32x4 (&acc)[2][2][4][2], const Unit& u, int wr, int wc, int fr, int fq) const {
        const int col0 = u.pn * 256 + wc * 32 + 8 * fq;
#pragma unroll
        for (int ai = 0; ai < 2; ++ai)
#pragma unroll
            for (int m = 0; m < 4; ++m) {
                const int row = u.pm * 256 + ai * 128 + wr * 64 + m * 16 + fr;
                const float* xr = (row < NPROMPT ? xp + (size_t)row * DM : xs + (size_t)(row - NPROMPT) * DM) + col0;
                bf16_t* brow = xb + (size_t)row * DM + col0;
                float ss = 0.f;
#pragma unroll
                for (int bj = 0; bj < 2; ++bj) {
                    const f32x4 a = acc[ai][bj][m][0] + *(const f32x4*)(xr + 128 * bj), b = acc[ai][bj][m][1] + *(const f32x4*)(xr + 128 * bj + 4);
                    *(u32x4*)(brow + 128 * bj) = pack8(a, b);
                    ss += (a[0] * a[0] + a[1] * a[1]) + (a[2] * a[2] + a[3] * a[3]) + (b[0] * b[0] + b[1] * b[1]) + (b[2] * b[2] + b[3] * b[3]);
                }
                ss += __shfl_xor(ss, 16); ss += __shfl_xor(ss, 32);
                if (fq == 0) atomicAdd(rss + row, ss);
                asm volatile("" ::: "memory");
            }
    }
};
struct EpiRes2 {
    static constexpr bool PERM = true, AFTER_DRAIN = false;
    const bf16_t* xb; float* out;
    __device__ __forceinline__ void operator()(f32x4 (&acc)[2][2][4][2], const Unit& u, int wr, int wc, int fr, int fq) const {
        const int col0 = u.pn * 256 + wc * 32 + 8 * fq;
#pragma unroll
        for (int ai = 0; ai < 2; ++ai)
#pragma unroll
            for (int m = 0; m < 4; ++m) {
                const int row = u.pm * 256 + ai * 128 + wr * 64 + m * 16 + fr;
                float* orow = out + (size_t)row * DM + col0; const bf16_t* brow = xb + (size_t)row * DM + col0;
#pragma unroll
                for (int bj = 0; bj < 2; ++bj) {
                    const u32x4 w = *(const u32x4*)(brow + 128 * bj);
                    const f32x4 a = acc[ai][bj][m][0] + (f32x4){bflo(w.x), bfhi(w.x), bflo(w.y), bfhi(w.y)}, b = acc[ai][bj][m][1] + (f32x4){bflo(w.z), bfhi(w.z), bflo(w.w), bfhi(w.w)};
                    *(f32x4*)(orow + 128 * bj) = a; *(f32x4*)(orow + 128 * bj + 4) = b;
                }
                asm volatile("" ::: "memory");
            }
    }
};
__device__ __forceinline__ float dpp_ror1(float v) { return __builtin_bit_cast(float, __builtin_amdgcn_update_dpp(0, __builtin_bit_cast(int, v), 0x121, 0xf, 0xf, false)); }
__device__ __forceinline__ float dpp_ror15(float v) { return __builtin_bit_cast(float, __builtin_amdgcn_update_dpp(0, __builtin_bit_cast(int, v), 0x12F, 0xf, 0xf, false)); }
struct EpiConvGate {
    static constexpr bool PERM = true, AFTER_DRAIN = false;
    const float *rss, *convw, *convb; bf16_t* act; LAS float* edge;
    template <bool BND> __device__ __forceinline__ void conv_gate(f32x4 (&acc)[2][2][4][2], const Unit& u, int wr, int wc, int fr, int fq, int tok0, int pcol) const {
        const int fcol = u.pn * 128 + pcol;
#pragma unroll
        for (int n = 0; n < 2; ++n) {
            f32x4 w0[2], w1[2], w2[2], bb[2];
#pragma unroll
            for (int bj = 0; bj < 2; ++bj) { const int c = bj * DFF + fcol + 4 * n;
                w0[bj] = *(const f32x4*)(convw + c); w1[bj] = *(const f32x4*)(convw + 2 * DFF + c); w2[bj] = *(const f32x4*)(convw + 4 * DFF + c); bb[bj] = *(const f32x4*)(convb + c); }
#pragma unroll
            for (int ai = 0; ai < 2; ++ai) {
                const int blk = 2 * ai + wr;
                f32x4 pe[2], ne[2];
#pragma unroll
                for (int bj = 0; bj < 2; ++bj) {
                    pe[bj] = blk > 0 ? *(const LAS f32x4*)(edge + ((blk - 1) * 2 + 1) * 256 + 128 * bj + pcol + 4 * n) : (f32x4){0.f, 0.f, 0.f, 0.f};
                    ne[bj] = blk < 3 ? *(const LAS f32x4*)(edge + ((blk + 1) * 2 + 0) * 256 + 128 * bj + pcol + 4 * n) : (f32x4){0.f, 0.f, 0.f, 0.f};
                }
#pragma unroll
                for (int m = 0; m < 4; ++m) {
                    const int r = ai * 128 + wr * 64 + m * 16 + fr, tok = tok0 + r;
                    bool isfirst = false, islast = false;
                    if (BND) { const int S1 = (tok < NPROMPT ? SEQP : SEQS) - 1, pos = tok & S1; isfirst = pos == 0; islast = pos == S1; }
                    f32x4 cv[2];
#pragma unroll
                    for (int bj = 0; bj < 2; ++bj) {
                        const f32x4 cur = acc[ai][bj][m][n];
                        const f32x4 ups = m > 0 ? acc[ai][bj][m > 0 ? m - 1 : 0][n] : pe[bj];
                        const f32x4 dns = m < 3 ? acc[ai][bj][m < 3 ? m + 1 : 3][n] : ne[bj];
                        f32x4 prev, next;
#pragma unroll
                        for (int j = 0; j < 4; ++j) {
                            const float t1 = fr == 15 ? ups[j] : cur[j]; float pv = dpp_ror1(t1);
                            const float t2 = fr == 0 ? dns[j] : cur[j]; float nx = dpp_ror15(t2);
                            if (BND) { prev[j] = isfirst ? 0.f : pv; next[j] = islast ? 0.f : nx; } else { prev[j] = pv; next[j] = nx; }
                        }
                        cv[bj] = w0[bj] * prev + w1[bj] * cur + w2[bj] * next + bb[bj];
                    }
                    f32x4 a;
#pragma unroll
                    for (int j = 0; j < 4; ++j) { const float g = cv[0][j]; const float sg = __builtin_amdgcn_rcpf(1.0f + __builtin_amdgcn_exp2f(-1.4426950408889634f * g)); a[j] = g * sg * cv[1][j]; }
                    if (r >= 1 && r <= 254 && (!BND || tok < MTOK)) *(u32x2*)(act + (size_t)tok * DFF + fcol + 4 * n) = pack4(a);
                    asm volatile("" ::: "memory");
                }
            }
        }
    }
    __device__ __forceinline__ void operator()(f32x4 (&acc)[2][2][4][2], const Unit& u, int wr, int wc, int fr, int fq) const {
        asm volatile("" : "+v"(fr), "+v"(fq));
        const int tok0 = 254 * u.pm - 1;
        const int pcol = wc * 32 + 8 * fq;
        const bool bnd = (tok0 < 0) || (((tok0 & (SEQP - 1)) + 256) >= SEQP) || (tok0 + 256 > MTOK);
#pragma unroll
        for (int ai = 0; ai < 2; ++ai)
#pragma unroll
            for (int m = 0; m < 4; ++m) {
                const int tok = tok0 + ai * 128 + wr * 64 + m * 16 + fr;
                if (bnd) {
                    const bool valid = (tok >= 0) && (tok < MTOK);
                    float rs = 0.f; if (valid) rs = rsqrtf(rss[tok] * (1.0f / 1024.0f) + EPSV);
#pragma unroll
                    for (int bj = 0; bj < 2; ++bj)
#pragma unroll
                        for (int n = 0; n < 2; ++n) { f32x4 x = acc[ai][bj][m][n] * rs;
#pragma unroll
                            for (int j = 0; j < 4; ++j) x[j] = valid ? x[j] : 0.f;
                            acc[ai][bj][m][n] = x; }
                } else {
                    const float rs = rsqrtf(rss[tok] * (1.0f / 1024.0f) + EPSV);
#pragma unroll
                    for (int bj = 0; bj < 2; ++bj)
#pragma unroll
                        for (int n = 0; n < 2; ++n) acc[ai][bj][m][n] = acc[ai][bj][m][n] * rs;
                }
            }
#pragma unroll
        for (int ai = 0; ai < 2; ++ai) {
            const int blk = 2 * ai + wr;
            if (fr == 0) {
#pragma unroll
                for (int bj = 0; bj < 2; ++bj)
#pragma unroll
                    for (int n = 0; n < 2; ++n) *(LAS f32x4*)(edge + (blk * 2 + 0) * 256 + 128 * bj + pcol + 4 * n) = acc[ai][bj][0][n];
            }
            if (fr == 15) {
#pragma unroll
                for (int bj = 0; bj < 2; ++bj)
#pragma unroll
                    for (int n = 0; n < 2; ++n) *(LAS f32x4*)(edge + (blk * 2 + 1) * 256 + 128 * bj + pcol + 4 * n) = acc[ai][bj][3][n];
            }
        }
        asm volatile("s_waitcnt lgkmcnt(0)\n\ts_barrier" ::: "memory");
        if (bnd) conv_gate<true>(acc, u, wr, wc, fr, fq, tok0, pcol); else conv_gate<false>(acc, u, wr, wc, fr, fq, tok0, pcol);
    }
};

__device__ __forceinline__ void p0_prologue(const Params& p, LAS unsigned char* lds, const int wave_s) {
    int tid_ = wave_s * 64 + lane_id(); asm volatile("" : "+v"(tid_));
    const int tid = tid_, G = gridDim.x, gt = blockIdx.x * 512 + tid, GT = G * 512, lane = tid & 63, wid = tid >> 6;
    unsigned char* ws = p.ws;
    bf16_t* WQKP = (bf16_t*)(ws + WS_WQKP); bf16_t* WV = (bf16_t*)(ws + WS_WV); bf16_t* WOUT = (bf16_t*)(ws + WS_WOUT); bf16_t* WUP = (bf16_t*)(ws + WS_WUP); bf16_t* WDN = (bf16_t*)(ws + WS_WDN);
    LAS float* tile = (LAS float*)lds;
    for (int t = blockIdx.x; t < 2752; t += G) {
        const float* src; int ld, k0, n0, kind;
        if (t < 512) { kind = 0; k0 = (t >> 5) * 64; n0 = (t & 31) * 64; src = p.in[I_WIN]; ld = 2048; }
        else if (t < 640) { const int u = t - 512; kind = 1; k0 = (u >> 4) * 64; n0 = (u & 15) * 64; src = p.in[I_WOUT]; ld = 1024; }
        else if (t < 2048) { const int u = t - 640; kind = 2; k0 = (u / 88) * 64; n0 = (u % 88) * 64; src = p.in[I_WUP]; ld = 5632; }
        else { const int u = t - 2048; kind = 3; k0 = (u >> 4) * 64; n0 = (u & 15) * 64; src = p.in[I_WDOWN]; ld = 1024; }
#pragma unroll
        for (int i = 0; i < 8; ++i) { const int e = tid + i * 512, kk = e >> 6, nn = e & 63;
            float v = src[(size_t)(k0 + kk) * ld + n0 + nn];
            if (kind == 1) v *= p.in[I_SUBG][(k0 + kk) & 127] * 0.8f;
            if (kind == 2) v *= p.in[I_N2G][k0 + kk];
            tile[kk * 65 + nn] = v; }
        __syncthreads();
#pragma unroll
        for (int i = 0; i < 8; ++i) { const int e = tid + i * 512, nn = e >> 6, kk = e & 63, n = n0 + nn; bf16_t* dst;
            if (kind == 0) {
                if (n < 1024 || n >= 1536) { const int L = n < 1024 ? n : n - 512; const int prow = (L & ~255) + ((L >> 5) & 1) * 128 + ((L >> 6) & 3) * 32 + (L & 31); dst = WQKP + (size_t)prow * 1024 + k0 + kk; }
                else dst = WV + (size_t)(n - 1024) * 1024 + k0 + kk;
            } else if (kind == 1) dst = WOUT + (size_t)n * 1024 + k0 + kk;
            else if (kind == 2) { const int f = n < DFF ? n : n - DFF; const int prow = (f >> 7) * 256 + (n < DFF ? 0 : 128) + (f & 127); dst = WUP + (size_t)prow * 1024 + k0 + kk; }
            else dst = WDN + (size_t)n * DFF + k0 + kk;
            *dst = f2bf(tile[kk * 65 + nn]); }
        __syncthreads();
    }
    for (int o = gt; o < 128 * 1024; o += GT) {
        const int n = o & 1023, c = o >> 10;
        const float* wo = p.in[I_WOUT] + (size_t)512 * 1024 + n;
        float a0 = 0.f, a1 = 0.f, a2 = 0.f, a3 = 0.f;
        const float* wp = p.in[I_WPOOL] + (size_t)c * 128; const float* ps = p.in[I_PSCALE];
#pragma unroll 8
        for (int e = 0; e < 128; ++e) {
            a0 += wp[e] * ps[e] * wo[(size_t)e * 1024];
            a1 += wp[16384 + e] * ps[128 + e] * wo[(size_t)(128 + e) * 1024];
            a2 += wp[32768 + e] * ps[256 + e] * wo[(size_t)(256 + e) * 1024];
            a3 += wp[49152 + e] * ps[384 + e] * wo[(size_t)(384 + e) * 1024];
        }
        bf16_t* dst = WOUT + (size_t)n * 1024 + 512 + c;
        dst[0] = f2bf(a0); dst[128] = f2bf(a1); dst[256] = f2bf(a2); dst[384] = f2bf(a3);
    }
    float* cosT = (float*)(ws + WS_COS); float* sinT = (float*)(ws + WS_SIN);
    for (int o = gt; o < 8192 * 32; o += GT) {
        const int s = o >> 5, i = o & 31;
        const float inv = exp2f(-(float)i * (13.287712379549449f / 32.0f));
        const float ang = (float)s * inv;
        const double rev = (double)ang * 0.15915494309189535; const float fr = (float)(rev - __builtin_rint(rev));
        cosT[o] = __builtin_amdgcn_cosf(fr); sinT[o] = __builtin_amdgcn_sinf(fr);
    }
    float* rss = (float*)(ws + WS_RSS);
    for (int o = gt; o < MTOK; o += GT) rss[o] = 0.f;
    if (gt < 128) ((float*)(ws + WS_QKG))[gt] = gt < 64 ? p.in[I_QG][gt] : p.in[I_KG][gt - 64];
    bf16_t* H = (bf16_t*)(ws + WS_H);
    f32x4 g1[4];
#pragma unroll
    for (int i = 0; i < 4; ++i) g1[i] = *(const f32x4*)(p.in[I_N1G] + lane * 4 + 256 * i);
    for (int row = blockIdx.x * 8 + wid; row < MTOK; row += G * 8) {
        const float* xr = (row < NPROMPT ? p.in[I_XP] + (size_t)row * DM : p.in[I_XS] + (size_t)(row - NPROMPT) * DM) + lane * 4;
        f32x4 v[4]; float ss = 0.f;
#pragma unroll
        for (int i = 0; i < 4; ++i) { v[i] = *(const f32x4*)(xr + 256 * i); ss += (v[i][0] * v[i][0] + v[i][1] * v[i][1]) + (v[i][2] * v[i][2] + v[i][3] * v[i][3]); }
#pragma unroll
        for (int o = 1; o < 64; o <<= 1) ss += __shfl_xor(ss, o);
        const float rstd = rsqrtf(ss * (1.0f / 1024.0f) + EPSV);
        bf16_t* hr = H + (size_t)row * DM + lane * 4;
#pragma unroll
        for (int i = 0; i < 4; ++i) *(u32x2*)(hr + 256 * i) = pack4(v[i] * rstd * g1[i]);
    }
}

__device__ __forceinline__ void pool_phase(const bf16_t* zp, bf16_t* mixed, const int wave_s) {
    const int GT = gridDim.x * 512; int tid_ = wave_s * 64 + lane_id(); asm volatile("" : "+v"(tid_));
    for (int item = blockIdx.x * 512 + tid_; item < MTOK * 64; item += GT) {
        const int tok = item >> 6, ch = item & 63, c0 = ch * 8, g = ch >> 4, half = 1 << g;
        const int S = tok < NPROMPT ? SEQP : SEQS, pos = tok & (S - 1), base = tok - pos;
        const int lo = max(pos - half, 0), hi = min(pos + half - 1, S - 1);
        float s[8];
#pragma unroll
        for (int j = 0; j < 8; ++j) s[j] = 0.f;
        for (int r = lo; r <= hi; ++r) {
            const u32x4 w = *(const u32x4*)(zp + (size_t)(base + r) * 512 + c0);
            s[0] += bflo(w.x); s[1] += bfhi(w.x); s[2] += bflo(w.y); s[3] += bfhi(w.y); s[4] += bflo(w.z); s[5] += bfhi(w.z); s[6] += bflo(w.w); s[7] += bfhi(w.w);
        }
        const u32x4 w = *(const u32x4*)(zp + (size_t)tok * 512 + c0);
        const float ic = 1.0f / (float)(hi - lo + 1);
        u32x4 o;
        o.x = cvt_pk_bf16(s[0] * ic - bflo(w.x), s[1] * ic - bfhi(w.x)); o.y = cvt_pk_bf16(s[2] * ic - bflo(w.y), s[3] * ic - bfhi(w.y));
        o.z = cvt_pk_bf16(s[4] * ic - bflo(w.z), s[5] * ic - bfhi(w.z)); o.w = cvt_pk_bf16(s[6] * ic - bflo(w.w), s[7] * ic - bfhi(w.w));
        *(u32x4*)(mixed + (size_t)tok * DM + 512 + c0) = o;
    }
}

#define MFMA32(a, b, c) __builtin_amdgcn_mfma_f32_32x32x16_bf16((a), (b), (c), 0, 0, 0)
constexpr int KROW = 256, VROW = 128, KBUF = 64 * KROW, VBUF = 128 * VROW, ABUF = KBUF + VBUF, QROW = 272;
__device__ __forceinline__ bf16x8 packp(const f32x16& x, int s) {
    u32x4 w;
    w.x = cvt_pk_bf16(x[8 * s + 0], x[8 * s + 1]); w.y = cvt_pk_bf16(x[8 * s + 2], x[8 * s + 3]); w.z = cvt_pk_bf16(x[8 * s + 4], x[8 * s + 5]); w.w = cvt_pk_bf16(x[8 * s + 6], x[8 * s + 7]);
    return __builtin_bit_cast(bf16x8, w);
}
__device__ __forceinline__ void attn_phase_online(LAS unsigned char* lds, const bf16_t* q, const bf16_t* k, const bf16_t* vT, bf16_t* mixed, float lam, const int wave_s) {
    int tid_ = wave_s * 64 + lane_id(); asm volatile("" : "+v"(tid_));
    const int tid = tid_, lane = tid & 63, r32 = lane & 31, hi = lane >> 5, wid = __builtin_amdgcn_readfirstlane(tid >> 6), G = gridDim.x;
    unsigned koff[2], voff[2];
#pragma unroll
    for (int i = 0; i < 2; ++i) {
        const int kr = 4 * (2 * wid + i) + (lane >> 4), kc = (lane & 15) ^ (kr & 15); koff[i] = (unsigned)(kr * 512 + kc * 8) * 2u;
        const int vd = 8 * (2 * wid + i) + (lane >> 3), vc = (lane & 7) ^ ((vd >> 1) & 7); voff[i] = (unsigned)(vd * MTOK + vc * 8) * 2u;
    }
    const int kx = r32 & 15, vx = (r32 >> 1) & 7;
    const unsigned lds0 = (unsigned)(size_t)lds;
#define ATT_DMA1(sbase, voff_, ldsdst) do { unsigned keep_; asm volatile("s_mov_b32 %0, m0\n\ts_mov_b32 m0, %3\n\ts_nop 0\n\tglobal_load_lds_dwordx4 %1, %2\n\ts_mov_b32 m0, %0" : "=&s"(keep_) : "v"(voff_), "s"(sbase), "s"(ldsdst) : "memory"); } while (0)
#define ATT_DMA(buf, kp, vp) do { _Pragma("unroll") for (int _i = 0; _i < 2; ++_i) { \
        ATT_DMA1((kp), koff[_i], lds0 + (unsigned)((buf) + (2 * wid + _i) * 1024)); \
        ATT_DMA1((vp), voff[_i], lds0 + (unsigned)((buf) + KBUF + (2 * wid + _i) * 1024)); } } while (0)
    for (int U = blockIdx.x; U < 2048; U += G) {
        const int rnd = U >> 8, cc = U & 255, x = cc & 7, jj = cc >> 3;
        int S, tok0, h, qb;
        if (rnd < 4) { const int pair = 4 * x + rnd; S = SEQS; tok0 = NPROMPT + (pair >> 2) * SEQS; h = pair & 3; qb = jj; }
        else { const int pair = 8 * x + 2 * (rnd - 4) + (jj >> 4); S = SEQP; tok0 = (pair >> 2) * SEQP; h = pair & 3; qb = jj & 15; }
        const bf16_t* Kg = k + (size_t)tok0 * 512 + h * 128;
        const bf16_t* Vg = vT + (size_t)(h * 128) * MTOK + tok0;
        const int NT = S / 64;
        const size_t qrow = (size_t)tok0 + qb * 256 + wid * 32 + r32;
        ATT_DMA(0, Kg, Vg);
        LAS unsigned char* Qs = lds + 2 * ABUF + wid * (32 * QROW) + r32 * QROW + hi * 16;
#pragma unroll
        for (int m = 0; m < 2; ++m)
#pragma unroll
            for (int d0 = 0; d0 < 4; ++d0) *(LAS bf16x8*)(Qs + m * 128 + d0 * 32) = *(const bf16x8*)(q + qrow * 512 + h * 128 + m * 64 + d0 * 16 + hi * 8);
        f32x16 o[2][4];
#pragma unroll
        for (int m = 0; m < 2; ++m)
#pragma unroll
            for (int db = 0; db < 4; ++db)
#pragma unroll
                for (int i = 0; i < 16; ++i) o[m][db][i] = 0.f;
        float mu[2] = {-1e30f, -1e30f}, l[2] = {0.f, 0.f};
        asm volatile("s_waitcnt vmcnt(0)" ::: "memory");
        __syncthreads();
        for (int t = 0; t < NT; ++t) {
            const int cb = (t & 1) * ABUF, nb = ((t + 1) & 1) * ABUF;
            if (t + 1 < NT) ATT_DMA(nb, Kg + (size_t)(t + 1) * 64 * 512, Vg + (t + 1) * 64);
            const LAS unsigned char* Kb = lds + cb + r32 * KROW;
            const LAS unsigned char* Vb = lds + cb + KBUF + r32 * VROW;
#pragma unroll
            for (int m = 0; m < 2; ++m) {
                f32x16 s0, s1;
#pragma unroll
                for (int i = 0; i < 16; ++i) { s0[i] = 0.f; s1[i] = 0.f; }
#pragma unroll
                for (int d0 = 0; d0 < 4; ++d0) {
                    const int kpos = ((m * 8 + d0 * 2 + hi) ^ kx) * 16;
                    const bf16x8 k0 = *(const LAS bf16x8*)(Kb + kpos), k1 = *(const LAS bf16x8*)(Kb + 32 * KROW + kpos);
                    const bf16x8 qv = *(const LAS bf16x8*)(Qs + m * 128 + d0 * 32);
                    s0 = MFMA32(k0, qv, s0); s1 = MFMA32(k1, qv, s1);
                    if (d0 == 1) __builtin_amdgcn_sched_barrier(0);
                }
                __builtin_amdgcn_sched_barrier(0);
                float mx = fmaxf(s0[0], s1[0]);
#pragma unroll
                for (int i = 1; i < 16; ++i) mx = fmaxf(mx, fmaxf(s0[i], s1[i]));
                mx = fmaxf(mx, __shfl_xor(mx, 32));
                const bool need = mx > mu[m] + 8.0f;
                if (__builtin_amdgcn_ballot_w64(need) != 0ull) {
                    const float nm = need ? mx : mu[m];
                    const float alpha = __builtin_amdgcn_exp2f(mu[m] - nm);
                    mu[m] = nm; l[m] *= alpha;
#pragma unroll
                    for (int db = 0; db < 4; ++db)
#pragma unroll
                        for (int i = 0; i < 16; ++i) o[m][db][i] *= alpha;
                }
                const float mm = mu[m];
                float ls = 0.f;
#pragma unroll
                for (int i = 0; i < 16; ++i) { s0[i] = __builtin_amdgcn_exp2f(s0[i] - mm); s1[i] = __builtin_amdgcn_exp2f(s1[i] - mm); ls += s0[i] + s1[i]; }
                l[m] += ls;
                const bf16x8 p0 = packp(s0, 0), p1 = packp(s0, 1), p2 = packp(s1, 0), p3 = packp(s1, 1);
                __builtin_amdgcn_sched_barrier(0);
#pragma unroll
                for (int db = 0; db < 4; ++db) {
                    const LAS unsigned char* vb = Vb + db * 32 * VROW;
                    const bf16x8 v0 = *(const LAS bf16x8*)(vb + ((0 + hi) ^ vx) * 16), v1 = *(const LAS bf16x8*)(vb + ((2 + hi) ^ vx) * 16), v2 = *(const LAS bf16x8*)(vb + ((4 + hi) ^ vx) * 16), v3 = *(const LAS bf16x8*)(vb + ((6 + hi) ^ vx) * 16);
                    o[m][db] = MFMA32(v0, p0, o[m][db]); o[m][db] = MFMA32(v1, p1, o[m][db]); o[m][db] = MFMA32(v2, p2, o[m][db]); o[m][db] = MFMA32(v3, p3, o[m][db]);
                    __builtin_amdgcn_sched_barrier(0);
                }
            }
            asm volatile("s_waitcnt vmcnt(0)" ::: "memory");
            __syncthreads();
        }
        const float l0 = l[0] + __shfl_xor(l[0], 32), l1 = l[1] + __shfl_xor(l[1], 32);
        const float c0 = 1.0f / l0, c1 = lam / l1;
        float ss = 0.f;
#pragma unroll
        for (int db = 0; db < 4; ++db)
#pragma unroll
            for (int i = 0; i < 16; ++i) { const float v = o[0][db][i] * c0 - o[1][db][i] * c1; o[0][db][i] = v; ss += v * v; }
        ss += __shfl_xor(ss, 32);
        const float rstd = rsqrtf(ss * (1.0f / 128.0f) + EPSV);
        bf16_t* orow = mixed + qrow * DM + h * 128 + 4 * hi;
#pragma unroll
        for (int db = 0; db < 4; ++db)
#pragma unroll
            for (int i4 = 0; i4 < 4; ++i4) {
                u32x2 w; w.x = cvt_pk_bf16(o[0][db][4 * i4] * rstd, o[0][db][4 * i4 + 1] * rstd); w.y = cvt_pk_bf16(o[0][db][4 * i4 + 2] * rstd, o[0][db][4 * i4 + 3] * rstd);
                *(u32x2*)(orow + 32 * db + 8 * i4) = w;
            }
    }
}


__device__ __forceinline__ void attn_phase_fast(LAS unsigned char* lds, const bf16_t* q, const bf16_t* k, const bf16_t* vT, bf16_t* mixed, float lam, const int wave_s) {
    int tid_ = wave_s * 64 + lane_id(); asm volatile("" : "+v"(tid_));
    const int wid = __builtin_amdgcn_readfirstlane(tid_ >> 6), G = gridDim.x;
    const unsigned lds0 = (unsigned)(size_t)lds;
    if (wid >= 4) __builtin_amdgcn_s_setprio(1);
    for (int U = blockIdx.x; U < 2048; U += G) {
        int lane_ = tid_ & 63; asm volatile("" : "+v"(lane_));
        const int lane = lane_, r32 = lane & 31, hi = lane >> 5;
        unsigned koff[2], voff[2];
#pragma unroll
        for (int i = 0; i < 2; ++i) {
            const int kr = 4 * (2 * wid + i) + (lane >> 4), kc = (lane & 15) ^ (kr & 15); koff[i] = (unsigned)(kr * 512 + kc * 8) * 2u;
            const int vd = 8 * (2 * wid + i) + (lane >> 3), vc = (lane & 7) ^ ((vd >> 1) & 7); voff[i] = (unsigned)(vd * MTOK + vc * 8) * 2u;
        }
        const int kx = r32 & 15, vx = (r32 >> 1) & 7;
        const int rnd = U >> 8, cc = U & 255, x = cc & 7, jj = cc >> 3;
        int S, tok0, h, qb;
        if (rnd < 4) { const int pair = 4 * x + rnd; S = SEQS; tok0 = NPROMPT + (pair >> 2) * SEQS; h = pair & 3; qb = jj; }
        else { const int pair = 8 * x + 2 * (rnd - 4) + (jj >> 4); S = SEQP; tok0 = (pair >> 2) * SEQP; h = pair & 3; qb = jj & 15; }
        const bf16_t* Kg = k + (size_t)tok0 * 512 + h * 128;
        const bf16_t* Vg = vT + (size_t)(h * 128) * MTOK + tok0;
        const int NT = S / 64;
        const size_t qrow = (size_t)tok0 + qb * 256 + wid * 32 + r32;
        ATT_DMA(0, Kg, Vg);
        LAS unsigned char* Qs = lds + 2 * ABUF + wid * (32 * QROW) + r32 * QROW + hi * 16;
#pragma unroll
        for (int m = 0; m < 2; ++m)
#pragma unroll
            for (int d0 = 0; d0 < 4; ++d0) *(LAS bf16x8*)(Qs + m * 128 + d0 * 32) = *(const bf16x8*)(q + qrow * 512 + h * 128 + m * 64 + d0 * 16 + hi * 8);
        f32x16 o[2][4];
#pragma unroll
        for (int m = 0; m < 2; ++m)
#pragma unroll
            for (int db = 0; db < 4; ++db)
#pragma unroll
                for (int i = 0; i < 16; ++i) o[m][db][i] = 0.f;
        float l[2] = {0.f, 0.f};
        asm volatile("s_waitcnt vmcnt(0)" ::: "memory");
        __syncthreads();
        for (int t = 0; t < NT; ++t) {
            const int cb = (t & 1) * ABUF, nb = ((t + 1) & 1) * ABUF;
            int ln = lane; asm volatile("" : "+v"(ln));
            const int r32 = ln & 31, hi = ln >> 5, kx = r32 & 15, vx = (r32 >> 1) & 7;
            if (t + 1 < NT) {
                unsigned koff[2], voff[2];
#pragma unroll
                for (int i = 0; i < 2; ++i) {
                    const int kr = 4 * (2 * wid + i) + (ln >> 4), kc = (ln & 15) ^ (kr & 15); koff[i] = (unsigned)(kr * 512 + kc * 8) * 2u;
                    const int vd = 8 * (2 * wid + i) + (ln >> 3), vc = (ln & 7) ^ ((vd >> 1) & 7); voff[i] = (unsigned)(vd * MTOK + vc * 8) * 2u;
                }
                ATT_DMA(nb, Kg + (size_t)(t + 1) * 64 * 512, Vg + (t + 1) * 64);
            }
            const LAS unsigned char* Qs = lds + 2 * ABUF + wid * (32 * QROW) + r32 * QROW + hi * 16;
            int kxh = (kx >> 1) << 5, vxh = (vx >> 1) << 5, kq = cb + r32 * KROW + ((hi ^ (kx & 1)) << 4), vq = cb + KBUF + r32 * VROW + ((hi ^ (vx & 1)) << 4);
            asm volatile("" : "+v"(kxh), "+v"(vxh), "+v"(kq), "+v"(vq));
            const LAS unsigned char* Kb = lds + kq;
            const LAS unsigned char* Vb = lds + vq;
#pragma unroll
            for (int m = 0; m < 2; ++m) {
                f32x16 s0, s1;
#pragma unroll
                for (int i = 0; i < 16; ++i) { s0[i] = 0.f; s1[i] = 0.f; }
#pragma unroll
                for (int d0 = 0; d0 < 4; ++d0) {
                    const int kpos = ((m * 4 + d0) << 5) ^ kxh;
                    const bf16x8 k0 = *(const LAS bf16x8*)(Kb + kpos), k1 = *(const LAS bf16x8*)(Kb + 32 * KROW + kpos);
                    const bf16x8 qv = *(const LAS bf16x8*)(Qs + m * 128 + d0 * 32);
                    s0 = MFMA32(k0, qv, s0); s1 = MFMA32(k1, qv, s1);
                    if (d0 == 1) __builtin_amdgcn_sched_barrier(0);
                }
                __builtin_amdgcn_sched_barrier(0);
                float ls = 0.f, ls2 = 0.f;
#pragma unroll
                for (int i = 0; i < 16; ++i) { float e0 = __builtin_amdgcn_exp2f(s0[i]), e1 = __builtin_amdgcn_exp2f(s1[i]); asm volatile("" : "+v"(e0), "+v"(e1)); s0[i] = e0; s1[i] = e1; ls += e0; ls2 += e1; }
                ls += ls2;
                l[m] += ls;
                const bf16x8 p0 = packp(s0, 0), p1 = packp(s0, 1), p2 = packp(s1, 0), p3 = packp(s1, 1);
                __builtin_amdgcn_sched_barrier(0);
#pragma unroll
                for (int db = 0; db < 4; ++db) {
                    const LAS unsigned char* vb = Vb + db * 32 * VROW;
                    const bf16x8 v0 = *(const LAS bf16x8*)(vb + (0 ^ vxh)), v1 = *(const LAS bf16x8*)(vb + (32 ^ vxh)), v2 = *(const LAS bf16x8*)(vb + (64 ^ vxh)), v3 = *(const LAS bf16x8*)(vb + (96 ^ vxh));
                    o[m][db] = MFMA32(v0, p0, o[m][db]); o[m][db] = MFMA32(v1, p1, o[m][db]); o[m][db] = MFMA32(v2, p2, o[m][db]); o[m][db] = MFMA32(v3, p3, o[m][db]);
                    __builtin_amdgcn_sched_barrier(0);
                }
            }
            asm volatile("s_waitcnt vmcnt(0)" ::: "memory");
            __syncthreads();
        }
        const float l0 = l[0] + __shfl_xor(l[0], 32), l1 = l[1] + __shfl_xor(l[1], 32);
        const float c0 = 1.0f / l0, c1 = lam / l1;
        float ss = 0.f;
#pragma unroll
        for (int db = 0; db < 4; ++db)
#pragma unroll
            for (int i = 0; i < 16; ++i) { const float v = o[0][db][i] * c0 - o[1][db][i] * c1; o[0][db][i] = v; ss += v * v; }
        ss += __shfl_xor(ss, 32);
        const float rstd = rsqrtf(ss * (1.0f / 128.0f) + EPSV);
        int lane2 = lane_id(); asm volatile("" : "+v"(lane2));
        bf16_t* orow = mixed + ((size_t)tok0 + qb * 256 + wid * 32 + (lane2 & 31)) * DM + h * 128 + 4 * (lane2 >> 5);
#pragma unroll
        for (int db = 0; db < 4; ++db)
#pragma unroll
            for (int i4 = 0; i4 < 4; ++i4) {
                u32x2 w; w.x = cvt_pk_bf16(o[0][db][4 * i4] * rstd, o[0][db][4 * i4 + 1] * rstd); w.y = cvt_pk_bf16(o[0][db][4 * i4 + 2] * rstd, o[0][db][4 * i4 + 3] * rstd);
                *(u32x2*)(orow + 32 * db + 8 * i4) = w;
            }
    }
    __builtin_amdgcn_s_setprio(0);
}


__global__ void __launch_bounds__(512) fwd_megakernel(Params p) {
    extern __shared__ __attribute__((aligned(16))) unsigned char lds_raw[];
    LAS unsigned char* lds = (LAS unsigned char*)lds_raw;
    cg::grid_group grid = cg::this_grid();
    unsigned char* ws = p.ws;
    const int G = gridDim.x, c = blockIdx.x;
    const int wave_s = __builtin_amdgcn_readfirstlane((int)threadIdx.x >> 6);
    bf16_t* WQKP = (bf16_t*)(ws + WS_WQKP); bf16_t* WV = (bf16_t*)(ws + WS_WV); bf16_t* WOUT = (bf16_t*)(ws + WS_WOUT); bf16_t* WUP = (bf16_t*)(ws + WS_WUP); bf16_t* WDN = (bf16_t*)(ws + WS_WDN);
    float* cosT = (float*)(ws + WS_COS); float* sinT = (float*)(ws + WS_SIN); float* rss = (float*)(ws + WS_RSS);
    bf16_t* Q = (bf16_t*)(ws + WS_Q); bf16_t* Kt = (bf16_t*)(ws + WS_K); bf16_t* VT = (bf16_t*)(ws + WS_VT); bf16_t* ZP = (bf16_t*)(ws + WS_ZP);
    bf16_t* H = (bf16_t*)(ws + WS_H); bf16_t* MIX = H; bf16_t* XB = (bf16_t*)(ws + WS_XB); bf16_t* ACT = (bf16_t*)(ws + WS_ACT);

#ifndef SKIP_P0
    p0_prologue(p, lds, wave_s);
#endif
    grid.sync();
#ifndef SKIP_P1
    {
        pg8::Gemm g{H, WQKP, MTOK, 1536, DM}; pg8::StaticOrder S; S.init(MTOK, 1536, G, c);
        EpiQKP E{ws, (const float*)(ws + WS_QKG), cosT, sinT};
        pg8::gemm_phase<EpiQKP, pg8::StaticOrder, true, true>(lds, g, S, E, wave_s);
    }
    {
        pg8::Gemm g{WV, H, 512, MTOK, DM}; pg8::StaticOrder S; S.init(512, MTOK, G, c);
        EpiVT E{VT};
        pg8::gemm_phase<EpiVT, pg8::StaticOrder, true, true>(lds, g, S, E, wave_s);
    }
#endif
    grid.sync();
#ifndef SKIP_P2
    pool_phase(ZP, MIX, wave_s);
    {
        float d1 = 0.f, d2 = 0.f;
        for (int i = 0; i < 64; ++i) { d1 += p.in[I_LQ1][i] * p.in[I_LK1][i]; d2 += p.in[I_LQ2][i] * p.in[I_LK2][i]; }
        const float lam = __builtin_bit_cast(float, __builtin_amdgcn_readfirstlane(__builtin_bit_cast(int, __expf(d1) - __expf(d2) + 0.2f)));
        float gq = 0.f, gk = 0.f;
        for (int i = 0; i < 64; ++i) { gq = fmaxf(gq, fabsf(p.in[I_QG][i])); gk = fmaxf(gk, fabsf(p.in[I_KG][i])); }
        const float bound = 64.0f * QSCALE * gq * gk;
        if (bound < 100.0f) attn_phase_fast(lds, Q, Kt, VT, MIX, lam, wave_s);
        else attn_phase_online(lds, Q, Kt, VT, MIX, lam, wave_s);
    }
#endif
    grid.sync();
#ifndef SKIP_P3
    {
        pg8::Gemm g{MIX, WOUT, MTOK, DM, DM}; pg8::StaticOrder S; S.init(MTOK, DM, G, c);
        EpiRes1 E{p.in[I_XP], p.in[I_XS], XB, rss};
        pg8::gemm_phase<EpiRes1, pg8::StaticOrder, true, true>(lds, g, S, E, wave_s);
    }
#endif
    grid.sync();
#ifndef SKIP_P4
    {
        pg8::Gemm g{XB, WUP, MTOK, 2 * DFF, DM}; pg8::StaticOrder S; S.init_tiles(517, 22, G, c, 1);
        EpiConvGate E{rss, p.in[I_CONVW], p.in[I_CONVB], ACT, (LAS float*)(lds + LDS_STAGE)};
        pg8::gemm_phase<EpiConvGate, pg8::StaticOrder, true, true>(lds, g, S, E, wave_s);
    }
#endif
    grid.sync();
#ifndef SKIP_P5
    {
        pg8::Gemm g{ACT, WDN, MTOK, DM, DFF}; pg8::StaticOrder S; S.init(MTOK, DM, G, c);
        EpiRes2 E{XB, p.out};
        pg8::gemm_phase<EpiRes2, pg8::StaticOrder, true, true>(lds, g, S, E, wave_s);
    }
#endif
}

extern "C" void kernel_launch(void* const* d_in, const int* in_sizes, int n_in, void* d_out, int out_size, void* d_ws, size_t ws_size, hipStream_t stream) {
    static int grid_blocks = 0;
    if (grid_blocks == 0) {
        if (n_in != 19 || ws_size < WS_END) { fprintf(stderr, "kernel_launch: unexpected n_in %d / ws_size %zu (need %zu)\n", n_in, ws_size, (size_t)WS_END); grid_blocks = -1; return; }
        int dev = 0, cus = 0, per_cu = 0;
        (void)hipGetDevice(&dev);
        (void)hipDeviceGetAttribute(&cus, hipDeviceAttributeMultiprocessorCount, dev);
        if (hipFuncSetAttribute((const void*)fwd_megakernel, hipFuncAttributeMaxDynamicSharedMemorySize, LDS_TOTAL) != hipSuccess) { fprintf(stderr, "kernel_launch: hipFuncSetAttribute failed\n"); grid_blocks = -1; return; }
        if (hipOccupancyMaxActiveBlocksPerMultiprocessor(&per_cu, (const void*)fwd_megakernel, 512, LDS_TOTAL) != hipSuccess || per_cu < 1) { fprintf(stderr, "kernel_launch: occupancy query failed (%d)\n", per_cu); (void)hipGetLastError(); per_cu = 1; }
        grid_blocks = cus * per_cu;
    }
    if (grid_blocks < 0) return;
    Params p{};
    for (int i = 0; i < 19; ++i) p.in[i] = (const float*)d_in[i];
    p.out = (float*)d_out; p.ws = (unsigned char*)d_ws;
    void* args[] = {&p};
    hipError_t e = hipLaunchCooperativeKernel((const void*)fwd_megakernel, dim3(grid_blocks), dim3(512), args, LDS_TOTAL, stream);
    if (e != hipSuccess) fprintf(stderr, "cooperative launch failed: %s (grid %d)\n", hipGetErrorString(e), grid_blocks);
}
```

```cpp
#include <hip/hip_runtime.h>
#include <hip/hip_cooperative_groups.h>
#include <cstdio>
#include <cstdint>
namespace cg = cooperative_groups;

namespace pg8 {
#define PG8_LAS __attribute__((address_space(3)))
typedef unsigned short bf16_t;
typedef short bf16x8 __attribute__((ext_vector_type(8)));
typedef float f32x4 __attribute__((ext_vector_type(4)));
typedef unsigned u32x4 __attribute__((ext_vector_type(4)));
constexpr int BM = 256, BK = 64, HALF = 128, HTB = HALF * BK * 2  , STAGE_BYTES = 8 * HTB, NXCD = 8, WGM = 8;

__host__ __device__ __forceinline__ int lds_byte(int r, int c) { const int st = (r >> 4) * 2 + (c >> 5), rr = r & 15, cc = c & 31, ob = rr * 64 + cc * 2; return st * 1024 + (ob ^ (((ob >> 9) & 1) << 5)); }
__host__ __device__ __forceinline__ void stage_rc(int b, int& R, int& C) { const int st = b / 1024, sb = b % 1024, swz = sb ^ (((sb >> 9) & 1) << 5); R = (st >> 1) * 16 + swz / 64; C = (st & 1) * 32 + (swz % 64) / 2; }
__host__ __device__ __forceinline__ int perm32(int rho) { const int n = rho >> 4, i = rho & 15; return 8 * (i >> 2) + 4 * n + (i & 3); }

struct Unit { int pm, pn; };
struct Gemm { const bf16_t* A; const bf16_t* Bt; int M, N, K; };

struct StaticOrder {
    int nM, nN, nwg, G, c; int halo;
    __host__ __device__ void init_tiles(int nM_, int nN_, int G_, int c_, int halo_) { nM = nM_; nN = nN_; nwg = nM * nN; G = G_; c = c_; halo = halo_; }
    __device__ __forceinline__ long a_off(int pm, int K) const { return halo ? ((long)254 * pm - 1) * (long)K * 2 : (long)pm * 256 * (long)K * 2; }
    __host__ __device__ void init(int M, int N, int G_, int c_) { nM = M / BM; nN = N / BM; nwg = nM * nN; G = G_; c = c_; halo = 0; }
    __host__ __device__ bool next(int i, Unit& u) const {
        const long L = (long)i * G + c; if (L >= nwg) return false;
        int wgid = (int)L; { const int q = nwg / NXCD, r = nwg % NXCD, xcd = wgid % NXCD, off = wgid / NXCD; wgid = (xcd < r ? xcd * (q + 1) : r * (q + 1) + (xcd - r) * q) + off; }
        const int nig = WGM * nN, gid = wgid / nig, fm = gid * WGM, gsz = (nM - fm) < WGM ? (nM - fm) : WGM;
        u.pm = fm + ((wgid % nig) % gsz); u.pn = (wgid % nig) / gsz; return true;
    }
    __device__ __forceinline__ void a_ready(const Unit&) const {}
    __device__ __forceinline__ void done(const Unit&) const {}
};
__device__ __forceinline__ unsigned cvt_pk_bf16(float lo, float hi) { unsigned r; asm volatile("v_cvt_pk_bf16_f32 %0, %1, %2" : "=v"(r) : "v"(lo), "v"(hi)); return r; }
typedef float f32x2 __attribute__((ext_vector_type(2)));
typedef float f32x2 __attribute__((ext_vector_type(2)));
template <class Epi, class Sched, bool ALIGN_EPI = false, bool SP2 = false>
__device__ __forceinline__ void gemm_phase(PG8_LAS unsigned char* lds, const Gemm g, const Sched& S, const Epi& E, const int wave_s) {
    int tid_; asm volatile("v_mbcnt_lo_u32_b32 %0, -1, 0\n\tv_mbcnt_hi_u32_b32 %0, -1, %0" : "=v"(tid_)); tid_ += wave_s * 64;
    const int tid = tid_, wid = __builtin_amdgcn_readfirstlane(tid >> 6), lane = tid & 63, wr = wid >> 2, wc = wid & 3, fr = lane & 15, fq = lane >> 4;
    const int K = g.K, nt = K / BK;
    unsigned voffA[2], voffB[2];
#pragma unroll
    for (int i = 0; i < 2; ++i) { int R, C; stage_rc(tid * 16 + i * 8192, R, C); const int Rb = Epi::PERM ? ((R & ~31) + perm32(R & 31)) : R;
        voffA[i] = (unsigned)(R * K + C) * 2u; voffB[i] = (unsigned)(Rb * K + C) * 2u; }
    const size_t kstep = (size_t)(BK * 2);
    const size_t hstep = (size_t)HALF * K * 2;
    const size_t tstep = 2 * hstep;
    const unsigned ldsw = (unsigned)wid * 1024u;
    const int aoff = lds_byte(wr * 64 + fr, fq * 8), boff = lds_byte(wc * 32 + fr, fq * 8);
#define PG8_SA(b, h) (((b) * 2 + (h)) * HTB)
#define PG8_SB(b, h) ((4 + (b) * 2 + (h)) * HTB)
#define PG8_STAGE(bufoff, gbase, voff) do { _Pragma("unroll") for (int _i = 0; _i < 2; ++_i) \
        __builtin_amdgcn_global_load_lds((const unsigned*)((const char*)(gbase) + (voff)[_i]), (PG8_LAS unsigned*)(lds + (bufoff) + ldsw + _i * 8192), 16, 0, 0); } while (0)
#define PG8_LDA(dst, b, h) do { _Pragma("unroll") for (int m = 0; m < 4; ++m) _Pragma("unroll") for (int k = 0; k < 2; ++k) dst[m][k] = *(const PG8_LAS bf16x8*)(lds + PG8_SA(b, h) + aoff + m * 2048 + k * 1024); } while (0)
#define PG8_LDB(dst, b, h) do { _Pragma("unroll") for (int n = 0; n < 2; ++n) _Pragma("unroll") for (int k = 0; k < 2; ++k) dst[n][k] = *(const PG8_LAS bf16x8*)(lds + PG8_SB(b, h) + boff + n * 2048 + k * 1024); } while (0)
#define PG8_MMA(ai, bj, At, Bt) do { __builtin_amdgcn_s_setprio(1); _Pragma("unroll") for (int m = 0; m < 4; ++m) _Pragma("unroll") for (int n = 0; n < 2; ++n) _Pragma("unroll") for (int k = 0; k < 2; ++k) \
        acc[ai][bj][m][n] = __builtin_amdgcn_mfma_f32_16x16x32_bf16(Bt[n][k], At[m][k], acc[ai][bj][m][n], 0, 0, 0); __builtin_amdgcn_s_setprio(0); } while (0)
#define PG8_WAIT_V(n) asm volatile("s_waitcnt vmcnt(" #n ")" ::: "memory")
#define PG8_WAIT_L(n) asm volatile("s_waitcnt lgkmcnt(" #n ")" ::: "memory")
#define PG8_BAR __builtin_amdgcn_s_barrier()
#define PG8_SCHED __builtin_amdgcn_sched_barrier(0)
    Unit cur, nxt; int ui = 0;
    if (!S.next(0, cur)) return;
    f32x4 acc[2][2][4][2];
#pragma unroll
    for (int a = 0; a < 2; ++a)
#pragma unroll
        for (int b = 0; b < 2; ++b)
#pragma unroll
            for (int m = 0; m < 4; ++m)
#pragma unroll
                for (int n = 0; n < 2; ++n) acc[a][b][m][n] = (f32x4){0.f, 0.f, 0.f, 0.f};
    bf16x8 At[4][2], B0[2][2], B1[2][2];
    const char* cA = (const char*)g.A + S.a_off(cur.pm, K); const char* cB = (const char*)g.Bt + (size_t)cur.pn * tstep;
    S.a_ready(cur);
    if constexpr (SP2) {
        PG8_STAGE(PG8_SB(0, 0), cB, voffB); PG8_STAGE(PG8_SB(0, 1), cB + hstep, voffB); PG8_STAGE(PG8_SA(0, 0), cA, voffA); PG8_STAGE(PG8_SA(0, 1), cA + hstep, voffA);
        if (wr == 1) PG8_BAR;
        PG8_WAIT_V(2); PG8_BAR;
        PG8_STAGE(PG8_SB(1, 0), cB + kstep, voffB); PG8_STAGE(PG8_SA(1, 0), cA + kstep, voffA); PG8_STAGE(PG8_SB(1, 1), cB + hstep + kstep, voffB);
        PG8_WAIT_V(6); PG8_BAR;
    } else {
        PG8_STAGE(PG8_SB(0, 0), cB, voffB); PG8_STAGE(PG8_SA(0, 0), cA, voffA); PG8_STAGE(PG8_SB(0, 1), cB + hstep, voffB); PG8_STAGE(PG8_SA(0, 1), cA + hstep, voffA);
        if (wr == 1) PG8_BAR;
        PG8_WAIT_V(4); PG8_BAR;
        PG8_STAGE(PG8_SB(1, 0), cB + kstep, voffB); PG8_STAGE(PG8_SA(1, 0), cA + kstep, voffA); PG8_STAGE(PG8_SB(1, 1), cB + hstep + kstep, voffB);
        PG8_WAIT_V(6); PG8_BAR;
    }
    for (;;) {
        const bool has_next = S.next(ui + 1, nxt);
        const char* nA = has_next ? (const char*)g.A + S.a_off(nxt.pm, K) : cA; const char* nB = has_next ? (const char*)g.Bt + (size_t)nxt.pn * tstep : cB;
        for (int t = 0; t < nt; t += 2) {
            const bool last = (t == nt - 2);
            const char* a1 = cA + (size_t)(t + 1) * kstep;
            const char* a2 = last ? nA : cA + (size_t)(t + 2) * kstep; const char* b2 = last ? nB : cB + (size_t)(t + 2) * kstep;
            const char* a3 = a2 + kstep; const char* b3 = b2 + kstep;
            if (last && has_next) S.a_ready(nxt);
            if constexpr (SP2) {
            PG8_LDB(B0, 0, 0); PG8_LDB(B1, 0, 1); PG8_SCHED; PG8_LDA(At, 0, 0); PG8_STAGE(PG8_SA(1, 1), a1 + hstep, voffA);
            PG8_WAIT_V(8); PG8_WAIT_L(0); PG8_BAR; PG8_MMA(0, 0, At, B0); PG8_MMA(0, 1, At, B1); PG8_BAR; PG8_SCHED;
            PG8_LDA(At, 0, 1); PG8_STAGE(PG8_SB(0, 0), b2, voffB); PG8_STAGE(PG8_SB(0, 1), b2 + hstep, voffB); PG8_STAGE(PG8_SA(0, 0), a2, voffA);
            PG8_WAIT_V(8); PG8_WAIT_L(0); PG8_BAR; PG8_MMA(1, 0, At, B0); PG8_MMA(1, 1, At, B1); PG8_BAR; PG8_SCHED;
            PG8_LDB(B0, 1, 0); PG8_LDB(B1, 1, 1); PG8_SCHED; PG8_LDA(At, 1, 0); PG8_STAGE(PG8_SA(0, 1), a2 + hstep, voffA);
            PG8_WAIT_V(8); PG8_WAIT_L(0); PG8_BAR; PG8_MMA(0, 0, At, B0); PG8_MMA(0, 1, At, B1); PG8_BAR; PG8_SCHED;
            PG8_LDA(At, 1, 1); PG8_STAGE(PG8_SB(1, 0), b3, voffB); PG8_STAGE(PG8_SB(1, 1), b3 + hstep, voffB); PG8_STAGE(PG8_SA(1, 0), a3, voffA);
            PG8_WAIT_V(8); PG8_WAIT_L(0); PG8_BAR; PG8_MMA(1, 0, At, B0); PG8_MMA(1, 1, At, B1); PG8_BAR; PG8_SCHED;
            } else {
            PG8_LDB(B0, 0, 0); PG8_SCHED; PG8_LDA(At, 0, 0); PG8_STAGE(PG8_SA(1, 1), a1 + hstep, voffA);
            PG8_WAIT_L(8); PG8_BAR; PG8_WAIT_L(0); PG8_MMA(0, 0, At, B0); PG8_BAR; PG8_SCHED;
            PG8_LDB(B1, 0, 1); PG8_STAGE(PG8_SB(0, 0), b2, voffB);
            PG8_BAR; PG8_WAIT_L(0); PG8_MMA(0, 1, At, B1); PG8_BAR;
            PG8_LDA(At, 0, 1); PG8_STAGE(PG8_SA(0, 0), a2, voffA);
            PG8_BAR; PG8_WAIT_L(0); PG8_MMA(1, 0, At, B0); PG8_BAR; PG8_SCHED;
            PG8_STAGE(PG8_SB(0, 1), b2 + hstep, voffB);
            PG8_WAIT_V(6); PG8_BAR; PG8_MMA(1, 1, At, B1); PG8_BAR;
            PG8_LDB(B0, 1, 0); PG8_SCHED; PG8_LDA(At, 1, 0); PG8_STAGE(PG8_SA(0, 1), a2 + hstep, voffA);
            PG8_WAIT_L(8); PG8_BAR; PG8_WAIT_L(0); PG8_MMA(0, 0, At, B0); PG8_BAR; PG8_SCHED;
            PG8_LDB(B1, 1, 1); PG8_STAGE(PG8_SB(1, 0), b3, voffB);
            PG8_BAR; PG8_WAIT_L(0); PG8_MMA(0, 1, At, B1); PG8_BAR;
            PG8_LDA(At, 1, 1); PG8_STAGE(PG8_SA(1, 0), a3, voffA);
            PG8_BAR; PG8_WAIT_L(0); PG8_MMA(1, 0, At, B0); PG8_BAR; PG8_SCHED;
            PG8_STAGE(PG8_SB(1, 1), b3 + hstep, voffB);
            PG8_WAIT_V(6); PG8_BAR; PG8_MMA(1, 1, At, B1); PG8_BAR;
            }
        }
        if constexpr (ALIGN_EPI) { if (wr == 0) PG8_BAR; }
        if constexpr (!Epi::AFTER_DRAIN) { E(acc, cur, wr, wc, fr, fq); S.done(cur); }
        if (!has_next) break;
#pragma unroll
        for (int a = 0; a < 2; ++a)
#pragma unroll
            for (int b = 0; b < 2; ++b)
#pragma unroll
                for (int m = 0; m < 4; ++m)
#pragma unroll
                    for (int n = 0; n < 2; ++n) acc[a][b][m][n] = (f32x4){0.f, 0.f, 0.f, 0.f};
        cur = nxt; cA = nA; cB = nB; ++ui;
        if constexpr (ALIGN_EPI) { if (wr == 1) PG8_BAR; }
    }
    PG8_WAIT_V(0);
    if constexpr (!ALIGN_EPI) { if (wr == 0) PG8_BAR; }
    PG8_BAR;
    if constexpr (Epi::AFTER_DRAIN) { E.fused(acc, cur, wr, wc, fr, fq, lds, wid, lane); S.done(cur); }
#undef PG8_SA
#undef PG8_SB
#undef PG8_STAGE
#undef PG8_LDA
#undef PG8_LDB
#undef PG8_MMA
#undef PG8_WAIT_V
#undef PG8_WAIT_L
#undef PG8_BAR
#undef PG8_SCHED
}
}

using pg8::bf16_t; using pg8::bf16x8; using pg8::f32x4; using pg8::u32x4; using pg8::Unit; using pg8::cvt_pk_bf16;
#define LAS __attribute__((address_space(3)))
typedef float f32x16 __attribute__((ext_vector_type(16)));
typedef unsigned u32x2 __attribute__((ext_vector_type(2)));
constexpr int DM = 1024, MTOK = 131072, NPROMPT = 65536, SEQP = 4096, SEQS = 8192, DFF = 2816;
constexpr float EPSV = 1e-6f;
constexpr float QSCALE = 0.125f * 1.4426950408889634f;
constexpr size_t MiB = 1024 * 1024;
constexpr size_t WS_WQKP = 0, WS_WV = 3 * MiB, WS_WOUT = 4 * MiB, WS_WUP = 6 * MiB, WS_WDN = 17 * MiB, WS_COS = 23 * MiB, WS_SIN = 24 * MiB, WS_RSS = 25 * MiB, WS_QKG = 25 * MiB + 768 * 1024,
                 WS_XB = 26 * MiB, WS_Q = WS_XB, WS_K = WS_XB + 128 * MiB, WS_ACT = 282 * MiB, WS_VT = WS_ACT, WS_ZP = WS_ACT + 128 * MiB, WS_H = WS_ACT + 256 * MiB,
                 WS_END = WS_ACT + 704 * MiB;
constexpr int LDS_STAGE = 131072, LDS_EDGE = 8192, LDS_TOTAL = 147456;

struct Params {
    const float* in[19];
    float* out;
    unsigned char* ws;
};
enum { I_XP = 0, I_XS, I_N1G, I_WIN, I_QG, I_KG, I_LQ1, I_LK1, I_LQ2, I_LK2, I_SUBG, I_WPOOL, I_PSCALE, I_WOUT, I_N2G, I_WUP, I_CONVW, I_CONVB, I_WDOWN };

__device__ __forceinline__ int lane_id() { int l; asm volatile("v_mbcnt_lo_u32_b32 %0, -1, 0\n\tv_mbcnt_hi_u32_b32 %0, -1, %0" : "=v"(l)); return l; }
__device__ __forceinline__ bf16_t f2bf(float x) { unsigned u = __float_as_uint(x); u += 0x7fffu + ((u >> 16) & 1u); return (bf16_t)(u >> 16); }
__device__ __forceinline__ float bf2f(unsigned short b) { return __uint_as_float(((unsigned)b) << 16); }
__device__ __forceinline__ float bflo(unsigned w) { return __uint_as_float(w << 16); }
__device__ __forceinline__ float bfhi(unsigned w) { return __uint_as_float(w & 0xffff0000u); }
__device__ __forceinline__ u32x4 pack8(f32x4 a, f32x4 b) { u32x4 w; w.x = cvt_pk_bf16(a[0], a[1]); w.y = cvt_pk_bf16(a[2], a[3]); w.z = cvt_pk_bf16(b[0], b[1]); w.w = cvt_pk_bf16(b[2], b[3]); return w; }
__device__ __forceinline__ u32x2 pack4(f32x4 a) { u32x2 w; w.x = cvt_pk_bf16(a[0], a[1]); w.y = cvt_pk_bf16(a[2], a[3]); return w; }

struct EpiQKP {
    static constexpr bool PERM = true, AFTER_DRAIN = false;
    unsigned char* ws; const float *qkg  , *cosT, *sinT;
    __device__ __forceinline__ void operator()(f32x4 (&acc)[2][2][4][2], const Unit& u, int wr, int wc, int fr, int fq) const {
        const int kind = u.pn >> 1;
        bf16_t* base = (bf16_t*)(ws + (kind == 0 ? WS_Q : (kind == 1 ? WS_K : WS_ZP)));
        const int colbase = (u.pn & 1) * 256 + wc * 64, i0 = 8 * fq;
        if (kind < 2) {
            const float* g = qkg + kind * 64;
            const float osc = kind == 0 ? QSCALE : 1.0f;
            const f32x4 g00 = *(const f32x4*)(g + i0), g01 = *(const f32x4*)(g + i0 + 4), g10 = *(const f32x4*)(g + 32 + i0), g11 = *(const f32x4*)(g + 32 + i0 + 4);
#pragma unroll
            for (int ai = 0; ai < 2; ++ai)
#pragma unroll
                for (int m = 0; m < 4; ++m) {
                    const int row = u.pm * 256 + ai * 128 + wr * 64 + m * 16 + fr;
                    const int pos = row < NPROMPT ? (row & (SEQP - 1)) : (row & (SEQS - 1));
                    const f32x4 a00 = acc[ai][0][m][0], a01 = acc[ai][0][m][1], a10 = acc[ai][1][m][0], a11 = acc[ai][1][m][1];
                    f32x4 sq = a00 * a00 + a01 * a01 + a10 * a10 + a11 * a11;
                    float ss = (sq[0] + sq[1]) + (sq[2] + sq[3]);
                    ss += __shfl_xor(ss, 16); ss += __shfl_xor(ss, 32);
                    const float rstd = rsqrtf(ss * (1.0f / 64.0f) + EPSV) * osc;
                    const f32x4 cs0 = *(const f32x4*)(cosT + pos * 32 + i0), sn0 = *(const f32x4*)(sinT + pos * 32 + i0);
                    const f32x4 cs1 = *(const f32x4*)(cosT + pos * 32 + i0 + 4), sn1 = *(const f32x4*)(sinT + pos * 32 + i0 + 4);
                    const f32x4 y00 = a00 * rstd * g00, y01 = a01 * rstd * g01, y10 = a10 * rstd * g10, y11 = a11 * rstd * g11;
                    bf16_t* rp = base + (size_t)row * 512 + colbase + i0;
                    *(u32x4*)(rp) = pack8(y00 * cs0 - y10 * sn0, y01 * cs1 - y11 * sn1);
                    *(u32x4*)(rp + 32) = pack8(y10 * cs0 + y00 * sn0, y11 * cs1 + y01 * sn1);
                    asm volatile("" ::: "memory");
                }
        } else {
#pragma unroll
            for (int ai = 0; ai < 2; ++ai)
#pragma unroll
                for (int m = 0; m < 4; ++m) {
                    const int row = u.pm * 256 + ai * 128 + wr * 64 + m * 16 + fr;
                    bf16_t* rp = base + (size_t)row * 512 + colbase + i0;
#pragma unroll
                    for (int bj = 0; bj < 2; ++bj) *(u32x4*)(rp + 32 * bj) = pack8(acc[ai][bj][m][0], acc[ai][bj][m][1]);
                }
        }
    }
};
struct EpiVT {
    static constexpr bool PERM = true, AFTER_DRAIN = false;
    bf16_t* vT;
    __device__ __forceinline__ void operator()(f32x4 (&acc)[2][2][4][2], const Unit& u, int wr, int wc, int fr, int fq) const {
#pragma unroll
        for (int ai = 0; ai < 2; ++ai)
#pragma unroll
            for (int m = 0; m < 4; ++m) {
                const int row = u.pm * 256 + ai * 128 + wr * 64 + m * 16 + fr;
                bf16_t* rp = vT + (size_t)row * MTOK + (size_t)u.pn * 256 + wc * 32 + 16 * (fq >> 1) + 4 * (fq & 1);
#pragma unroll
                for (int bj = 0; bj < 2; ++bj)
#pragma unroll
                    for (int n = 0; n < 2; ++n) *(u32x2*)(rp + 128 * bj + 8 * n) = pack4(acc[ai][bj][m][n]);
            }
    }
};
struct EpiRes1 {
    static constexpr bool PERM = true, AFTER_DRAIN = false;
    const float *xp, *xs; bf16_t* xb; float* rss;
    __device__ __forceinline__ void operator()(f32x4 (&acc)[2][2][4][2], const Unit& u, int wr, int wc, int fr, int fq) const {
        const int col0 = u.pn * 256 + wc * 32 + 8 * fq;
#pragma unroll
        for (int ai = 0; ai < 2; ++ai)
#pragma unroll
            for (int m = 0; m < 4; ++m) {
                const int row = u.pm * 256 + ai * 128 + wr * 64 + m * 16 + fr;
                const float* xr = (row < NPROMPT ? xp + (size_t)row * DM : xs + (size_t)(row - NPROMPT) * DM) + col0;
                bf16_t* brow = xb + (size_t)row * DM + col0;
                float ss = 0.f;
#pragma unroll
                for (int bj = 0; bj < 2; ++bj) {
                    const f32x4 a = acc[ai][bj][m][0] + *(const f32x4*)(xr + 128 * bj), b = acc[ai][bj][m][1] + *(const f32x4*)(xr + 128 * bj + 4);
                    *(u32x4*)(brow + 128 * bj) = pack8(a, b);
                    ss += (a[0] * a[0] + a[1] * a[1]) + (a[2] * a[2] + a[3] * a[3]) + (b[0] * b[0] + b[1] * b[1]) + (b[2] * b[2] + b[3] * b[3]);
                }
                ss += __shfl_xor(ss, 16); ss += __shfl_xor(ss, 32);
                if (fq == 0) atomicAdd(rss + row, ss);
                asm volatile("" ::: "memory");
            }
    }
};
struct EpiRes2 {
    static constexpr bool PERM = true, AFTER_DRAIN = false;
    const bf16_t* xb; float* out;
    __device__ __forceinline__ void operator()(f32x4 (&acc)[2][2][4][2], const Unit& u, int wr, int wc, int fr, int fq) const {
        const int col0 = u.pn * 256 + wc * 32 + 8 * fq;
#pragma unroll
        for (int ai = 0; ai < 2; ++ai)
#pragma unroll
            for (int m = 0; m < 4; ++m) {
                const int row = u.pm * 256 + ai * 128 + wr * 64 + m * 16 + fr;
                float* orow = out + (size_t)row * DM + col0; const bf16_t* brow = xb + (size_t)row * DM + col0;
#pragma unroll
                for (int bj = 0; bj < 2; ++bj) {
                    const u32x4 w = *(const u32x4*)(brow + 128 * bj);
                    const f32x4 a = acc[ai][bj][m][0] + (f32x4){bflo(w.x), bfhi(w.x), bflo(w.y), bfhi(w.y)}, b = acc[ai][bj][m][1] + (f32x4){bflo(w.z), bfhi(w.z), bflo(w.w), bfhi(w.w)};
                    *(f32x4*)(orow + 128 * bj) = a; *(f32x4*)(orow + 128 * bj + 4) = b;
                }
                asm volatile("" ::: "memory");
            }
    }
};
__device__ __forceinline__ float dpp_ror1(float v) { return __builtin_bit_cast(float, __builtin_amdgcn_update_dpp(0, __builtin_bit_cast(int, v), 0x121, 0xf, 0xf, false)); }
__device__ __forceinline__ float dpp_ror15(float v) { return __builtin_bit_cast(float, __builtin_amdgcn_update_dpp(0, __builtin_bit_cast(int, v), 0x12F, 0xf, 0xf, false)); }
struct EpiConvGate {
    static constexpr bool PERM = true, AFTER_DRAIN = false;
    const float *rss, *convw, *convb; bf16_t* act; LAS float* edge;
    template <bool BND> __device__ __forceinline__ void conv_gate(f32x4 (&acc)[2][2][4][2], const Unit& u, int wr, int wc, int fr, int fq, int tok0, int pcol) const {
        const int fcol = u.pn * 128 + pcol;
#pragma unroll
        for (int n = 0; n < 2; ++n) {
            f32x4 w0[2], w1[2], w2[2], bb[2];
#pragma unroll
            for (int bj = 0; bj < 2; ++bj) { const int c = bj * DFF + fcol + 4 * n;
                w0[bj] = *(const f32x4*)(convw + c); w1[bj] = *(const f32x4*)(convw + 2 * DFF + c); w2[bj] = *(const f32x4*)(convw + 4 * DFF + c); bb[bj] = *(const f32x4*)(convb + c); }
#pragma unroll
            for (int ai = 0; ai < 2; ++ai) {
                const int blk = 2 * ai + wr;
                f32x4 pe[2], ne[2];
#pragma unroll
                for (int bj = 0; bj < 2; ++bj) {
                    pe[bj] = blk > 0 ? *(const LAS f32x4*)(edge + ((blk - 1) * 2 + 1) * 256 + 128 * bj + pcol + 4 * n) : (f32x4){0.f, 0.f, 0.f, 0.f};
                    ne[bj] = blk < 3 ? *(const LAS f32x4*)(edge + ((blk + 1) * 2 + 0) * 256 + 128 * bj + pcol + 4 * n) : (f32x4){0.f, 0.f, 0.f, 0.f};
                }
#pragma unroll
                for (int m = 0; m < 4; ++m) {
                    const int r = ai * 128 + wr * 64 + m * 16 + fr, tok = tok0 + r;
                    bool isfirst = false, islast = false;
                    if (BND) { const int S1 = (tok < NPROMPT ? SEQP : SEQS) - 1, pos = tok & S1; isfirst = pos == 0; islast = pos == S1; }
                    f32x4 cv[2];
#pragma unroll
                    for (int bj = 0; bj < 2; ++bj) {
                        const f32x4 cur = acc[ai][bj][m][n];
                        const f32x4 ups = m > 0 ? acc[ai][bj][m > 0 ? m - 1 : 0][n] : pe[bj];
                        const f32x4 dns = m < 3 ? acc[ai][bj][m < 3 ? m + 1 : 3][n] : ne[bj];
                        f32x4 prev, next;
#pragma unroll
                        for (int j = 0; j < 4; ++j) {
                            const float t1 = fr == 15 ? ups[j] : cur[j]; float pv = dpp_ror1(t1);
                            const float t2 = fr == 0 ? dns[j] : cur[j]; float nx = dpp_ror15(t2);
                            if (BND) { prev[j] = isfirst ? 0.f : pv; next[j] = islast ? 0.f : nx; } else { prev[j] = pv; next[j] = nx; }
                        }
                        cv[bj] = w0[bj] * prev + w1[bj] * cur + w2[bj] * next + bb[bj];
                    }
                    f32x4 a;
#pragma unroll
                    for (int j = 0; j < 4; ++j) { const float g = cv[0][j]; const float sg = __builtin_amdgcn_rcpf(1.0f + __builtin_amdgcn_exp2f(-1.4426950408889634f * g)); a[j] = g * sg * cv[1][j]; }
                    if (r >= 1 && r <= 254 && (!BND || tok < MTOK)) *(u32x2*)(act + (size_t)tok * DFF + fcol + 4 * n) = pack4(a);
                    asm volatile("" ::: "memory");
                }
            }
        }
    }
    __device__ __forceinline__ void operator()(f32x4 (&acc)[2][2][4][2], const Unit& u, int wr, int wc, int fr, int fq) const {
        asm volatile("" : "+v"(fr), "+v"(fq));
        const int tok0 = 254 * u.pm - 1;
        const int pcol = wc * 32 + 8 * fq;
        const bool bnd = (tok0 < 0) || (((tok0 & (SEQP - 1)) + 256) >= SEQP) || (tok0 + 256 > MTOK);
#pragma unroll
        for (int ai = 0; ai < 2; ++ai)
#pragma unroll
            for (int m = 0; m < 4; ++m) {
                const int tok = tok0 + ai * 128 + wr * 64 + m * 16 + fr;
                if (bnd) {
                    const bool valid = (tok >= 0) && (tok < MTOK);
                    float rs = 0.f; if (valid) rs = rsqrtf(rss[tok] * (1.0f / 1024.0f) + EPSV);
#pragma unroll
                    for (int bj = 0; bj < 2; ++bj)
#pragma unroll
                        for (int n = 0; n < 2; ++n) { f32x4 x = acc[ai][bj][m][n] * rs;
#pragma unroll
                            for (int j = 0; j < 4; ++j) x[j] = valid ? x[j] : 0.f;
                            acc[ai][bj][m][n] = x; }
                } else {
                    const float rs = rsqrtf(rss[tok] * (1.0f / 1024.0f) + EPSV);
#pragma unroll
                    for (int bj = 0; bj < 2; ++bj)
#pragma unroll
                        for (int n = 0; n < 2; ++n) acc[ai][bj][m][n] = acc[ai][bj][m][n] * rs;
                }
            }
#pragma unroll
        for (int ai = 0; ai < 2; ++ai) {
            const int blk = 2 * ai + wr;
            if (fr == 0) {
#pragma unroll
                for (int bj = 0; bj < 2; ++bj)
#pragma unroll
                    for (int n = 0; n < 2; ++n) *(LAS f32x4*)(edge + (blk * 2 + 0) * 256 + 128 * bj + pcol + 4 * n) = acc[ai][bj][0][n];
            }
            if (fr == 15) {
#pragma unroll
                for (int bj = 0; bj < 2; ++bj)
#pragma unroll
                    for (int n = 0; n < 2; ++n) *(LAS f32x4*)(edge + (blk * 2 + 1) * 256 + 128 * bj + pcol + 4 * n) = acc[ai][bj][3][n];
            }
        }
        asm volatile("s_waitcnt lgkmcnt(0)\n\ts_barrier" ::: "memory");
        if (bnd) conv_gate<true>(acc, u, wr, wc, fr, fq, tok0, pcol); else conv_gate<false>(acc, u, wr, wc, fr, fq, tok0, pcol);
    }
};

__device__ __forceinline__ void p0_prologue(const Params& p, LAS unsigned char* lds, const int wave_s) {
    int tid_ = wave_s * 64 + lane_id(); asm volatile("" : "+v"(tid_));
    const int tid = tid_, G = gridDim.x, gt = blockIdx.x * 512 + tid, GT = G * 512, lane = tid & 63, wid = tid >> 6;
    unsigned char* ws = p.ws;
    bf16_t* WQKP = (bf16_t*)(ws + WS_WQKP); bf16_t* WV = (bf16_t*)(ws + WS_WV); bf16_t* WOUT = (bf16_t*)(ws + WS_WOUT); bf16_t* WUP = (bf16_t*)(ws + WS_WUP); bf16_t* WDN = (bf16_t*)(ws + WS_WDN);
    LAS float* tile = (LAS float*)lds;
    for (int t = blockIdx.x; t < 2752; t += G) {
        const float* src; int ld, k0, n0, kind;
        if (t < 512) { kind = 0; k0 = (t >> 5) * 64; n0 = (t & 31) * 64; src = p.in[I_WIN]; ld = 2048; }
        else if (t < 640) { const int u = t - 512; kind = 1; k0 = (u >> 4) * 64; n0 = (u & 15) * 64; src = p.in[I_WOUT]; ld = 1024; }
        else if (t < 2048) { const int u = t - 640; kind = 2; k0 = (u / 88) * 64; n0 = (u % 88) * 64; src = p.in[I_WUP]; ld = 5632; }
        else { const int u = t - 2048; kind = 3; k0 = (u >> 4) * 64; n0 = (u & 15) * 64; src = p.in[I_WDOWN]; ld = 1024; }
#pragma unroll
        for (int i = 0; i < 8; ++i) { const int e = tid + i * 512, kk = e >> 6, nn = e & 63;
            float v = src[(size_t)(k0 + kk) * ld + n0 + nn];
            if (kind == 1) v *= p.in[I_SUBG][(k0 + kk) & 127] * 0.8f;
            if (kind == 2) v *= p.in[I_N2G][k0 + kk];
            tile[kk * 65 + nn] = v; }
        __syncthreads();
#pragma unroll
        for (int i = 0; i < 8; ++i) { const int e = tid + i * 512, nn = e >> 6, kk = e & 63, n = n0 + nn; bf16_t* dst;
            if (kind == 0) {
                if (n < 1024 || n >= 1536) { const int L = n < 1024 ? n : n - 512; const int prow = (L & ~255) + ((L >> 5) & 1) * 128 + ((L >> 6) & 3) * 32 + (L & 31); dst = WQKP + (size_t)prow * 1024 + k0 + kk; }
                else dst = WV + (size_t)(n - 1024) * 1024 + k0 + kk;
            } else if (kind == 1) dst = WOUT + (size_t)n * 1024 + k0 + kk;
            else if (kind == 2) { const int f = n < DFF ? n : n - DFF; const int prow = (f >> 7) * 256 + (n < DFF ? 0 : 128) + (f & 127); dst = WUP + (size_t)prow * 1024 + k0 + kk; }
            else dst = WDN + (size_t)n * DFF + k0 + kk;
            *dst = f2bf(tile[kk * 65 + nn]); }
        __syncthreads();
    }
    for (int o = gt; o < 128 * 1024; o += GT) {
        const int n = o & 1023, c = o >> 10;
        const float* wo = p.in[I_WOUT] + (size_t)512 * 1024 + n;
        float a0 = 0.f, a1 = 0.f, a2 = 0.f, a3 = 0.f;
        const float* wp = p.in[I_WPOOL] + (size_t)c * 128; const float* ps = p.in[I_PSCALE];
#pragma unroll 8
        for (int e = 0; e < 128; ++e) {
            a0 += wp[e] * ps[e] * wo[(size_t)e * 1024];
            a1 += wp[16384 + e] * ps[128 + e] * wo[(size_t)(128 + e) * 1024];
            a2 += wp[32768 + e] * ps[256 + e] * wo[(size_t)(256 + e) * 1024];
            a3 += wp[49152 + e] * ps[384 + e] * wo[(size_t)(384 + e) * 1024];
        }
        bf16_t* dst = WOUT + (size_t)n * 1024 + 512 + c;
        dst[0] = f2bf(a0); dst[128] = f2bf(a1); dst[256] = f2bf(a2); dst[384] = f2bf(a3);
    }
    float* cosT = (float*)(ws + WS_COS); float* sinT = (float*)(ws + WS_SIN);
    for (int o = gt; o < 8192 * 32; o += GT) {
        const int s = o >> 5, i = o & 31;
        const float inv = exp2f(-(float)i * (13.287712379549449f / 32.0f));
        const float ang = (float)s * inv;
        const double rev = (double)ang * 0.15915494309189535; const float fr = (float)(rev - __builtin_rint(rev));
        cosT[o] = __builtin_amdgcn_cosf(fr); sinT[o] = __builtin_amdgcn_sinf(fr);
    }
    float* rss = (float*)(ws + WS_RSS);
    for (int o = gt; o < MTOK; o += GT) rss[o] = 0.f;
    if (gt < 128) ((float*)(ws + WS_QKG))[gt] = gt < 64 ? p.in[I_QG][gt] : p.in[I_KG][gt - 64];
    bf16_t* H = (bf16_t*)(ws + WS_H);
    f32x4 g1[4];
#pragma unroll
    for (int i = 0; i < 4; ++i) g1[i] = *(const f32x4*)(p.in[I_N1G] + lane * 4 + 256 * i);
    for (int row = blockIdx.x * 8 + wid; row < MTOK; row += G * 8) {
        const float* xr = (row < NPROMPT ? p.in[I_XP] + (size_t)row * DM : p.in[I_XS] + (size_t)(row - NPROMPT) * DM) + lane * 4;
        f32x4 v[4]; float ss = 0.f;
#pragma unroll
        for (int i = 0; i < 4; ++i) { v[i] = *(const f32x4*)(xr + 256 * i); ss += (v[i][0] * v[i][0] + v[i][1] * v[i][1]) + (v[i][2] * v[i][2] + v[i][3] * v[i][3]); }
#pragma unroll
        for (int o = 1; o < 64; o <<= 1) ss += __shfl_xor(ss, o);
        const float rstd = rsqrtf(ss * (1.0f / 1024.0f) + EPSV);
        bf16_t* hr = H + (size_t)row * DM + lane * 4;
#pragma unroll
        for (int i = 0; i < 4; ++i) *(u32x2*)(hr + 256 * i) = pack4(v[i] * rstd * g1[i]);
    }
}

__device__ __forceinline__ void pool_phase(const bf16_t* zp, bf16_t* mixed, const int wave_s) {
    const int GT = gridDim.x * 512; int tid_ = wave_s * 64 + lane_id(); asm volatile("" : "+v"(tid_));
    for (int item = blockIdx.x * 512 + tid_; item < MTOK * 64; item += GT) {
        const int tok = item >> 6, ch = item & 63, c0 = ch * 8, g = ch >> 4, half = 1 << g;
        const int S = tok < NPROMPT ? SEQP : SEQS, pos = tok & (S - 1), base = tok - pos;
        const int lo = max(pos - half, 0), hi = min(pos + half - 1, S - 1);
        float s[8];
#pragma unroll
        for (int j = 0; j < 8; ++j) s[j] = 0.f;
        for (int r = lo; r <= hi; ++r) {
            const u32x4 w = *(const u32x4*)(zp + (size_t)(base + r) * 512 + c0);
            s[0] += bflo(w.x); s[1] += bfhi(w.x); s[2] += bflo(w.y); s[3] += bfhi(w.y); s[4] += bflo(w.z); s[5] += bfhi(w.z); s[6] += bflo(w.w); s[7] += bfhi(w.w);
        }
        const u32x4 w = *(const u32x4*)(zp + (size_t)tok * 512 + c0);
        const float ic = 1.0f / (float)(hi - lo + 1);
        u32x4 o;
        o.x = cvt_pk_bf16(s[0] * ic - bflo(w.x), s[1] * ic - bfhi(w.x)); o.y = cvt_pk_bf16(s[2] * ic - bflo(w.y), s[3] * ic - bfhi(w.y));
        o.z = cvt_pk_bf16(s[4] * ic - bflo(w.z), s[5] * ic - bfhi(w.z)); o.w = cvt_pk_bf16(s[6] * ic - bflo(w.w), s[7] * ic - bfhi(w.w));
        *(u32x4*)(mixed + (size_t)tok * DM + 512 + c0) = o;
    }
}

#define MFMA32(a, b, c) __builtin_amdgcn_mfma_f32_32x32x16_bf16((a), (b), (c), 0, 0, 0)
constexpr int KROW = 256, VROW = 128, KBUF = 64 * KROW, VBUF = 128 * VROW, ABUF = KBUF + VBUF, QROW = 272;
__device__ __forceinline__ bf16x8 packp(const f32x16& x, int s) {
    u32x4 w;
    w.x = cvt_pk_bf16(x[8 * s + 0], x[8 * s + 1]); w.y = cvt_pk_bf16(x[8 * s + 2], x[8 * s + 3]); w.z = cvt_pk_bf16(x[8 * s + 4], x[8 * s + 5]); w.w = cvt_pk_bf16(x[8 * s + 6], x[8 * s + 7]);
    return __builtin_bit_cast(bf16x8, w);
}
__device__ __forceinline__ void attn_phase_online(LAS unsigned char* lds, const bf16_t* q, const bf16_t* k, const bf16_t* vT, bf16_t* mixed, float lam, const int wave_s) {
    int tid_ = wave_s * 64 + lane_id(); asm volatile("" : "+v"(tid_));
    const int tid = tid_, lane = tid & 63, r32 = lane & 31, hi = lane >> 5, wid = __builtin_amdgcn_readfirstlane(tid >> 6), G = gridDim.x;
    unsigned koff[2], voff[2];
#pragma unroll
    for (int i = 0; i < 2; ++i) {
        const int kr = 4 * (2 * wid + i) + (lane >> 4), kc = (lane & 15) ^ (kr & 15); koff[i] = (unsigned)(kr * 512 + kc * 8) * 2u;
        const int vd = 8 * (2 * wid + i) + (lane >> 3), vc = (lane & 7) ^ ((vd >> 1) & 7); voff[i] = (unsigned)(vd * MTOK + vc * 8) * 2u;
    }
    const int kx = r32 & 15, vx = (r32 >> 1) & 7;
    const unsigned lds0 = (unsigned)(size_t)lds;
#define ATT_DMA1(sbase, voff_, ldsdst) do { unsigned keep_; asm volatile("s_mov_b32 %0, m0\n\ts_mov_b32 m0, %3\n\ts_nop 0\n\tglobal_load_lds_dwordx4 %1, %2\n\ts_mov_b32 m0, %0" : "=&s"(keep_) : "v"(voff_), "s"(sbase), "s"(ldsdst) : "memory"); } while (0)
#define ATT_DMA(buf, kp, vp) do { _Pragma("unroll") for (int _i = 0; _i < 2; ++_i) { \
        ATT_DMA1((kp), koff[_i], lds0 + (unsigned)((buf) + (2 * wid + _i) * 1024)); \
        ATT_DMA1((vp), voff[_i], lds0 + (unsigned)((buf) + KBUF + (2 * wid + _i) * 1024)); } } while (0)
    for (int U = blockIdx.x; U < 2048; U += G) {
        const int rnd = U >> 8, cc = U & 255, x = cc & 7, jj = cc >> 3;
        int S, tok0, h, qb;
        if (rnd < 4) { const int pair = 4 * x + rnd; S = SEQS; tok0 = NPROMPT + (pair >> 2) * SEQS; h = pair & 3; qb = jj; }
        else { const int pair = 8 * x + 2 * (rnd - 4) + (jj >> 4); S = SEQP; tok0 = (pair >> 2) * SEQP; h = pair & 3; qb = jj & 15; }
        const bf16_t* Kg = k + (size_t)tok0 * 512 + h * 128;
        const bf16_t* Vg = vT + (size_t)(h * 128) * MTOK + tok0;
        const int NT = S / 64;
        const size_t qrow = (size_t)tok0 + qb * 256 + wid * 32 + r32;
        ATT_DMA(0, Kg, Vg);
        LAS unsigned char* Qs = lds + 2 * ABUF + wid * (32 * QROW) + r32 * QROW + hi * 16;
#pragma unroll
        for (int m = 0; m < 2; ++m)
#pragma unroll
            for (int d0 = 0; d0 < 4; ++d0) *(LAS bf16x8*)(Qs + m * 128 + d0 * 32) = *(const bf16x8*)(q + qrow * 512 + h * 128 + m * 64 + d0 * 16 + hi * 8);
        f32x16 o[2][4];
#pragma unroll
        for (int m = 0; m < 2; ++m)
#pragma unroll
            for (int db = 0; db < 4; ++db)
#pragma unroll
                for (int i = 0; i < 16; ++i) o[m][db][i] = 0.f;
        float mu[2] = {-1e30f, -1e30f}, l[2] = {0.f, 0.f};
        asm volatile("s_waitcnt vmcnt(0)" ::: "memory");
        __syncthreads();
        for (int t = 0; t < NT; ++t) {
            const int cb = (t & 1) * ABUF, nb = ((t + 1) & 1) * ABUF;
            if (t + 1 < NT) ATT_DMA(nb, Kg + (size_t)(t + 1) * 64 * 512, Vg + (t + 1) * 64);
            const LAS unsigned char* Kb = lds + cb + r32 * KROW;
            const LAS unsigned char* Vb = lds + cb + KBUF + r32 * VROW;
#pragma unroll
            for (int m = 0; m < 2; ++m) {
                f32x16 s0, s1;
#pragma unroll
                for (int i = 0; i < 16; ++i) { s0[i] = 0.f; s1[i] = 0.f; }
#pragma unroll
                for (int d0 = 0; d0 < 4; ++d0) {
                    const int kpos = ((m * 8 + d0 * 2 + hi) ^ kx) * 16;
                    const bf16x8 k0 = *(const LAS bf16x8*)(Kb + kpos), k1 = *(const LAS bf16x8*)(Kb + 32 * KROW + kpos);
                    const bf16x8 qv = *(const LAS bf16x8*)(Qs + m * 128 + d0 * 32);
                    s0 = MFMA32(k0, qv, s0); s1 = MFMA32(k1, qv, s1);
                    if (d0 == 1) __builtin_amdgcn_sched_barrier(0);
                }
                __builtin_amdgcn_sched_barrier(0);
                float mx = fmaxf(s0[0], s1[0]);
#pragma unroll
                for (int i = 1; i < 16; ++i) mx = fmaxf(mx, fmaxf(s0[i], s1[i]));
                mx = fmaxf(mx, __shfl_xor(mx, 32));
                const bool need = mx > mu[m] + 8.0f;
                if (__builtin_amdgcn_ballot_w64(need) != 0ull) {
                    const float nm = need ? mx : mu[m];
                    const float alpha = __builtin_amdgcn_exp2f(mu[m] - nm);
                    mu[m] = nm; l[m] *= alpha;
#pragma unroll
                    for (int db = 0; db < 4; ++db)
#pragma unroll
                        for (int i = 0; i < 16; ++i) o[m][db][i] *= alpha;
                }
                const float mm = mu[m];
                float ls = 0.f;
#pragma unroll
                for (int i = 0; i < 16; ++i) { s0[i] = __builtin_amdgcn_exp2f(s0[i] - mm); s1[i] = __builtin_amdgcn_exp2f(s1[i] - mm); ls += s0[i] + s1[i]; }
                l[m] += ls;
                const bf16x8 p0 = packp(s0, 0), p1 = packp(s0, 1), p2 = packp(s1, 0), p3 = packp(s1, 1);
                __builtin_amdgcn_sched_barrier(0);
#pragma unroll
                for (int db = 0; db < 4; ++db) {
                    const LAS unsigned char* vb = Vb + db * 32 * VROW;
                    const bf16x8 v0 = *(const LAS bf16x8*)(vb + ((0 + hi) ^ vx) * 16), v1 = *(const LAS bf16x8*)(vb + ((2 + hi) ^ vx) * 16), v2 = *(const LAS bf16x8*)(vb + ((4 + hi) ^ vx) * 16), v3 = *(const LAS bf16x8*)(vb + ((6 + hi) ^ vx) * 16);
                    o[m][db] = MFMA32(v0, p0, o[m][db]); o[m][db] = MFMA32(v1, p1, o[m][db]); o[m][db] = MFMA32(v2, p2, o[m][db]); o[m][db] = MFMA32(v3, p3, o[m][db]);
                    __builtin_amdgcn_sched_barrier(0);
                }
            }
            asm volatile("s_waitcnt vmcnt(0)" ::: "memory");
            __syncthreads();
        }
        const float l0 = l[0] + __shfl_xor(l[0], 32), l1 = l[1] + __shfl_xor(l[1], 32);
        const float c0 = 1.0f / l0, c1 = lam / l1;
        float ss = 0.f;
#pragma unroll
        for (int db = 0; db < 4; ++db)
#pragma unroll
            for (int i = 0; i < 16; ++i) { const float v = o[0][db][i] * c0 - o[1][db][i] * c1; o[0][db][i] = v; ss += v * v; }
        ss += __shfl_xor(ss, 32);
        const float rstd = rsqrtf(ss * (1.0f / 128.0f) + EPSV);
        bf16_t* orow = mixed + qrow * DM + h * 128 + 4 * hi;
#pragma unroll
        for (int db = 0; db < 4; ++db)
#pragma unroll
            for (int i4 = 0; i4 < 4; ++i4) {
                u32x2 w; w.x = cvt_pk_bf16(o[0][db][4 * i4] * rstd, o[0][db][4 * i4 + 1] * rstd); w.y = cvt_pk_bf16(o[0][db][4 * i4 + 2] * rstd, o[0][db][4 * i4 + 3] * rstd);
                *(u32x2*)(orow + 32 * db + 8 * i4) = w;
            }
    }
}


__device__ __forceinline__ void attn_phase_fast(LAS unsigned char* lds, const bf16_t* q, const bf16_t* k, const bf16_t* vT, bf16_t* mixed, float lam, const int wave_s) {
    int tid_ = wave_s * 64 + lane_id(); asm volatile("" : "+v"(tid_));
    const int wid = __builtin_amdgcn_readfirstlane(tid_ >> 6), G = gridDim.x;
    const unsigned lds0 = (unsigned)(size_t)lds;
    if (wid >= 4) __builtin_amdgcn_s_setprio(1);
    for (int U = blockIdx.x; U < 2048; U += G) {
        int lane_ = tid_ & 63; asm volatile("" : "+v"(lane_));
        const int lane = lane_, r32 = lane & 31, hi = lane >> 5;
        unsigned koff[2], voff[2];
#pragma unroll
        for (int i = 0; i < 2; ++i) {
            const int kr = 4 * (2 * wid + i) + (lane >> 4), kc = (lane & 15) ^ (kr & 15); koff[i] = (unsigned)(kr * 512 + kc * 8) * 2u;
            const int vd = 8 * (2 * wid + i) + (lane >> 3), vc = (lane & 7) ^ ((vd >> 1) & 7); voff[i] = (unsigned)(vd * MTOK + vc * 8) * 2u;
        }
        const int kx = r32 & 15, vx = (r32 >> 1) & 7;
        const int rnd = U >> 8, cc = U & 255, x = cc & 7, jj = cc >> 3;
        int S, tok0, h, qb;
        if (rnd < 4) { const int pair = 4 * x + rnd; S = SEQS; tok0 = NPROMPT + (pair >> 2) * SEQS; h = pair & 3; qb = jj; }
        else { const int pair = 8 * x + 2 * (rnd - 4) + (jj >> 4); S = SEQP; tok0 = (pair >> 2) * SEQP; h = pair & 3; qb = jj & 15; }
        const bf16_t* Kg = k + (size_t)tok0 * 512 + h * 128;
        const bf16_t* Vg = vT + (size_t)(h * 128) * MTOK + tok0;
        const int NT = S / 64;
        const size_t qrow = (size_t)tok0 + qb * 256 + wid * 32 + r32;
        ATT_DMA(0, Kg, Vg);
        LAS unsigned char* Qs = lds + 2 * ABUF + wid * (32 * QROW) + r32 * QROW + hi * 16;
#pragma unroll
        for (int m = 0; m < 2; ++m)
#pragma unroll
            for (int d0 = 0; d0 < 4; ++d0) *(LAS bf16x8*)(Qs + m * 128 + d0 * 32) = *(const bf16x8*)(q + qrow * 512 + h * 128 + m * 64 + d0 * 16 + hi * 8);
        f32x16 o[2][4];
#pragma unroll
        for (int m = 0; m < 2; ++m)
#pragma unroll
            for (int db = 0; db < 4; ++db)
#pragma unroll
                for (int i = 0; i < 16; ++i) o[m][db][i] = 0.f;
        float l[2] = {0.f, 0.f};
        asm volatile("s_waitcnt vmcnt(0)" ::: "memory");
        __syncthreads();
        for (int t = 0; t < NT; ++t) {
            const int cb = (t & 1) * ABUF, nb = ((t + 1) & 1) * ABUF;
            int ln = lane; asm volatile("" : "+v"(ln));
            const int r32 = ln & 31, hi = ln >> 5, kx = r32 & 15, vx = (r32 >> 1) & 7;
            if (t + 1 < NT) {
                unsigned koff[2], voff[2];
#pragma unroll
                for (int i = 0; i < 2; ++i) {
                    const int kr = 4 * (2 * wid + i) + (ln >> 4), kc = (ln & 15) ^ (kr & 15); koff[i] = (unsigned)(kr * 512 + kc * 8) * 2u;
                    const int vd = 8 * (2 * wid + i) + (ln >> 3), vc = (ln & 7) ^ ((vd >> 1) & 7); voff[i] = (unsigned)(vd * MTOK + vc * 8) * 2u;
                }
                ATT_DMA(nb, Kg + (size_t)(t + 1) * 64 * 512, Vg + (t + 1) * 64);
            }
            const LAS unsigned char* Qs = lds + 2 * ABUF + wid * (32 * QROW) + r32 * QROW + hi * 16;
            int kxh = (kx >> 1) << 5, vxh = (vx >> 1) << 5, kq = cb + r32 * KROW + ((hi ^ (kx & 1)) << 4), vq = cb + KBUF + r32 * VROW + ((hi ^ (vx & 1)) << 4);
            asm volatile("" : "+v"(kxh), "+v"(vxh), "+v"(kq), "+v"(vq));
            const LAS unsigned char* Kb = lds + kq;
            const LAS unsigned char* Vb = lds + vq;
#pragma unroll
            for (int m = 0; m < 2; ++m) {
                f32x16 s0, s1;
#pragma unroll
                for (int i = 0; i < 16; ++i) { s0[i] = 0.f; s1[i] = 0.f; }
#pragma unroll
                for (int d0 = 0; d0 < 4; ++d0) {
                    const int kpos = ((m * 4 + d0) << 5) ^ kxh;
                    const bf16x8 k0 = *(const LAS bf16x8*)(Kb + kpos), k1 = *(const LAS bf16x8*)(Kb + 32 * KROW + kpos);
                    const bf16x8 qv = *(const LAS bf16x8*)(Qs + m * 128 + d0 * 32);
                    s0 = MFMA32(k0, qv, s0); s1 = MFMA32(k1, qv, s1);
                    if (d0 == 1) __builtin_amdgcn_sched_barrier(0);
                }
                __builtin_amdgcn_sched_barrier(0);
                float ls = 0.f, ls2 = 0.f;
#pragma unroll
                for (int i = 0; i < 16; ++i) { float e0 = __builtin_amdgcn_exp2f(s0[i]), e1 = __builtin_amdgcn_exp2f(s1[i]); asm volatile("" : "+v"(e0), "+v"(e1)); s0[i] = e0; s1[i] = e1; ls += e0; ls2 += e1; }
                ls += ls2;
                l[m] += ls;
                const bf16x8 p0 = packp(s0, 0), p1 = packp(s0, 1), p2 = packp(s1, 0), p3 = packp(s1, 1);
                __builtin_amdgcn_sched_barrier(0);
#pragma unroll
                for (int db = 0; db < 4; ++db) {
                    const LAS unsigned char* vb = Vb + db * 32 * VROW;
                    const bf16x8 v0 = *(const LAS bf16x8*)(vb + (0 ^ vxh)), v1 = *(const LAS bf16x8*)(vb + (32 ^ vxh)), v2 = *(const LAS bf16x8*)(vb + (64 ^ vxh)), v3 = *(const LAS bf16x8*)(vb + (96 ^ vxh));
                    o[m][db] = MFMA32(v0, p0, o[m][db]); o[m][db] = MFMA32(v1, p1, o[m][db]); o[m][db] = MFMA32(v2, p2, o[m][db]); o[m][db] = MFMA32(v3, p3, o[m][db]);
                    if (db == 1) __builtin_amdgcn_sched_barrier(0);
                }
                __builtin_amdgcn_sched_barrier(0);
            }
            asm volatile("s_waitcnt vmcnt(0)" ::: "memory");
            __syncthreads();
        }
        const float l0 = l[0] + __shfl_xor(l[0], 32), l1 = l[1] + __shfl_xor(l[1], 32);
        const float c0 = 1.0f / l0, c1 = lam / l1;
        float ss = 0.f;
#pragma unroll
        for (int db = 0; db < 4; ++db)
#pragma unroll
            for (int i = 0; i < 16; ++i) { const float v = o[0][db][i] * c0 - o[1][db][i] * c1; o[0][db][i] = v; ss += v * v; }
        ss += __shfl_xor(ss, 32);
        const float rstd = rsqrtf(ss * (1.0f / 128.0f) + EPSV);
        int lane2 = lane_id(); asm volatile("" : "+v"(lane2));
        bf16_t* orow = mixed + ((size_t)tok0 + qb * 256 + wid * 32 + (lane2 & 31)) * DM + h * 128 + 4 * (lane2 >> 5);
#pragma unroll
        for (int db = 0; db < 4; ++db)
#pragma unroll
            for (int i4 = 0; i4 < 4; ++i4) {
                u32x2 w; w.x = cvt_pk_bf16(o[0][db][4 * i4] * rstd, o[0][db][4 * i4 + 1] * rstd); w.y = cvt_pk_bf16(o[0][db][4 * i4 + 2] * rstd, o[0][db][4 * i4 + 3] * rstd);
                *(u32x2*)(orow + 32 * db + 8 * i4) = w;
            }
    }
    __builtin_amdgcn_s_setprio(0);
}


__global__ void __launch_bounds__(512) fwd_megakernel(Params p) {
    extern __shared__ __attribute__((aligned(16))) unsigned char lds_raw[];
    LAS unsigned char* lds = (LAS unsigned char*)lds_raw;
    cg::grid_group grid = cg::this_grid();
    unsigned char* ws = p.ws;
    const int G = gridDim.x, c = blockIdx.x;
    const int wave_s = __builtin_amdgcn_readfirstlane((int)threadIdx.x >> 6);
    bf16_t* WQKP = (bf16_t*)(ws + WS_WQKP); bf16_t* WV = (bf16_t*)(ws + WS_WV); bf16_t* WOUT = (bf16_t*)(ws + WS_WOUT); bf16_t* WUP = (bf16_t*)(ws + WS_WUP); bf16_t* WDN = (bf16_t*)(ws + WS_WDN);
    float* cosT = (float*)(ws + WS_COS); float* sinT = (float*)(ws + WS_SIN); float* rss = (float*)(ws + WS_RSS);
    bf16_t* Q = (bf16_t*)(ws + WS_Q); bf16_t* Kt = (bf16_t*)(ws + WS_K); bf16_t* VT = (bf16_t*)(ws + WS_VT); bf16_t* ZP = (bf16_t*)(ws + WS_ZP);
    bf16_t* H = (bf16_t*)(ws + WS_H); bf16_t* MIX = H; bf16_t* XB = (bf16_t*)(ws + WS_XB); bf16_t* ACT = (bf16_t*)(ws + WS_ACT);

#ifndef SKIP_P0
    p0_prologue(p, lds, wave_s);
#endif
    grid.sync();
#ifndef SKIP_P1
    {
        pg8::Gemm g{H, WQKP, MTOK, 1536, DM}; pg8::StaticOrder S; S.init(MTOK, 1536, G, c);
        EpiQKP E{ws, (const float*)(ws + WS_QKG), cosT, sinT};
        pg8::gemm_phase<EpiQKP, pg8::StaticOrder, true, true>(lds, g, S, E, wave_s);
    }
    {
        pg8::Gemm g{WV, H, 512, MTOK, DM}; pg8::StaticOrder S; S.init(512, MTOK, G, c);
        EpiVT E{VT};
        pg8::gemm_phase<EpiVT, pg8::StaticOrder, true, true>(lds, g, S, E, wave_s);
    }
#endif
    grid.sync();
#ifndef SKIP_P2
    pool_phase(ZP, MIX, wave_s);
    {
        float d1 = 0.f, d2 = 0.f;
        for (int i = 0; i < 64; ++i) { d1 += p.in[I_LQ1][i] * p.in[I_LK1][i]; d2 += p.in[I_LQ2][i] * p.in[I_LK2][i]; }
        const float lam = __builtin_bit_cast(float, __builtin_amdgcn_readfirstlane(__builtin_bit_cast(int, __expf(d1) - __expf(d2) + 0.2f)));
        float gq = 0.f, gk = 0.f;
        for (int i = 0; i < 64; ++i) { gq = fmaxf(gq, fabsf(p.in[I_QG][i])); gk = fmaxf(gk, fabsf(p.in[I_KG][i])); }
        const float bound = 64.0f * QSCALE * gq * gk;
        if (bound < 100.0f) attn_phase_fast(lds, Q, Kt, VT, MIX, lam, wave_s);
        else attn_phase_online(lds, Q, Kt, VT, MIX, lam, wave_s);
    }
#endif
    grid.sync();
#ifndef SKIP_P3
    {
        pg8::Gemm g{MIX, WOUT, MTOK, DM, DM}; pg8::StaticOrder S; S.init(MTOK, DM, G, c);
        EpiRes1 E{p.in[I_XP], p.in[I_XS], XB, rss};
        pg8::gemm_phase<EpiRes1, pg8::StaticOrder, true, true>(lds, g, S, E, wave_s);
    }
#endif
    grid.sync();
#ifndef SKIP_P4
    {
        pg8::Gemm g{XB, WUP, MTOK, 2 * DFF, DM}; pg8::StaticOrder S; S.init_tiles(517, 22, G, c, 1);
        EpiConvGate E{rss, p.in[I_CONVW], p.in[I_CONVB], ACT, (LAS float*)(lds + LDS_STAGE)};
        pg8::gemm_phase<EpiConvGate, pg8::StaticOrder, true, true>(lds, g, S, E, wave_s);
    }
#endif
    grid.sync();
#ifndef SKIP_P5
    {
        pg8::Gemm g{ACT, WDN, MTOK, DM, DFF}; pg8::StaticOrder S; S.init(MTOK, DM, G, c);
        EpiRes2 E{XB, p.out};
        pg8::gemm_phase<EpiRes2, pg8::StaticOrder, true, true>(lds, g, S, E, wave_s);
    }
#endif
}

extern "C" void kernel_launch(void* const* d_in, const int* in_sizes, int n_in, void* d_out, int out_size, void* d_ws, size_t ws_size, hipStream_t stream) {
    static int grid_blocks = 0;
    if (grid_blocks == 0) {
        if (n_in != 19 || ws_size < WS_END) { fprintf(stderr, "kernel_launch: unexpected n_in %d / ws_size %zu (need %zu)\n", n_in, ws_size, (size_t)WS_END); grid_blocks = -1; return; }
        int dev = 0, cus = 0, per_cu = 0;
        (void)hipGetDevice(&dev);
        (void)hipDeviceGetAttribute(&cus, hipDeviceAttributeMultiprocessorCount, dev);
        if (hipFuncSetAttribute((const void*)fwd_megakernel, hipFuncAttributeMaxDynamicSharedMemorySize, LDS_TOTAL) != hipSuccess) { fprintf(stderr, "kernel_launch: hipFuncSetAttribute failed\n"); grid_blocks = -1; return; }
        if (hipOccupancyMaxActiveBlocksPerMultiprocessor(&per_cu, (const void*)fwd_megakernel, 512, LDS_TOTAL) != hipSuccess || per_cu < 1) { fprintf(stderr, "kernel_launch: occupancy query failed (%d)\n", per_cu); (void)hipGetLastError(); per_cu = 1; }
        grid_blocks = cus * per_cu;
    }
    if (grid_blocks < 0) return;
    Params p{};
    for (int i = 0; i < 19; ++i) p.in[i] = (const float*)d_in[i];
    p.out = (float*)d_out; p.ws = (unsigned char*)d_ws;
    void* args[] = {&p};
    hipError_t e = hipLaunchCooperativeKernel((const void*)fwd_megakernel, dim3(grid_blocks), dim3(512), args, LDS_TOTAL, stream);
    if (e != hipSuccess) fprintf(stderr, "cooperative launch failed: %s (grid %d)\n", hipGetErrorString(e), grid_blocks);
}
```

```cpp
#include <hip/hip_runtime.h>
#include <hip/hip_cooperative_groups.h>
#include <cstdio>
#include <cstdint>
namespace cg = cooperative_groups;

namespace pg8 {
#define PG8_LAS __attribute__((address_space(3)))
typedef unsigned short bf16_t;
typedef short bf16x8 __attribute__((ext_vector_type(8)));
typedef float f32x4 __attribute__((ext_vector_type(4)));
typedef unsigned u32x4 __attribute__((ext_vector_type(4)));
constexpr int BM = 256, BK = 64, HALF = 128, HTB = HALF * BK * 2  , STAGE_BYTES = 8 * HTB, NXCD = 8, WGM = 8;

__host__ __device__ __forceinline__ int lds_byte(int r, int c) { const int st = (r >> 4) * 2 + (c >> 5), rr = r & 15, cc = c & 31, ob = rr * 64 + cc * 2; return st * 1024 + (ob ^ (((ob >> 9) & 1) << 5)); }
__host__ __device__ __forceinline__ void stage_rc(int b, int& R, int& C) { const int st = b / 1024, sb = b % 1024, swz = sb ^ (((sb >> 9) & 1) << 5); R = (st >> 1) * 16 + swz / 64; C = (st & 1) * 32 + (swz % 64) / 2; }
__host__ __device__ __forceinline__ int perm32(int rho) { const int n = rho >> 4, i = rho & 15; return 8 * (i >> 2) + 4 * n + (i & 3); }

struct Unit { int pm, pn; };
struct Gemm { const bf16_t* A; const bf16_t* Bt; int M, N, K; };

struct StaticOrder {
    int nM, nN, nwg, G, c; int halo;
    __host__ __device__ void init_tiles(int nM_, int nN_, int G_, int c_, int halo_) { nM = nM_; nN = nN_; nwg = nM * nN; G = G_; c = c_; halo = halo_; }
    __device__ __forceinline__ long a_off(int pm, int K) const { return halo ? ((long)254 * pm - 1) * (long)K * 2 : (long)pm * 256 * (long)K * 2; }
    __host__ __device__ void init(int M, int N, int G_, int c_) { nM = M / BM; nN = N / BM; nwg = nM * nN; G = G_; c = c_; halo = 0; }
    __host__ __device__ bool next(int i, Unit& u) const {
        const long L = (long)i * G + c; if (L >= nwg) return false;
        int wgid = (int)L; { const int q = nwg / NXCD, r = nwg % NXCD, xcd = wgid % NXCD, off = wgid / NXCD; wgid = (xcd < r ? xcd * (q + 1) : r * (q + 1) + (xcd - r) * q) + off; }
        const int nig = WGM * nN, gid = wgid / nig, fm = gid * WGM, gsz = (nM - fm) < WGM ? (nM - fm) : WGM;
        u.pm = fm + ((wgid % nig) % gsz); u.pn = (wgid % nig) / gsz; return true;
    }
    __device__ __forceinline__ void a_ready(const Unit&) const {}
    __device__ __forceinline__ void done(const Unit&) const {}
};
__device__ __forceinline__ unsigned cvt_pk_bf16(float lo, float hi) { unsigned r; asm volatile("v_cvt_pk_bf16_f32 %0, %1, %2" : "=v"(r) : "v"(lo), "v"(hi)); return r; }
typedef float f32x2 __attribute__((ext_vector_type(2)));
typedef float f32x2 __attribute__((ext_vector_type(2)));
template <class Epi, class Sched, bool ALIGN_EPI = false, bool SP2 = false>
__device__ __forceinline__ void gemm_phase(PG8_LAS unsigned char* lds, const Gemm g, const Sched& S, const Epi& E, const int wave_s) {
    int tid_; asm volatile("v_mbcnt_lo_u32_b32 %0, -1, 0\n\tv_mbcnt_hi_u32_b32 %0, -1, %0" : "=v"(tid_)); tid_ += wave_s * 64;
    const int tid = tid_, wid = __builtin_amdgcn_readfirstlane(tid >> 6), lane = tid & 63, wr = wid >> 2, wc = wid & 3, fr = lane & 15, fq = lane >> 4;
    const int K = g.K, nt = K / BK;
    unsigned voffA[2], voffB[2];
#pragma unroll
    for (int i = 0; i < 2; ++i) { int R, C; stage_rc(tid * 16 + i * 8192, R, C); const int Rb = Epi::PERM ? ((R & ~31) + perm32(R & 31)) : R;
        voffA[i] = (unsigned)(R * K + C) * 2u; voffB[i] = (unsigned)(Rb * K + C) * 2u; }
    const size_t kstep = (size_t)(BK * 2);
    const size_t hstep = (size_t)HALF * K * 2;
    const size_t tstep = 2 * hstep;
    const unsigned ldsw = (unsigned)wid * 1024u;
    const int aoff = lds_byte(wr * 64 + fr, fq * 8), boff = lds_byte(wc * 32 + fr, fq * 8);
#define PG8_SA(b, h) (((b) * 2 + (h)) * HTB)
#define PG8_SB(b, h) ((4 + (b) * 2 + (h)) * HTB)
#define PG8_STAGE(bufoff, gbase, voff) do { _Pragma("unroll") for (int _i = 0; _i < 2; ++_i) \
        __builtin_amdgcn_global_load_lds((const unsigned*)((const char*)(gbase) + (voff)[_i]), (PG8_LAS unsigned*)(lds + (bufoff) + ldsw + _i * 8192), 16, 0, 0); } while (0)
#define PG8_LDA(dst, b, h) do { _Pragma("unroll") for (int m = 0; m < 4; ++m) _Pragma("unroll") for (int k = 0; k < 2; ++k) dst[m][k] = *(const PG8_LAS bf16x8*)(lds + PG8_SA(b, h) + aoff + m * 2048 + k * 1024); } while (0)
#define PG8_LDB(dst, b, h) do { _Pragma("unroll") for (int n = 0; n < 2; ++n) _Pragma("unroll") for (int k = 0; k < 2; ++k) dst[n][k] = *(const PG8_LAS bf16x8*)(lds + PG8_SB(b, h) + boff + n * 2048 + k * 1024); } while (0)
#define PG8_MMA(ai, bj, At, Bt) do { __builtin_amdgcn_s_setprio(1); _Pragma("unroll") for (int m = 0; m < 4; ++m) _Pragma("unroll") for (int n = 0; n < 2; ++n) _Pragma("unroll") for (int k = 0; k < 2; ++k) \
        acc[ai][bj][m][n] = __builtin_amdgcn_mfma_f32_16x16x32_bf16(Bt[n][k], At[m][k], acc[ai][bj][m][n], 0, 0, 0); __builtin_amdgcn_s_setprio(0); } while (0)
#define PG8_WAIT_V(n) asm volatile("s_waitcnt vmcnt(" #n ")" ::: "memory")
#define PG8_WAIT_L(n) asm volatile("s_waitcnt lgkmcnt(" #n ")" ::: "memory")
#define PG8_BAR __builtin_amdgcn_s_barrier()
#define PG8_SCHED __builtin_amdgcn_sched_barrier(0)
    Unit cur, nxt; int ui = 0;
    if (!S.next(0, cur)) return;
    f32x4 acc[2][2][4][2];
#pragma unroll
    for (int a = 0; a < 2; ++a)
#pragma unroll
        for (int b = 0; b < 2; ++b)
#pragma unroll
            for (int m = 0; m < 4; ++m)
#pragma unroll
                for (int n = 0; n < 2; ++n) acc[a][b][m][n] = (f32x4){0.f, 0.f, 0.f, 0.f};
    bf16x8 At[4][2], B0[2][2], B1[2][2];
    const char* cA = (const char*)g.A + S.a_off(cur.pm, K); const char* cB = (const char*)g.Bt + (size_t)cur.pn * tstep;
    S.a_ready(cur);
    if constexpr (SP2) {
        PG8_STAGE(PG8_SB(0, 0), cB, voffB); PG8_STAGE(PG8_SB(0, 1), cB + hstep, voffB); PG8_STAGE(PG8_SA(0, 0), cA, voffA); PG8_STAGE(PG8_SA(0, 1), cA + hstep, voffA);
        if (wr == 1) PG8_BAR;
        PG8_WAIT_V(2); PG8_BAR;
        PG8_STAGE(PG8_SB(1, 0), cB + kstep, voffB); PG8_STAGE(PG8_SA(1, 0), cA + kstep, voffA); PG8_STAGE(PG8_SB(1, 1), cB + hstep + kstep, voffB);
        PG8_WAIT_V(6); PG8_BAR;
    } else {
        PG8_STAGE(PG8_SB(0, 0), cB, voffB); PG8_STAGE(PG8_SA(0, 0), cA, voffA); PG8_STAGE(PG8_SB(0, 1), cB + hstep, voffB); PG8_STAGE(PG8_SA(0, 1), cA + hstep, voffA);
        if (wr == 1) PG8_BAR;
        PG8_WAIT_V(4); PG8_BAR;
        PG8_STAGE(PG8_SB(1, 0), cB + kstep, voffB); PG8_STAGE(PG8_SA(1, 0), cA + kstep, voffA); PG8_STAGE(PG8_SB(1, 1), cB + hstep + kstep, voffB);
        PG8_WAIT_V(6); PG8_BAR;
    }
    for (;;) {
        const bool has_next = S.next(ui + 1, nxt);
        const char* nA = has_next ? (const char*)g.A + S.a_off(nxt.pm, K) : cA; const char* nB = has_next ? (const char*)g.Bt + (size_t)nxt.pn * tstep : cB;
        for (int t = 0; t < nt; t += 2) {
            const bool last = (t == nt - 2);
            const char* a1 = cA + (size_t)(t + 1) * kstep;
            const char* a2 = last ? nA : cA + (size_t)(t + 2) * kstep; const char* b2 = last ? nB : cB + (size_t)(t + 2) * kstep;
            const char* a3 = a2 + kstep; const char* b3 = b2 + kstep;
            if (last && has_next) S.a_ready(nxt);
            if constexpr (SP2) {
            PG8_LDB(B0, 0, 0); PG8_LDB(B1, 0, 1); PG8_SCHED; PG8_LDA(At, 0, 0); PG8_STAGE(PG8_SA(1, 1), a1 + hstep, voffA);
            PG8_WAIT_V(8); PG8_WAIT_L(0); PG8_BAR; PG8_MMA(0, 0, At, B0); PG8_MMA(0, 1, At, B1); PG8_BAR; PG8_SCHED;
            PG8_LDA(At, 0, 1); PG8_STAGE(PG8_SB(0, 0), b2, voffB); PG8_STAGE(PG8_SB(0, 1), b2 + hstep, voffB); PG8_STAGE(PG8_SA(0, 0), a2, voffA);
            PG8_WAIT_V(8); PG8_WAIT_L(0); PG8_BAR; PG8_MMA(1, 0, At, B0); PG8_MMA(1, 1, At, B1); PG8_BAR; PG8_SCHED;
            PG8_LDB(B0, 1, 0); PG8_LDB(B1, 1, 1); PG8_SCHED; PG8_LDA(At, 1, 0); PG8_STAGE(PG8_SA(0, 1), a2 + hstep, voffA);
            PG8_WAIT_V(8); PG8_WAIT_L(0); PG8_BAR; PG8_MMA(0, 0, At, B0); PG8_MMA(0, 1, At, B1); PG8_BAR; PG8_SCHED;
            PG8_LDA(At, 1, 1); PG8_STAGE(PG8_SB(1, 0), b3, voffB); PG8_STAGE(PG8_SB(1, 1), b3 + hstep, voffB); PG8_STAGE(PG8_SA(1, 0), a3, voffA);
            PG8_WAIT_V(8); PG8_WAIT_L(0); PG8_BAR; PG8_MMA(1, 0, At, B0); PG8_MMA(1, 1, At, B1); PG8_BAR; PG8_SCHED;
            } else {
            PG8_LDB(B0, 0, 0); PG8_SCHED; PG8_LDA(At, 0, 0); PG8_STAGE(PG8_SA(1, 1), a1 + hstep, voffA);
            PG8_WAIT_L(8); PG8_BAR; PG8_WAIT_L(0); PG8_MMA(0, 0, At, B0); PG8_BAR; PG8_SCHED;
            PG8_LDB(B1, 0, 1); PG8_STAGE(PG8_SB(0, 0), b2, voffB);
            PG8_BAR; PG8_WAIT_L(0); PG8_MMA(0, 1, At, B1); PG8_BAR;
            PG8_LDA(At, 0, 1); PG8_STAGE(PG8_SA(0, 0), a2, voffA);
            PG8_BAR; PG8_WAIT_L(0); PG8_MMA(1, 0, At, B0); PG8_BAR; PG8_SCHED;
            PG8_STAGE(PG8_SB(0, 1), b2 + hstep, voffB);
            PG8_WAIT_V(6); PG8_BAR; PG8_MMA(1, 1, At, B1); PG8_BAR;
            PG8_LDB(B0, 1, 0); PG8_SCHED; PG8_LDA(At, 1, 0); PG8_STAGE(PG8_SA(0, 1), a2 + hstep, voffA);
            PG8_WAIT_L(8); PG8_BAR; PG8_WAIT_L(0); PG8_MMA(0, 0, At, B0); PG8_BAR; PG8_SCHED;
            PG8_LDB(B1, 1, 1); PG8_STAGE(PG8_SB(1, 0), b3, voffB);
            PG8_BAR; PG8_WAIT_L(0); PG8_MMA(0, 1, At, B1); PG8_BAR;
            PG8_LDA(At, 1, 1); PG8_STAGE(PG8_SA(1, 0), a3, voffA);
            PG8_BAR; PG8_WAIT_L(0); PG8_MMA(1, 0, At, B0); PG8_BAR; PG8_SCHED;
            PG8_STAGE(PG8_SB(1, 1), b3 + hstep, voffB);
            PG8_WAIT_V(6); PG8_BAR; PG8_MMA(1, 1, At, B1); PG8_BAR;
            }
        }
        if constexpr (ALIGN_EPI) { if (wr == 0) PG8_BAR; }
        if constexpr (!Epi::AFTER_DRAIN) { E(acc, cur, wr, wc, fr, fq); S.done(cur); }
        if (!has_next) break;
#pragma unroll
        for (int a = 0; a < 2; ++a)
#pragma unroll
            for (int b = 0; b < 2; ++b)
#pragma unroll
                for (int m = 0; m < 4; ++m)
#pragma unroll
                    for (int n = 0; n < 2; ++n) acc[a][b][m][n] = (f32x4){0.f, 0.f, 0.f, 0.f};
        cur = nxt; cA = nA; cB = nB; ++ui;
        if constexpr (ALIGN_EPI) { if (wr == 1) PG8_BAR; }
    }
    PG8_WAIT_V(0);
    if constexpr (!ALIGN_EPI) { if (wr == 0) PG8_BAR; }
    PG8_BAR;
    if constexpr (Epi::AFTER_DRAIN) { E.fused(acc, cur, wr, wc, fr, fq, lds, wid, lane); S.done(cur); }
#undef PG8_SA
#undef PG8_SB
#undef PG8_STAGE
#undef PG8_LDA
#undef PG8_LDB
#undef PG8_MMA
#undef PG8_WAIT_V
#undef PG8_WAIT_L
#undef PG8_BAR
#undef PG8_SCHED
}
}

using pg8::bf16_t; using pg8::bf16x8; using pg8::f32x4; using pg8::u32x4; using pg8::Unit; using pg8::cvt_pk_bf16;
#define LAS __attribute__((address_space(3)))
typedef float f32x16 __attribute__((ext_vector_type(16)));
typedef unsigned u32x2 __attribute__((ext_vector_type(2)));
constexpr int DM = 1024, MTOK = 131072, NPROMPT = 65536, SEQP = 4096, SEQS = 8192, DFF = 2816;
constexpr float EPSV = 1e-6f;
constexpr float QSCALE = 0.125f * 1.4426950408889634f;
constexpr size_t MiB = 1024 * 1024;
constexpr size_t WS_WQKP = 0, WS_WV = 3 * MiB, WS_WOUT = 4 * MiB, WS_WUP = 6 * MiB, WS_WDN = 17 * MiB, WS_COS = 23 * MiB, WS_SIN = 24 * MiB, WS_RSS = 25 * MiB, WS_QKG = 25 * MiB + 768 * 1024,
                 WS_XB = 26 * MiB, WS_Q = WS_XB, WS_K = WS_XB + 128 * MiB, WS_ACT = 282 * MiB, WS_VT = WS_ACT, WS_ZP = WS_ACT + 128 * MiB, WS_H = WS_ACT + 256 * MiB,
                 WS_END = WS_ACT + 704 * MiB;
constexpr int LDS_STAGE = 131072, LDS_EDGE = 8192, LDS_TOTAL = 147456;

struct Params {
    const float* in[19];
    float* out;
    unsigned char* ws;
};
enum { I_XP = 0, I_XS, I_N1G, I_WIN, I_QG, I_KG, I_LQ1, I_LK1, I_LQ2, I_LK2, I_SUBG, I_WPOOL, I_PSCALE, I_WOUT, I_N2G, I_WUP, I_CONVW, I_CONVB, I_WDOWN };

__device__ __forceinline__ int lane_id() { int l; asm volatile("v_mbcnt_lo_u32_b32 %0, -1, 0\n\tv_mbcnt_hi_u32_b32 %0, -1, %0" : "=v"(l)); return l; }
__device__ __forceinline__ bf16_t f2bf(float x) { unsigned u = __float_as_uint(x); u += 0x7fffu + ((u >> 16) & 1u); return (bf16_t)(u >> 16); }
__device__ __forceinline__ float bf2f(unsigned short b) { return __uint_as_float(((unsigned)b) << 16); }
__device__ __forceinline__ float bflo(unsigned w) { return __uint_as_float(w << 16); }
__device__ __forceinline__ float bfhi(unsigned w) { return __uint_as_float(w & 0xffff0000u); }
__device__ __forceinline__ u32x4 pack8(f32x4 a, f32x4 b) { u32x4 w; w.x = cvt_pk_bf16(a[0], a[1]); w.y = cvt_pk_bf16(a[2], a[3]); w.z = cvt_pk_bf16(b[0], b[1]); w.w = cvt_pk_bf16(b[2], b[3]); return w; }
__device__ __forceinline__ u32x2 pack4(f32x4 a) { u32x2 w; w.x = cvt_pk_bf16(a[0], a[1]); w.y = cvt_pk_bf16(a[2], a[3]); return w; }

struct EpiQKP {
    static constexpr bool PERM = true, AFTER_DRAIN = false;
    unsigned char* ws; const float *qkg  , *cosT, *sinT;
    __device__ __forceinline__ void operator()(f32x4 (&acc)[2][2][4][2], const Unit& u, int wr, int wc, int fr, int fq) const {
        const int kind = u.pn >> 1;
        bf16_t* base = (bf16_t*)(ws + (kind == 0 ? WS_Q : (kind == 1 ? WS_K : WS_ZP)));
        const int colbase = (u.pn & 1) * 256 + wc * 64, i0 = 8 * fq;
        if (kind < 2) {
            const float* g = qkg + kind * 64;
            const float osc = kind == 0 ? QSCALE : 1.0f;
            const f32x4 g00 = *(const f32x4*)(g + i0), g01 = *(const f32x4*)(g + i0 + 4), g10 = *(const f32x4*)(g + 32 + i0), g11 = *(const f32x4*)(g + 32 + i0 + 4);
#pragma unroll
            for (int ai = 0; ai < 2; ++ai)
#pragma unroll
                for (int m = 0; m < 4; ++m) {
                    const int row = u.pm * 256 + ai * 128 + wr * 64 + m * 16 + fr;
                    const int pos = row < NPROMPT ? (row & (SEQP - 1)) : (row & (SEQS - 1));
                    const f32x4 a00 = acc[ai][0][m][0], a01 = acc[ai][0][m][1], a10 = acc[ai][1][m][0], a11 = acc[ai][1][m][1];
                    f32x4 sq = a00 * a00 + a01 * a01 + a10 * a10 + a11 * a11;
                    float ss = (sq[0] + sq[1]) + (sq[2] + sq[3]);
                    ss += __shfl_xor(ss, 16); ss += __shfl_xor(ss, 32);
                    const float rstd = rsqrtf(ss * (1.0f / 64.0f) + EPSV) * osc;
                    const f32x4 cs0 = *(const f32x4*)(cosT + pos * 32 + i0), sn0 = *(const f32x4*)(sinT + pos * 32 + i0);
                    const f32x4 cs1 = *(const f32x4*)(cosT + pos * 32 + i0 + 4), sn1 = *(const f32x4*)(sinT + pos * 32 + i0 + 4);
                    const f32x4 y00 = a00 * rstd * g00, y01 = a01 * rstd * g01, y10 = a10 * rstd * g10, y11 = a11 * rstd * g11;
                    bf16_t* rp = base + (size_t)row * 512 + colbase + i0;
                    *(u32x4*)(rp) = pack8(y00 * cs0 - y10 * sn0, y01 * cs1 - y11 * sn1);
                    *(u32x4*)(rp + 32) = pack8(y10 * cs0 + y00 * sn0, y11 * cs1 + y01 * sn1);
                    asm volatile("" ::: "memory");
                }
        } else {
#pragma unroll
            for (int ai = 0; ai < 2; ++ai)
#pragma unroll
                for (int m = 0; m < 4; ++m) {
                    const int row = u.pm * 256 + ai * 128 + wr * 64 + m * 16 + fr;
                    bf16_t* rp = base + (size_t)row * 512 + colbase + i0;
#pragma unroll
                    for (int bj = 0; bj < 2; ++bj) *(u32x4*)(rp + 32 * bj) = pack8(acc[ai][bj][m][0], acc[ai][bj][m][1]);
                }
        }
    }
};
struct EpiVT {
    static constexpr bool PERM = true, AFTER_DRAIN = false;
    bf16_t* vT;
    __device__ __forceinline__ void operator()(f32x4 (&acc)[2][2][4][2], const Unit& u, int wr, int wc, int fr, int fq) const {
#pragma unroll
        for (int ai = 0; ai < 2; ++ai)
#pragma unroll
            for (int m = 0; m < 4; ++m) {
                const int row = u.pm * 256 + ai * 128 + wr * 64 + m * 16 + fr;
                bf16_t* rp = vT + (size_t)row * MTOK + (size_t)u.pn * 256 + wc * 32 + 16 * (fq >> 1) + 4 * (fq & 1);
#pragma unroll
                for (int bj = 0; bj < 2; ++bj)
#pragma unroll
                    for (int n = 0; n < 2; ++n) *(u32x2*)(rp + 128 * bj + 8 * n) = pack4(acc[ai][bj][m][n]);
            }
    }
};
struct EpiRes1 {
    static constexpr bool PERM = true, AFTER_DRAIN = false;
    const float *xp, *xs; bf16_t* xb; float* rss;
    __device__ __forceinline__ void operator()(f32x4 (&acc)[2][2][4][2], const Unit& u, int wr, int wc, int fr, int fq) const {
        const int col0 = u.pn * 256 + wc * 32 + 8 * fq;
#pragma unroll
        for (int ai = 0; ai < 2; ++ai)
#pragma unroll
            for (int m = 0; m < 4; ++m) {
                const int row = u.pm * 256 + ai * 128 + wr * 64 + m * 16 + fr;
                const float* xr = (row < NPROMPT ? xp + (size_t)row * DM : xs + (size_t)(row - NPROMPT) * DM) + col0;
                bf16_t* brow = xb + (size_t)row * DM + col0;
                float ss = 0.f;
#pragma unroll
                for (int bj = 0; bj < 2; ++bj) {
                    const f32x4 a = acc[ai][bj][m][0] + *(const f32x4*)(xr + 128 * bj), b = acc[ai][bj][m][1] + *(const f32x4*)(xr + 128 * bj + 4);
                    *(u32x4*)(brow + 128 * bj) = pack8(a, b);
                    ss += (a[0] * a[0] + a[1] * a[1]) + (a[2] * a[2] + a[3] * a[3]) + (b[0] * b[0] + b[1] * b[1]) + (b[2] * b[2] + b[3] * b[3]);
                }
                ss += __shfl_xor(ss, 16); ss += __shfl_xor(ss, 32);
                if (fq == 0) atomicAdd(rss + row, ss);
                asm volatile("" ::: "memory");
            }
    }
};
struct EpiRes2 {
    static constexpr bool PERM = true, AFTER_DRAIN = false;
    const bf16_t* xb; float* out;
    __device__ __forceinline__ void operator()(f32x4 (&acc)[2][2][4][2], const Unit& u, int wr, int wc, int fr, int fq) const {
        const int col0 = u.pn * 256 + wc * 32 + 8 * fq;
#pragma unroll
        for (int ai = 0; ai < 2; ++ai)
#pragma unroll
            for (int m = 0; m < 4; ++m) {
                const int row = u.pm * 256 + ai * 128 + wr * 64 + m * 16 + fr;
                float* orow = out + (size_t)row * DM + col0; const bf16_t* brow = xb + (size_t)row * DM + col0;
#pragma unroll
                for (int bj = 0; bj < 2; ++bj) {
                    const u32x4 w = *(const u32x4*)(brow + 128 * bj);
                    const f32x4 a = acc[ai][bj][m][0] + (f32x4){bflo(w.x), bfhi(w.x), bflo(w.y), bfhi(w.y)}, b = acc[ai][bj][m][1] + (f32x4){bflo(w.z), bfhi(w.z), bflo(w.w), bfhi(w.w)};
                    *(f32x4*)(orow + 128 * bj) = a; *(f32x4*)(orow + 128 * bj + 4) = b;
                }
                asm volatile("" ::: "memory");
            }
    }
};
__device__ __forceinline__ float dpp_ror1(float v) { return __builtin_bit_cast(float, __builtin_amdgcn_update_dpp(0, __builtin_bit_cast(int, v), 0x121, 0xf, 0xf, false)); }
__device__ __forceinline__ float dpp_ror15(float v) { return __builtin_bit_cast(float, __builtin_amdgcn_update_dpp(0, __builtin_bit_cast(int, v), 0x12F, 0xf, 0xf, false)); }
struct EpiConvGate {
    static constexpr bool PERM = true, AFTER_DRAIN = false;
    const float *rss, *convw, *convb; bf16_t* act; LAS float* edge;
    template <bool BND> __device__ __forceinline__ void conv_gate(f32x4 (&acc)[2][2][4][2], const Unit& u, int wr, int wc, int fr, int fq, int tok0, int pcol) const {
        const int fcol = u.pn * 128 + pcol;
#pragma unroll
        for (int n = 0; n < 2; ++n) {
            f32x4 w0[2], w1[2], w2[2], bb[2];
#pragma unroll
            for (int bj = 0; bj < 2; ++bj) { const int c = bj * DFF + fcol + 4 * n;
                w0[bj] = *(const f32x4*)(convw + c); w1[bj] = *(const f32x4*)(convw + 2 * DFF + c); w2[bj] = *(const f32x4*)(convw + 4 * DFF + c); bb[bj] = *(const f32x4*)(convb + c); }
#pragma unroll
            for (int ai = 0; ai < 2; ++ai) {
                const int blk = 2 * ai + wr;
                f32x4 pe[2], ne[2];
#pragma unroll
                for (int bj = 0; bj < 2; ++bj) {
                    pe[bj] = blk > 0 ? *(const LAS f32x4*)(edge + ((blk - 1) * 2 + 1) * 256 + 128 * bj + pcol + 4 * n) : (f32x4){0.f, 0.f, 0.f, 0.f};
                    ne[bj] = blk < 3 ? *(const LAS f32x4*)(edge + ((blk + 1) * 2 + 0) * 256 + 128 * bj + pcol + 4 * n) : (f32x4){0.f, 0.f, 0.f, 0.f};
                }
#pragma unroll
                for (int m = 0; m < 4; ++m) {
                    const int r = ai * 128 + wr * 64 + m * 16 + fr, tok = tok0 + r;
                    bool isfirst = false, islast = false;
                    if (BND) { const int S1 = (tok < NPROMPT ? SEQP : SEQS) - 1, pos = tok & S1; isfirst = pos == 0; islast = pos == S1; }
                    f32x4 cv[2];
#pragma unroll
                    for (int bj = 0; bj < 2; ++bj) {
                        const f32x4 cur = acc[ai][bj][m][n];
                        const f32x4 ups = m > 0 ? acc[ai][bj][m > 0 ? m - 1 : 0][n] : pe[bj];
                        const f32x4 dns = m < 3 ? acc[ai][bj][m < 3 ? m + 1 : 3][n] : ne[bj];
                        f32x4 prev, next;
#pragma unroll
                        for (int j = 0; j < 4; ++j) {
                            const float t1 = fr == 15 ? ups[j] : cur[j]; float pv = dpp_ror1(t1);
                            const float t2 = fr == 0 ? dns[j] : cur[j]; float nx = dpp_ror15(t2);
                            if (BND) { prev[j] = isfirst ? 0.f : pv; next[j] = islast ? 0.f : nx; } else { prev[j] = pv; next[j] = nx; }
                        }
                        cv[bj] = w0[bj] * prev + w1[bj] * cur + w2[bj] * next + bb[bj];
                    }
                    f32x4 a;
#pragma unroll
                    for (int j = 0; j < 4; ++j) { const float g = cv[0][j]; const float sg = __builtin_amdgcn_rcpf(1.0f + __builtin_amdgcn_exp2f(-1.4426950408889634f * g)); a[j] = g * sg * cv[1][j]; }
                    if (r >= 1 && r <= 254 && (!BND || tok < MTOK)) *(u32x2*)(act + (size_t)tok * DFF + fcol + 4 * n) = pack4(a);
                    asm volatile("" ::: "memory");
                }
            }
        }
    }
    __device__ __forceinline__ void operator()(f32x4 (&acc)[2][2][4][2], const Unit& u, int wr, int wc, int fr, int fq) const {
        asm volatile("" : "+v"(fr), "+v"(fq));
        const int tok0 = 254 * u.pm - 1;
        const int pcol = wc * 32 + 8 * fq;
        const bool bnd = (tok0 < 0) || (((tok0 & (SEQP - 1)) + 256) >= SEQP) || (tok0 + 256 > MTOK);
#pragma unroll
        for (int ai = 0; ai < 2; ++ai)
#pragma unroll
            for (int m = 0; m < 4; ++m) {
                const int tok = tok0 + ai * 128 + wr * 64 + m * 16 + fr;
                if (bnd) {
                    const bool valid = (tok >= 0) && (tok < MTOK);
                    float rs = 0.f; if (valid) rs = rsqrtf(rss[tok] * (1.0f / 1024.0f) + EPSV);
#pragma unroll
                    for (int bj = 0; bj < 2; ++bj)
#pragma unroll
                        for (int n = 0; n < 2; ++n) { f32x4 x = acc[ai][bj][m][n] * rs;
#pragma unroll
                            for (int j = 0; j < 4; ++j) x[j] = valid ? x[j] : 0.f;
                            acc[ai][bj][m][n] = x; }
                } else {
                    const float rs = rsqrtf(rss[tok] * (1.0f / 1024.0f) + EPSV);
#pragma unroll
                    for (int bj = 0; bj < 2; ++bj)
#pragma unroll
                        for (int n = 0; n < 2; ++n) acc[ai][bj][m][n] = acc[ai][bj][m][n] * rs;
                }
            }
#pragma unroll
        for (int ai = 0; ai < 2; ++ai) {
            const int blk = 2 * ai + wr;
            if (fr == 0) {
#pragma unroll
                for (int bj = 0; bj < 2; ++bj)
#pragma unroll
                    for (int n = 0; n < 2; ++n) *(LAS f32x4*)(edge + (blk * 2 + 0) * 256 + 128 * bj + pcol + 4 * n) = acc[ai][bj][0][n];
            }
            if (fr == 15) {
#pragma unroll
                for (int bj = 0; bj < 2; ++bj)
#pragma unroll
                    for (int n = 0; n < 2; ++n) *(LAS f32x4*)(edge + (blk * 2 + 1) * 256 + 128 * bj + pcol + 4 * n) = acc[ai][bj][3][n];
            }
        }
        asm volatile("s_waitcnt lgkmcnt(0)\n\ts_barrier" ::: "memory");
        if (bnd) conv_gate<true>(acc, u, wr, wc, fr, fq, tok0, pcol); else conv_gate<false>(acc, u, wr, wc, fr, fq, tok0, pcol);
    }
};

__device__ __forceinline__ void p0_prologue(const Params& p, LAS unsigned char* lds, const int wave_s) {
    int tid_ = wave_s * 64 + lane_id(); asm volatile("" : "+v"(tid_));
    const int tid = tid_, G = gridDim.x, gt = blockIdx.x * 512 + tid, GT = G * 512, lane = tid & 63, wid = tid >> 6;
    unsigned char* ws = p.ws;
    bf16_t* WQKP = (bf16_t*)(ws + WS_WQKP); bf16_t* WV = (bf16_t*)(ws + WS_WV); bf16_t* WOUT = (bf16_t*)(ws + WS_WOUT); bf16_t* WUP = (bf16_t*)(ws + WS_WUP); bf16_t* WDN = (bf16_t*)(ws + WS_WDN);
    LAS float* tile = (LAS float*)lds;
    for (int t = blockIdx.x; t < 2752; t += G) {
        const float* src; int ld, k0, n0, kind;
        if (t < 512) { kind = 0; k0 = (t >> 5) * 64; n0 = (t & 31) * 64; src = p.in[I_WIN]; ld = 2048; }
        else if (t < 640) { const int u = t - 512; kind = 1; k0 = (u >> 4) * 64; n0 = (u & 15) * 64; src = p.in[I_WOUT]; ld = 1024; }
        else if (t < 2048) { const int u = t - 640; kind = 2; k0 = (u / 88) * 64; n0 = (u % 88) * 64; src = p.in[I_WUP]; ld = 5632; }
        else { const int u = t - 2048; kind = 3; k0 = (u >> 4) * 64; n0 = (u & 15) * 64; src = p.in[I_WDOWN]; ld = 1024; }
#pragma unroll
        for (int i = 0; i < 8; ++i) { const int e = tid + i * 512, kk = e >> 6, nn = e & 63;
            float v = src[(size_t)(k0 + kk) * ld + n0 + nn];
            if (kind == 1) v *= p.in[I_SUBG][(k0 + kk) & 127] * 0.8f;
            if (kind == 2) v *= p.in[I_N2G][k0 + kk];
            tile[kk * 65 + nn] = v; }
        __syncthreads();
#pragma unroll
        for (int i = 0; i < 8; ++i) { const int e = tid + i * 512, nn = e >> 6, kk = e & 63, n = n0 + nn; bf16_t* dst;
            if (kind == 0) {
                if (n < 1024 || n >= 1536) { const int L = n < 1024 ? n : n - 512; const int prow = (L & ~255) + ((L >> 5) & 1) * 128 + ((L >> 6) & 3) * 32 + (L & 31); dst = WQKP + (size_t)prow * 1024 + k0 + kk; }
                else dst = WV + (size_t)(n - 1024) * 1024 + k0 + kk;
            } else if (kind == 1) dst = WOUT + (size_t)n * 1024 + k0 + kk;
            else if (kind == 2) { const int f = n < DFF ? n : n - DFF; const int prow = (f >> 7) * 256 + (n < DFF ? 0 : 128) + (f & 127); dst = WUP + (size_t)prow * 1024 + k0 + kk; }
            else dst = WDN + (size_t)n * DFF + k0 + kk;
            *dst = f2bf(tile[kk * 65 + nn]); }
        __syncthreads();
    }
    for (int o = gt; o < 128 * 1024; o += GT) {
        const int n = o & 1023, c = o >> 10;
        const float* wo = p.in[I_WOUT] + (size_t)512 * 1024 + n;
        float a0 = 0.f, a1 = 0.f, a2 = 0.f, a3 = 0.f;
        const float* wp = p.in[I_WPOOL] + (size_t)c * 128; const float* ps = p.in[I_PSCALE];
#pragma unroll 8
        for (int e = 0; e < 128; ++e) {
            a0 += wp[e] * ps[e] * wo[(size_t)e * 1024];
            a1 += wp[16384 + e] * ps[128 + e] * wo[(size_t)(128 + e) * 1024];
            a2 += wp[32768 + e] * ps[256 + e] * wo[(size_t)(256 + e) * 1024];
            a3 += wp[49152 + e] * ps[384 + e] * wo[(size_t)(384 + e) * 1024];
        }
        bf16_t* dst = WOUT + (size_t)n * 1024 + 512 + c;
        dst[0] = f2bf(a0); dst[128] = f2bf(a1); dst[256] = f2bf(a2); dst[384] = f2bf(a3);
    }
    float* cosT = (float*)(ws + WS_COS); float* sinT = (float*)(ws + WS_SIN);
    for (int o = gt; o < 8192 * 32; o += GT) {
        const int s = o >> 5, i = o & 31;
        const float inv = exp2f(-(float)i * (13.287712379549449f / 32.0f));
        const float ang = (float)s * inv;
        const double rev = (double)ang * 0.15915494309189535; const float fr = (float)(rev - __builtin_rint(rev));
        cosT[o] = __builtin_amdgcn_cosf(fr); sinT[o] = __builtin_amdgcn_sinf(fr);
    }
    float* rss = (float*)(ws + WS_RSS);
    for (int o = gt; o < MTOK; o += GT) rss[o] = 0.f;
    if (gt < 128) ((float*)(ws + WS_QKG))[gt] = gt < 64 ? p.in[I_QG][gt] : p.in[I_KG][gt - 64];
    bf16_t* H = (bf16_t*)(ws + WS_H);
    f32x4 g1[4];
#pragma unroll
    for (int i = 0; i < 4; ++i) g1[i] = *(const f32x4*)(p.in[I_N1G] + lane * 4 + 256 * i);
    for (int row = blockIdx.x * 8 + wid; row < MTOK; row += G * 8) {
        const float* xr = (row < NPROMPT ? p.in[I_XP] + (size_t)row * DM : p.in[I_XS] + (size_t)(row - NPROMPT) * DM) + lane * 4;
        f32x4 v[4]; float ss = 0.f;
#pragma unroll
        for (int i = 0; i < 4; ++i) { v[i] = *(const f32x4*)(xr + 256 * i); ss += (v[i][0] * v[i][0] + v[i][1] * v[i][1]) + (v[i][2] * v[i][2] + v[i][3] * v[i][3]); }
#pragma unroll
        for (int o = 1; o < 64; o <<= 1) ss += __shfl_xor(ss, o);
        const float rstd = rsqrtf(ss * (1.0f / 1024.0f) + EPSV);
        bf16_t* hr = H + (size_t)row * DM + lane * 4;
#pragma unroll
        for (int i = 0; i < 4; ++i) *(u32x2*)(hr + 256 * i) = pack4(v[i] * rstd * g1[i]);
    }
}

__device__ __forceinline__ void pool_phase(const bf16_t* zp, bf16_t* mixed, const int wave_s) {
    const int lane = lane_id(), c0 = lane * 8, half = 1 << (lane >> 4);
    for (int r = blockIdx.x * 8 + wave_s; r < MTOK / 64; r += gridDim.x * 8) {
        const int tok_base = r * 64, S = tok_base < NPROMPT ? SEQP : SEQS, pos0 = tok_base & (S - 1);
        const bf16_t* zs = zp + (size_t)(tok_base - pos0) * 512 + c0;
        bf16_t* ms = mixed + (size_t)(tok_base - pos0) * DM + 512 + c0;
        float s0 = 0.f, s1 = 0.f, s2 = 0.f, s3 = 0.f, s4 = 0.f, s5 = 0.f, s6 = 0.f, s7 = 0.f;
#define POOL_ACC(V_, sg) do { s0 += sg bflo(V_.x); s1 += sg bfhi(V_.x); s2 += sg bflo(V_.y); s3 += sg bfhi(V_.y); s4 += sg bflo(V_.z); s5 += sg bfhi(V_.z); s6 += sg bflo(V_.w); s7 += sg bfhi(V_.w); } while (0)
#pragma unroll
        for (int d = -8; d < 8; ++d) { const int j = pos0 + d; if (d >= -half && d < half && j >= 0 && j < S) { const u32x4 w = *(const u32x4*)(zs + (size_t)j * 512); POOL_ACC(w, +); } }
#pragma unroll 4
        for (int i = 0; i < 64; ++i) {
            const int sp = pos0 + i, lo = max(sp - half, 0), hi = min(sp + half - 1, S - 1);
            const float ic = 1.0f / (float)(hi - lo + 1);
            const u32x4 w = *(const u32x4*)(zs + (size_t)sp * 512);
            u32x4 o;
            o.x = cvt_pk_bf16(s0 * ic - bflo(w.x), s1 * ic - bfhi(w.x)); o.y = cvt_pk_bf16(s2 * ic - bflo(w.y), s3 * ic - bfhi(w.y));
            o.z = cvt_pk_bf16(s4 * ic - bflo(w.z), s5 * ic - bfhi(w.z)); o.w = cvt_pk_bf16(s6 * ic - bflo(w.w), s7 * ic - bfhi(w.w));
            *(u32x4*)(ms + (size_t)sp * DM) = o;
            const int jn = sp + half, jo = sp - half;
            if (jn < S) { const u32x4 wn = *(const u32x4*)(zs + (size_t)jn * 512); POOL_ACC(wn, +); }
            if (jo >= 0) { const u32x4 wo = *(const u32x4*)(zs + (size_t)jo * 512); POOL_ACC(wo, -); }
        }
    }
}

#define MFMA32(a, b, c) __builtin_amdgcn_mfma_f32_32x32x16_bf16((a), (b), (c), 0, 0, 0)
constexpr int KROW = 256, VROW = 128, KBUF = 64 * KROW, VBUF = 128 * VROW, ABUF = KBUF + VBUF, QROW = 272;
__device__ __forceinline__ bf16x8 packp(const f32x16& x, int s) {
    u32x4 w;
    w.x = cvt_pk_bf16(x[8 * s + 0], x[8 * s + 1]); w.y = cvt_pk_bf16(x[8 * s + 2], x[8 * s + 3]); w.z = cvt_pk_bf16(x[8 * s + 4], x[8 * s + 5]); w.w = cvt_pk_bf16(x[8 * s + 6], x[8 * s + 7]);
    return __builtin_bit_cast(bf16x8, w);
}
__device__ __forceinline__ void attn_phase_online(LAS unsigned char* lds, const bf16_t* q, const bf16_t* k, const bf16_t* vT, bf16_t* mixed, float lam, const int wave_s) {
    int tid_ = wave_s * 64 + lane_id(); asm volatile("" : "+v"(tid_));
    const int tid = tid_, lane = tid & 63, r32 = lane & 31, hi = lane >> 5, wid = __builtin_amdgcn_readfirstlane(tid >> 6), G = gridDim.x;
    unsigned koff[2], voff[2];
#pragma unroll
    for (int i = 0; i < 2; ++i) {
        const int kr = 4 * (2 * wid + i) + (lane >> 4), kc = (lane & 15) ^ (kr & 15); koff[i] = (unsigned)(kr * 512 + kc * 8) * 2u;
        const int vd = 8 * (2 * wid + i) + (lane >> 3), vc = (lane & 7) ^ ((vd >> 1) & 7); voff[i] = (unsigned)(vd * MTOK + vc * 8) * 2u;
    }
    const int kx = r32 & 15, vx = (r32 >> 1) & 7;
    const unsigned lds0 = (unsigned)(size_t)lds;
#define ATT_DMA1(sbase, voff_, ldsdst) do { unsigned keep_; asm volatile("s_mov_b32 %0, m0\n\ts_mov_b32 m0, %3\n\ts_nop 0\n\tglobal_load_lds_dwordx4 %1, %2\n\ts_mov_b32 m0, %0" : "=&s"(keep_) : "v"(voff_), "s"(sbase), "s"(ldsdst) : "memory"); } while (0)
#define ATT_DMA(buf, kp, vp) do { _Pragma("unroll") for (int _i = 0; _i < 2; ++_i) { \
        ATT_DMA1((kp), koff[_i], lds0 + (unsigned)((buf) + (2 * wid + _i) * 1024)); \
        ATT_DMA1((vp), voff[_i], lds0 + (unsigned)((buf) + KBUF + (2 * wid + _i) * 1024)); } } while (0)
    for (int U = blockIdx.x; U < 2048; U += G) {
        const int rnd = U >> 8, cc = U & 255, x = cc & 7, jj = cc >> 3;
        int S, tok0, h, qb;
        if (rnd < 4) { const int pair = 4 * x + rnd; S = SEQS; tok0 = NPROMPT + (pair >> 2) * SEQS; h = pair & 3; qb = jj; }
        else { const int pair = 8 * x + 2 * (rnd - 4) + (jj >> 4); S = SEQP; tok0 = (pair >> 2) * SEQP; h = pair & 3; qb = jj & 15; }
        const bf16_t* Kg = k + (size_t)tok0 * 512 + h * 128;
        const bf16_t* Vg = vT + (size_t)(h * 128) * MTOK + tok0;
        const int NT = S / 64;
        const size_t qrow = (size_t)tok0 + qb * 256 + wid * 32 + r32;
        ATT_DMA(0, Kg, Vg);
        LAS unsigned char* Qs = lds + 2 * ABUF + wid * (32 * QROW) + r32 * QROW + hi * 16;
#pragma unroll
        for (int m = 0; m < 2; ++m)
#pragma unroll
            for (int d0 = 0; d0 < 4; ++d0) *(LAS bf16x8*)(Qs + m * 128 + d0 * 32) = *(const bf16x8*)(q + qrow * 512 + h * 128 + m * 64 + d0 * 16 + hi * 8);
        f32x16 o[2][4];
#pragma unroll
        for (int m = 0; m < 2; ++m)
#pragma unroll
            for (int db = 0; db < 4; ++db)
#pragma unroll
                for (int i = 0; i < 16; ++i) o[m][db][i] = 0.f;
        float mu[2] = {-1e30f, -1e30f}, l[2] = {0.f, 0.f};
        asm volatile("s_waitcnt vmcnt(0)" ::: "memory");
        __syncthreads();
        for (int t = 0; t < NT; ++t) {
            const int cb = (t & 1) * ABUF, nb = ((t + 1) & 1) * ABUF;
            if (t + 1 < NT) ATT_DMA(nb, Kg + (size_t)(t + 1) * 64 * 512, Vg + (t + 1) * 64);
            const LAS unsigned char* Kb = lds + cb + r32 * KROW;
            const LAS unsigned char* Vb = lds + cb + KBUF + r32 * VROW;
#pragma unroll
            for (int m = 0; m < 2; ++m) {
                f32x16 s0, s1;
#pragma unroll
                for (int i = 0; i < 16; ++i) { s0[i] = 0.f; s1[i] = 0.f; }
#pragma unroll
                for (int d0 = 0; d0 < 4; ++d0) {
                    const int kpos = ((m * 8 + d0 * 2 + hi) ^ kx) * 16;
                    const bf16x8 k0 = *(const LAS bf16x8*)(Kb + kpos), k1 = *(const LAS bf16x8*)(Kb + 32 * KROW + kpos);
                    const bf16x8 qv = *(const LAS bf16x8*)(Qs + m * 128 + d0 * 32);
                    s0 = MFMA32(k0, qv, s0); s1 = MFMA32(k1, qv, s1);
                    if (d0 == 1) __builtin_amdgcn_sched_barrier(0);
                }
                __builtin_amdgcn_sched_barrier(0);
                float mx = fmaxf(s0[0], s1[0]);
#pragma unroll
                for (int i = 1; i < 16; ++i) mx = fmaxf(mx, fmaxf(s0[i], s1[i]));
                mx = fmaxf(mx, __shfl_xor(mx, 32));
                const bool need = mx > mu[m] + 8.0f;
                if (__builtin_amdgcn_ballot_w64(need) != 0ull) {
                    const float nm = need ? mx : mu[m];
                    const float alpha = __builtin_amdgcn_exp2f(mu[m] - nm);
                    mu[m] = nm; l[m] *= alpha;
#pragma unroll
                    for (int db = 0; db < 4; ++db)
#pragma unroll
                        for (int i = 0; i < 16; ++i) o[m][db][i] *= alpha;
                }
                const float mm = mu[m];
                float ls = 0.f;
#pragma unroll
                for (int i = 0; i < 16; ++i) { s0[i] = __builtin_amdgcn_exp2f(s0[i] - mm); s1[i] = __builtin_amdgcn_exp2f(s1[i] - mm); ls += s0[i] + s1[i]; }
                l[m] += ls;
                const bf16x8 p0 = packp(s0, 0), p1 = packp(s0, 1), p2 = packp(s1, 0), p3 = packp(s1, 1);
                __builtin_amdgcn_sched_barrier(0);
#pragma unroll
                for (int db = 0; db < 4; ++db) {
                    const LAS unsigned char* vb = Vb + db * 32 * VROW;
                    const bf16x8 v0 = *(const LAS bf16x8*)(vb + ((0 + hi) ^ vx) * 16), v1 = *(const LAS bf16x8*)(vb + ((2 + hi) ^ vx) * 16), v2 = *(const LAS bf16x8*)(vb + ((4 + hi) ^ vx) * 16), v3 = *(const LAS bf16x8*)(vb + ((6 + hi) ^ vx) * 16);
                    o[m][db] = MFMA32(v0, p0, o[m][db]); o[m][db] = MFMA32(v1, p1, o[m][db]); o[m][db] = MFMA32(v2, p2, o[m][db]); o[m][db] = MFMA32(v3, p3, o[m][db]);
                    __builtin_amdgcn_sched_barrier(0);
                }
            }
            asm volatile("s_waitcnt vmcnt(0)" ::: "memory");
            __syncthreads();
        }
        const float l0 = l[0] + __shfl_xor(l[0], 32), l1 = l[1] + __shfl_xor(l[1], 32);
        const float c0 = 1.0f / l0, c1 = lam / l1;
        float ss = 0.f;
#pragma unroll
        for (int db = 0; db < 4; ++db)
#pragma unroll
            for (int i = 0; i < 16; ++i) { const float v = o[0][db][i] * c0 - o[1][db][i] * c1; o[0][db][i] = v; ss += v * v; }
        ss += __shfl_xor(ss, 32);
        const float rstd = rsqrtf(ss * (1.0f / 128.0f) + EPSV);
        bf16_t* orow = mixed + qrow * DM + h * 128 + 4 * hi;
#pragma unroll
        for (int db = 0; db < 4; ++db)
#pragma unroll
            for (int i4 = 0; i4 < 4; ++i4) {
                u32x2 w; w.x = cvt_pk_bf16(o[0][db][4 * i4] * rstd, o[0][db][4 * i4 + 1] * rstd); w.y = cvt_pk_bf16(o[0][db][4 * i4 + 2] * rstd, o[0][db][4 * i4 + 3] * rstd);
                *(u32x2*)(orow + 32 * db + 8 * i4) = w;
            }
    }
}


__device__ __forceinline__ void attn_phase_fast(LAS unsigned char* lds, const bf16_t* q, const bf16_t* k, const bf16_t* vT, bf16_t* mixed, float lam, const int wave_s) {
    int tid_ = wave_s * 64 + lane_id(); asm volatile("" : "+v"(tid_));
    const int wid = __builtin_amdgcn_readfirstlane(tid_ >> 6), G = gridDim.x;
    const unsigned lds0 = (unsigned)(size_t)lds;
    if (wid >= 4) __builtin_amdgcn_s_setprio(1);
    for (int U = blockIdx.x; U < 2048; U += G) {
        int lane_ = tid_ & 63; asm volatile("" : "+v"(lane_));
        const int lane = lane_, r32 = lane & 31, hi = lane >> 5;
        unsigned koff[2], voff[2];
#pragma unroll
        for (int i = 0; i < 2; ++i) {
            const int kr = 4 * (2 * wid + i) + (lane >> 4), kc = (lane & 15) ^ (kr & 15); koff[i] = (unsigned)(kr * 512 + kc * 8) * 2u;
            const int vd = 8 * (2 * wid + i) + (lane >> 3), vc = (lane & 7) ^ ((vd >> 1) & 7); voff[i] = (unsigned)(vd * MTOK + vc * 8) * 2u;
        }
        const int kx = r32 & 15, vx = (r32 >> 1) & 7;
        const int rnd = U >> 8, cc = U & 255, x = cc & 7, jj = cc >> 3;
        int S, tok0, h, qb;
        if (rnd < 4) { const int pair = 4 * x + rnd; S = SEQS; tok0 = NPROMPT + (pair >> 2) * SEQS; h = pair & 3; qb = jj; }
        else { const int pair = 8 * x + 2 * (rnd - 4) + (jj >> 4); S = SEQP; tok0 = (pair >> 2) * SEQP; h = pair & 3; qb = jj & 15; }
        const bf16_t* Kg = k + (size_t)tok0 * 512 + h * 128;
        const bf16_t* Vg = vT + (size_t)(h * 128) * MTOK + tok0;
        const int NT = S / 64;
        const size_t qrow = (size_t)tok0 + qb * 256 + wid * 32 + r32;
        ATT_DMA(0, Kg, Vg);
        LAS unsigned char* Qs = lds + 2 * ABUF + wid * (32 * QROW) + r32 * QROW + hi * 16;
#pragma unroll
        for (int m = 0; m < 2; ++m)
#pragma unroll
            for (int d0 = 0; d0 < 4; ++d0) *(LAS bf16x8*)(Qs + m * 128 + d0 * 32) = *(const bf16x8*)(q + qrow * 512 + h * 128 + m * 64 + d0 * 16 + hi * 8);
        f32x16 o[2][4];
#pragma unroll
        for (int m = 0; m < 2; ++m)
#pragma unroll
            for (int db = 0; db < 4; ++db)
#pragma unroll
                for (int i = 0; i < 16; ++i) o[m][db][i] = 0.f;
        float l[2] = {0.f, 0.f};
        asm volatile("s_waitcnt vmcnt(0)" ::: "memory");
        __syncthreads();
        for (int t = 0; t < NT; ++t) {
            const int cb = (t & 1) * ABUF, nb = ((t + 1) & 1) * ABUF;
            int ln = lane; asm volatile("" : "+v"(ln));
            const int r32 = ln & 31, hi = ln >> 5, kx = r32 & 15, vx = (r32 >> 1) & 7;
            if (t + 1 < NT) {
                unsigned koff[2], voff[2];
#pragma unroll
                for (int i = 0; i < 2; ++i) {
                    const int kr = 4 * (2 * wid + i) + (ln >> 4), kc = (ln & 15) ^ (kr & 15); koff[i] = (unsigned)(kr * 512 + kc * 8) * 2u;
                    const int vd = 8 * (2 * wid + i) + (ln >> 3), vc = (ln & 7) ^ ((vd >> 1) & 7); voff[i] = (unsigned)(vd * MTOK + vc * 8) * 2u;
                }
                ATT_DMA(nb, Kg + (size_t)(t + 1) * 64 * 512, Vg + (t + 1) * 64);
            }
            const LAS unsigned char* Qs = lds + 2 * ABUF + wid * (32 * QROW) + r32 * QROW + hi * 16;
            int kxh = (kx >> 1) << 5, vxh = (vx >> 1) << 5, kq = cb + r32 * KROW + ((hi ^ (kx & 1)) << 4), vq = cb + KBUF + r32 * VROW + ((hi ^ (vx & 1)) << 4);
            asm volatile("" : "+v"(kxh), "+v"(vxh), "+v"(kq), "+v"(vq));
            const LAS unsigned char* Kb = lds + kq;
            const LAS unsigned char* Vb = lds + vq;
#pragma unroll
            for (int m = 0; m < 2; ++m) {
                f32x16 s0, s1;
#pragma unroll
                for (int i = 0; i < 16; ++i) { s0[i] = 0.f; s1[i] = 0.f; }
#pragma unroll
                for (int d0 = 0; d0 < 4; ++d0) {
                    const int kpos = ((m * 4 + d0) << 5) ^ kxh;
                    const bf16x8 k0 = *(const LAS bf16x8*)(Kb + kpos), k1 = *(const LAS bf16x8*)(Kb + 32 * KROW + kpos);
                    const bf16x8 qv = *(const LAS bf16x8*)(Qs + m * 128 + d0 * 32);
                    s0 = MFMA32(k0, qv, s0); s1 = MFMA32(k1, qv, s1);
                    if (d0 == 1) __builtin_amdgcn_sched_barrier(0);
                }
                __builtin_amdgcn_sched_barrier(0);
                float ls = 0.f, ls2 = 0.f;
#pragma unroll
                for (int i = 0; i < 16; ++i) { float e0 = __builtin_amdgcn_exp2f(s0[i]), e1 = __builtin_amdgcn_exp2f(s1[i]); asm volatile("" : "+v"(e0), "+v"(e1)); s0[i] = e0; s1[i] = e1; ls += e0; ls2 += e1; }
                ls += ls2;
                l[m] += ls;
                const bf16x8 p0 = packp(s0, 0), p1 = packp(s0, 1), p2 = packp(s1, 0), p3 = packp(s1, 1);
                __builtin_amdgcn_sched_barrier(0);
#pragma unroll
                for (int db = 0; db < 4; ++db) {
                    const LAS unsigned char* vb = Vb + db * 32 * VROW;
                    const bf16x8 v0 = *(const LAS bf16x8*)(vb + (0 ^ vxh)), v1 = *(const LAS bf16x8*)(vb + (32 ^ vxh)), v2 = *(const LAS bf16x8*)(vb + (64 ^ vxh)), v3 = *(const LAS bf16x8*)(vb + (96 ^ vxh));
                    o[m][db] = MFMA32(v0, p0, o[m][db]); o[m][db] = MFMA32(v1, p1, o[m][db]); o[m][db] = MFMA32(v2, p2, o[m][db]); o[m][db] = MFMA32(v3, p3, o[m][db]);
                    if (db == 1) __builtin_amdgcn_sched_barrier(0);
                }
                __builtin_amdgcn_sched_barrier(0);
            }
            asm volatile("s_waitcnt vmcnt(0)" ::: "memory");
            __syncthreads();
        }
        const float l0 = l[0] + __shfl_xor(l[0], 32), l1 = l[1] + __shfl_xor(l[1], 32);
        const float c0 = 1.0f / l0, c1 = lam / l1;
        float ss = 0.f;
#pragma unroll
        for (int db = 0; db < 4; ++db)
#pragma unroll
            for (int i = 0; i < 16; ++i) { const float v = o[0][db][i] * c0 - o[1][db][i] * c1; o[0][db][i] = v; ss += v * v; }
        ss += __shfl_xor(ss, 32);
        const float rstd = rsqrtf(ss * (1.0f / 128.0f) + EPSV);
        int lane2 = lane_id(); asm volatile("" : "+v"(lane2));
        bf16_t* orow = mixed + ((size_t)tok0 + qb * 256 + wid * 32 + (lane2 & 31)) * DM + h * 128 + 4 * (lane2 >> 5);
#pragma unroll
        for (int db = 0; db < 4; ++db)
#pragma unroll
            for (int i4 = 0; i4 < 4; ++i4) {
                u32x2 w; w.x = cvt_pk_bf16(o[0][db][4 * i4] * rstd, o[0][db][4 * i4 + 1] * rstd); w.y = cvt_pk_bf16(o[0][db][4 * i4 + 2] * rstd, o[0][db][4 * i4 + 3] * rstd);
                *(u32x2*)(orow + 32 * db + 8 * i4) = w;
            }
    }
    __builtin_amdgcn_s_setprio(0);
}


__global__ void __launch_bounds__(512) fwd_megakernel(Params p) {
    extern __shared__ __attribute__((aligned(16))) unsigned char lds_raw[];
    LAS unsigned char* lds = (LAS unsigned char*)lds_raw;
    cg::grid_group grid = cg::this_grid();
    unsigned char* ws = p.ws;
    const int G = gridDim.x, c = blockIdx.x;
    const int wave_s = __builtin_amdgcn_readfirstlane((int)threadIdx.x >> 6);
    bf16_t* WQKP = (bf16_t*)(ws + WS_WQKP); bf16_t* WV = (bf16_t*)(ws + WS_WV); bf16_t* WOUT = (bf16_t*)(ws + WS_WOUT); bf16_t* WUP = (bf16_t*)(ws + WS_WUP); bf16_t* WDN = (bf16_t*)(ws + WS_WDN);
    float* cosT = (float*)(ws + WS_COS); float* sinT = (float*)(ws + WS_SIN); float* rss = (float*)(ws + WS_RSS);
    bf16_t* Q = (bf16_t*)(ws + WS_Q); bf16_t* Kt = (bf16_t*)(ws + WS_K); bf16_t* VT = (bf16_t*)(ws + WS_VT); bf16_t* ZP = (bf16_t*)(ws + WS_ZP);
    bf16_t* H = (bf16_t*)(ws + WS_H); bf16_t* MIX = H; bf16_t* XB = (bf16_t*)(ws + WS_XB); bf16_t* ACT = (bf16_t*)(ws + WS_ACT);

#ifndef SKIP_P0
    p0_prologue(p, lds, wave_s);
#endif
    grid.sync();
#ifndef SKIP_P1
    {
        pg8::Gemm g{H, WQKP, MTOK, 1536, DM}; pg8::StaticOrder S; S.init(MTOK, 1536, G, c);
        EpiQKP E{ws, (const float*)(ws + WS_QKG), cosT, sinT};
        pg8::gemm_phase<EpiQKP, pg8::StaticOrder, true, true>(lds, g, S, E, wave_s);
    }
    {
        pg8::Gemm g{WV, H, 512, MTOK, DM}; pg8::StaticOrder S; S.init(512, MTOK, G, c);
        EpiVT E{VT};
        pg8::gemm_phase<EpiVT, pg8::StaticOrder, true, true>(lds, g, S, E, wave_s);
    }
#endif
    grid.sync();
#ifndef SKIP_P2
    pool_phase(ZP, MIX, wave_s);
    {
        float d1 = 0.f, d2 = 0.f;
        for (int i = 0; i < 64; ++i) { d1 += p.in[I_LQ1][i] * p.in[I_LK1][i]; d2 += p.in[I_LQ2][i] * p.in[I_LK2][i]; }
        const float lam = __builtin_bit_cast(float, __builtin_amdgcn_readfirstlane(__builtin_bit_cast(int, __expf(d1) - __expf(d2) + 0.2f)));
        float gq = 0.f, gk = 0.f;
        for (int i = 0; i < 64; ++i) { gq = fmaxf(gq, fabsf(p.in[I_QG][i])); gk = fmaxf(gk, fabsf(p.in[I_KG][i])); }
        const float bound = 64.0f * QSCALE * gq * gk;
        if (bound < 100.0f) attn_phase_fast(lds, Q, Kt, VT, MIX, lam, wave_s);
        else attn_phase_online(lds, Q, Kt, VT, MIX, lam, wave_s);
    }
#endif
    grid.sync();
#ifndef SKIP_P3
    {
        pg8::Gemm g{MIX, WOUT, MTOK, DM, DM}; pg8::StaticOrder S; S.init(MTOK, DM, G, c);
        EpiRes1 E{p.in[I_XP], p.in[I_XS], XB, rss};
        pg8::gemm_phase<EpiRes1, pg8::StaticOrder, true, true>(lds, g, S, E, wave_s);
    }
#endif
    grid.sync();
#ifndef SKIP_P4
    {
        pg8::Gemm g{XB, WUP, MTOK, 2 * DFF, DM}; pg8::StaticOrder S; S.init_tiles(517, 22, G, c, 1);
        EpiConvGate E{rss, p.in[I_CONVW], p.in[I_CONVB], ACT, (LAS float*)(lds + LDS_STAGE)};
        pg8::gemm_phase<EpiConvGate, pg8::StaticOrder, true, true>(lds, g, S, E, wave_s);
    }
#endif
    grid.sync();
#ifndef SKIP_P5
    {
        pg8::Gemm g{ACT, WDN, MTOK, DM, DFF}; pg8::StaticOrder S; S.init(MTOK, DM, G, c);
        EpiRes2 E{XB, p.out};
        pg8::gemm_phase<EpiRes2, pg8::StaticOrder, true, true>(lds, g, S, E, wave_s);
    }
#endif
}

extern "C" void kernel_launch(void* const* d_in, const int* in_sizes, int n_in, void* d_out, int out_size, void* d_ws, size_t ws_size, hipStream_t stream) {
    static int grid_blocks = 0;
    if (grid_blocks == 0) {
        if (n_in != 19 || ws_size < WS_END) { fprintf(stderr, "kernel_launch: unexpected n_in %d / ws_size %zu (need %zu)\n", n_in, ws_size, (size_t)WS_END); grid_blocks = -1; return; }
        int dev = 0, cus = 0, per_cu = 0;
        (void)hipGetDevice(&dev);
        (void)hipDeviceGetAttribute(&cus, hipDeviceAttributeMultiprocessorCount, dev);
        if (hipFuncSetAttribute((const void*)fwd_megakernel, hipFuncAttributeMaxDynamicSharedMemorySize, LDS_TOTAL) != hipSuccess) { fprintf(stderr, "kernel_launch: hipFuncSetAttribute failed\n"); grid_blocks = -1; return; }
        if (hipOccupancyMaxActiveBlocksPerMultiprocessor(&per_cu, (const void*)fwd_megakernel, 512, LDS_TOTAL) != hipSuccess || per_cu < 1) { fprintf(stderr, "kernel_launch: occupancy query failed (%d)\n", per_cu); (void)hipGetLastError(); per_cu = 1; }
        grid_blocks = cus * per_cu;
    }
    if (grid_blocks < 0) return;
    Params p{};
    for (int i = 0; i < 19; ++i) p.in[i] = (const float*)d_in[i];
    p.out = (float*)d_out; p.ws = (unsigned char*)d_ws;
    void* args[] = {&p};
    hipError_t e = hipLaunchCooperativeKernel((const void*)fwd_megakernel, dim3(grid_blocks), dim3(512), args, LDS_TOTAL, stream);
    if (e != hipSuccess) fprintf(stderr, "cooperative launch failed: %s (grid %d)\n", hipGetErrorString(e), grid_blocks);
}
```

```cpp
#include <hip/hip_runtime.h>
#include <hip/hip_cooperative_groups.h>
#include <cstdio>
#include <cstdint>
namespace cg = cooperative_groups;

namespace pg8 {
#define PG8_LAS __attribute__((address_space(3)))
typedef unsigned short bf16_t;
typedef short bf16x8 __attribute__((ext_vector_type(8)));
typedef float f32x4 __attribute__((ext_vector_type(4)));
typedef unsigned u32x4 __attribute__((ext_vector_type(4)));
constexpr int BM = 256, BK = 64, HALF = 128, HTB = HALF * BK * 2  , STAGE_BYTES = 8 * HTB, NXCD = 8, WGM = 8;

__host__ __device__ __forceinline__ int lds_byte(int r, int c) { const int st = (r >> 4) * 2 + (c >> 5), rr = r & 15, cc = c & 31, ob = rr * 64 + cc * 2; return st * 1024 + (ob ^ (((ob >> 9) & 1) << 5)); }
__host__ __device__ __forceinline__ void stage_rc(int b, int& R, int& C) { const int st = b / 1024, sb = b % 1024, swz = sb ^ (((sb >> 9) & 1) << 5); R = (st >> 1) * 16 + swz / 64; C = (st & 1) * 32 + (swz % 64) / 2; }
__host__ __device__ __forceinline__ int perm32(int rho) { const int n = rho >> 4, i = rho & 15; return 8 * (i >> 2) + 4 * n + (i & 3); }

struct Unit { int pm, pn; };
struct Gemm { const bf16_t* A; const bf16_t* Bt; int M, N, K; };

struct StaticOrder {
    int nM, nN, nwg, G, c; int halo;
    __host__ __device__ void init_tiles(int nM_, int nN_, int G_, int c_, int halo_) { nM = nM_; nN = nN_; nwg = nM * nN; G = G_; c = c_; halo = halo_; }
    __device__ __forceinline__ long a_off(int pm, int K) const { return halo ? ((long)254 * pm - 1) * (long)K * 2 : (long)pm * 256 * (long)K * 2; }
    __host__ __device__ void init(int M, int N, int G_, int c_) { nM = M / BM; nN = N / BM; nwg = nM * nN; G = G_; c = c_; halo = 0; }
    __host__ __device__ bool next(int i, Unit& u) const {
        const long L = (long)i * G + c; if (L >= nwg) return false;
        int wgid = (int)L; { const int q = nwg / NXCD, r = nwg % NXCD, xcd = wgid % NXCD, off = wgid / NXCD; wgid = (xcd < r ? xcd * (q + 1) : r * (q + 1) + (xcd - r) * q) + off; }
        const int nig = WGM * nN, gid = wgid / nig, fm = gid * WGM, gsz = (nM - fm) < WGM ? (nM - fm) : WGM;
        u.pm = fm + ((wgid % nig) % gsz); u.pn = (wgid % nig) / gsz; return true;
    }
    __device__ __forceinline__ void a_ready(const Unit&) const {}
    __device__ __forceinline__ void done(const Unit&) const {}
};
__device__ __forceinline__ unsigned cvt_pk_bf16(float lo, float hi) { unsigned r; asm volatile("v_cvt_pk_bf16_f32 %0, %1, %2" : "=v"(r) : "v"(lo), "v"(hi)); return r; }
typedef float f32x2 __attribute__((ext_vector_type(2)));
typedef float f32x2 __attribute__((ext_vector_type(2)));
template <class Epi, class Sched, bool ALIGN_EPI = false, bool SP2 = false>
__device__ __forceinline__ void gemm_phase(PG8_LAS unsigned char* lds, const Gemm g, const Sched& S, const Epi& E, const int wave_s) {
    int tid_; asm volatile("v_mbcnt_lo_u32_b32 %0, -1, 0\n\tv_mbcnt_hi_u32_b32 %0, -1, %0" : "=v"(tid_)); tid_ += wave_s * 64;
    const int tid = tid_, wid = __builtin_amdgcn_readfirstlane(tid >> 6), lane = tid & 63, wr = wid >> 2, wc = wid & 3, fr = lane & 15, fq = lane >> 4;
    const int K = g.K, nt = K / BK;
    unsigned voffA[2], voffB[2];
#pragma unroll
    for (int i = 0; i < 2; ++i) { int R, C; stage_rc(tid * 16 + i * 8192, R, C); const int Rb = Epi::PERM ? ((R & ~31) + perm32(R & 31)) : R;
        voffA[i] = (unsigned)(R * K + C) * 2u; voffB[i] = (unsigned)(Rb * K + C) * 2u; }
    const size_t kstep = (size_t)(BK * 2);
    const size_t hstep = (size_t)HALF * K * 2;
    const size_t tstep = 2 * hstep;
    const unsigned ldsw = (unsigned)wid * 1024u;
    const int aoff = lds_byte(wr * 64 + fr, fq * 8), boff = lds_byte(wc * 32 + fr, fq * 8);
#define PG8_SA(b, h) (((b) * 2 + (h)) * HTB)
#define PG8_SB(b, h) ((4 + (b) * 2 + (h)) * HTB)
#define PG8_STAGE(bufoff, gbase, voff) do { _Pragma("unroll") for (int _i = 0; _i < 2; ++_i) \
        __builtin_amdgcn_global_load_lds((const unsigned*)((const char*)(gbase) + (voff)[_i]), (PG8_LAS unsigned*)(lds + (bufoff) + ldsw + _i * 8192), 16, 0, 0); } while (0)
#define PG8_LDA(dst, b, h) do { _Pragma("unroll") for (int m = 0; m < 4; ++m) _Pragma("unroll") for (int k = 0; k < 2; ++k) dst[m][k] = *(const PG8_LAS bf16x8*)(lds + PG8_SA(b, h) + aoff + m * 2048 + k * 1024); } while (0)
#define PG8_LDB(dst, b, h) do { _Pragma("unroll") for (int n = 0; n < 2; ++n) _Pragma("unroll") for (int k = 0; k < 2; ++k) dst[n][k] = *(const PG8_LAS bf16x8*)(lds + PG8_SB(b, h) + boff + n * 2048 + k * 1024); } while (0)
#define PG8_MMA(ai, bj, At, Bt) do { __builtin_amdgcn_s_setprio(1); _Pragma("unroll") for (int m = 0; m < 4; ++m) _Pragma("unroll") for (int n = 0; n < 2; ++n) _Pragma("unroll") for (int k = 0; k < 2; ++k) \
        acc[ai][bj][m][n] = __builtin_amdgcn_mfma_f32_16x16x32_bf16(Bt[n][k], At[m][k], acc[ai][bj][m][n], 0, 0, 0); __builtin_amdgcn_s_setprio(0); } while (0)
#define PG8_WAIT_V(n) asm volatile("s_waitcnt vmcnt(" #n ")" ::: "memory")
#define PG8_WAIT_L(n) asm volatile("s_waitcnt lgkmcnt(" #n ")" ::: "memory")
#define PG8_BAR __builtin_amdgcn_s_barrier()
#define PG8_SCHED __builtin_amdgcn_sched_barrier(0)
    Unit cur, nxt; int ui = 0;
    if (!S.next(0, cur)) return;
    f32x4 acc[2][2][4][2];
#pragma unroll
    for (int a = 0; a < 2; ++a)
#pragma unroll
        for (int b = 0; b < 2; ++b)
#pragma unroll
            for (int m = 0; m < 4; ++m)
#pragma unroll
                for (int n = 0; n < 2; ++n) acc[a][b][m][n] = (f32x4){0.f, 0.f, 0.f, 0.f};
    bf16x8 At[4][2], B0[2][2], B1[2][2];
    const char* cA = (const char*)g.A + S.a_off(cur.pm, K); const char* cB = (const char*)g.Bt + (size_t)cur.pn * tstep;
    S.a_ready(cur);
    if constexpr (SP2) {
        PG8_STAGE(PG8_SB(0, 0), cB, voffB); PG8_STAGE(PG8_SB(0, 1), cB + hstep, voffB); PG8_STAGE(PG8_SA(0, 0), cA, voffA); PG8_STAGE(PG8_SA(0, 1), cA + hstep, voffA);
        if (wr == 1) PG8_BAR;
        PG8_WAIT_V(2); PG8_BAR;
        PG8_STAGE(PG8_SB(1, 0), cB + kstep, voffB); PG8_STAGE(PG8_SA(1, 0), cA + kstep, voffA); PG8_STAGE(PG8_SB(1, 1), cB + hstep + kstep, voffB);
        PG8_WAIT_V(6); PG8_BAR;
    } else {
        PG8_STAGE(PG8_SB(0, 0), cB, voffB); PG8_STAGE(PG8_SA(0, 0), cA, voffA); PG8_STAGE(PG8_SB(0, 1), cB + hstep, voffB); PG8_STAGE(PG8_SA(0, 1), cA + hstep, voffA);
        if (wr == 1) PG8_BAR;
        PG8_WAIT_V(4); PG8_BAR;
        PG8_STAGE(PG8_SB(1, 0), cB + kstep, voffB); PG8_STAGE(PG8_SA(1, 0), cA + kstep, voffA); PG8_STAGE(PG8_SB(1, 1), cB + hstep + kstep, voffB);
        PG8_WAIT_V(6); PG8_BAR;
    }
    for (;;) {
        const bool has_next = S.next(ui + 1, nxt);
        const char* nA = has_next ? (const char*)g.A + S.a_off(nxt.pm, K) : cA; const char* nB = has_next ? (const char*)g.Bt + (size_t)nxt.pn * tstep : cB;
        for (int t = 0; t < nt; t += 2) {
            const bool last = (t == nt - 2);
            const char* a1 = cA + (size_t)(t + 1) * kstep;
            const char* a2 = last ? nA : cA + (size_t)(t + 2) * kstep; const char* b2 = last ? nB : cB + (size_t)(t + 2) * kstep;
            const char* a3 = a2 + kstep; const char* b3 = b2 + kstep;
            if (last && has_next) S.a_ready(nxt);
            if constexpr (SP2) {
            PG8_LDB(B0, 0, 0); PG8_LDB(B1, 0, 1); PG8_SCHED; PG8_LDA(At, 0, 0); PG8_STAGE(PG8_SA(1, 1), a1 + hstep, voffA);
            PG8_WAIT_V(8); PG8_WAIT_L(0); PG8_BAR; PG8_MMA(0, 0, At, B0); PG8_MMA(0, 1, At, B1); PG8_BAR; PG8_SCHED;
            PG8_LDA(At, 0, 1); PG8_STAGE(PG8_SB(0, 0), b2, voffB); PG8_STAGE(PG8_SB(0, 1), b2 + hstep, voffB); PG8_STAGE(PG8_SA(0, 0), a2, voffA);
            PG8_WAIT_V(8); PG8_WAIT_L(0); PG8_BAR; PG8_MMA(1, 0, At, B0); PG8_MMA(1, 1, At, B1); PG8_BAR; PG8_SCHED;
            PG8_LDB(B0, 1, 0); PG8_LDB(B1, 1, 1); PG8_SCHED; PG8_LDA(At, 1, 0); PG8_STAGE(PG8_SA(0, 1), a2 + hstep, voffA);
            PG8_WAIT_V(8); PG8_WAIT_L(0); PG8_BAR; PG8_MMA(0, 0, At, B0); PG8_MMA(0, 1, At, B1); PG8_BAR; PG8_SCHED;
            PG8_LDA(At, 1, 1); PG8_STAGE(PG8_SB(1, 0), b3, voffB); PG8_STAGE(PG8_SB(1, 1), b3 + hstep, voffB); PG8_STAGE(PG8_SA(1, 0), a3, voffA);
            PG8_WAIT_V(8); PG8_WAIT_L(0); PG8_BAR; PG8_MMA(1, 0, At, B0); PG8_MMA(1, 1, At, B1); PG8_BAR; PG8_SCHED;
            } else {
            PG8_LDB(B0, 0, 0); PG8_SCHED; PG8_LDA(At, 0, 0); PG8_STAGE(PG8_SA(1, 1), a1 + hstep, voffA);
            PG8_WAIT_L(8); PG8_BAR; PG8_WAIT_L(0); PG8_MMA(0, 0, At, B0); PG8_BAR; PG8_SCHED;
            PG8_LDB(B1, 0, 1); PG8_STAGE(PG8_SB(0, 0), b2, voffB);
            PG8_BAR; PG8_WAIT_L(0); PG8_MMA(0, 1, At, B1); PG8_BAR;
            PG8_LDA(At, 0, 1); PG8_STAGE(PG8_SA(0, 0), a2, voffA);
            PG8_BAR; PG8_WAIT_L(0); PG8_MMA(1, 0, At, B0); PG8_BAR; PG8_SCHED;
            PG8_STAGE(PG8_SB(0, 1), b2 + hstep, voffB);
            PG8_WAIT_V(6); PG8_BAR; PG8_MMA(1, 1, At, B1); PG8_BAR;
            PG8_LDB(B0, 1, 0); PG8_SCHED; PG8_LDA(At, 1, 0); PG8_STAGE(PG8_SA(0, 1), a2 + hstep, voffA);
            PG8_WAIT_L(8); PG8_BAR; PG8_WAIT_L(0); PG8_MMA(0, 0, At, B0); PG8_BAR; PG8_SCHED;
            PG8_LDB(B1, 1, 1); PG8_STAGE(PG8_SB(1, 0), b3, voffB);
            PG8_BAR; PG8_WAIT_L(0); PG8_MMA(0, 1, At, B1); PG8_BAR;
            PG8_LDA(At, 1, 1); PG8_STAGE(PG8_SA(1, 0), a3, voffA);
            PG8_BAR; PG8_WAIT_L(0); PG8_MMA(1, 0, At, B0); PG8_BAR; PG8_SCHED;
            PG8_STAGE(PG8_SB(1, 1), b3 + hstep, voffB);
            PG8_WAIT_V(6); PG8_BAR; PG8_MMA(1, 1, At, B1); PG8_BAR;
            }
        }
        if constexpr (ALIGN_EPI) { if (wr == 0) PG8_BAR; }
        if constexpr (!Epi::AFTER_DRAIN) { E(acc, cur, wr, wc, fr, fq); S.done(cur); }
        if (!has_next) break;
#pragma unroll
        for (int a = 0; a < 2; ++a)
#pragma unroll
            for (int b = 0; b < 2; ++b)
#pragma unroll
                for (int m = 0; m < 4; ++m)
#pragma unroll
                    for (int n = 0; n < 2; ++n) acc[a][b][m][n] = (f32x4){0.f, 0.f, 0.f, 0.f};
        cur = nxt; cA = nA; cB = nB; ++ui;
        if constexpr (ALIGN_EPI) { if (wr == 1) PG8_BAR; }
    }
    PG8_WAIT_V(0);
    if constexpr (!ALIGN_EPI) { if (wr == 0) PG8_BAR; }
    PG8_BAR;
    if constexpr (Epi::AFTER_DRAIN) { E.fused(acc, cur, wr, wc, fr, fq, lds, wid, lane); S.done(cur); }
#undef PG8_SA
#undef PG8_SB
#undef PG8_STAGE
#undef PG8_LDA
#undef PG8_LDB
#undef PG8_MMA
#undef PG8_WAIT_V
#undef PG8_WAIT_L
#undef PG8_BAR
#undef PG8_SCHED
}
}

using pg8::bf16_t; using pg8::bf16x8; using pg8::f32x4; using pg8::u32x4; using pg8::Unit; using pg8::cvt_pk_bf16;
#define LAS __attribute__((address_space(3)))
typedef float f32x16 __attribute__((ext_vector_type(16)));
typedef unsigned u32x2 __attribute__((ext_vector_type(2)));
constexpr int DM = 1024, MTOK = 131072, NPROMPT = 65536, SEQP = 4096, SEQS = 8192, DFF = 2816;
constexpr float EPSV = 1e-6f;
constexpr float QSCALE = 0.125f * 1.4426950408889634f;
constexpr size_t MiB = 1024 * 1024;
constexpr size_t WS_WQKP = 0, WS_WV = 3 * MiB, WS_WOUT = 4 * MiB, WS_WUP = 6 * MiB, WS_WDN = 17 * MiB, WS_COS = 23 * MiB, WS_SIN = 24 * MiB, WS_RSS = 25 * MiB, WS_QKG = 25 * MiB + 768 * 1024, WS_BAR = 25 * MiB + 832 * 1024,
                 WS_XB = 26 * MiB, WS_Q = WS_XB, WS_K = WS_XB + 128 * MiB, WS_ACT = 282 * MiB, WS_VT = WS_ACT, WS_ZP = WS_ACT + 128 * MiB, WS_H = WS_ACT + 256 * MiB,
                 WS_END = WS_ACT + 704 * MiB;
constexpr int LDS_STAGE = 131072, LDS_EDGE = 8192, LDS_TOTAL = 147456;

struct Params {
    const float* in[19];
    float* out;
    unsigned char* ws;
};
enum { I_XP = 0, I_XS, I_N1G, I_WIN, I_QG, I_KG, I_LQ1, I_LK1, I_LQ2, I_LK2, I_SUBG, I_WPOOL, I_PSCALE, I_WOUT, I_N2G, I_WUP, I_CONVW, I_CONVB, I_WDOWN };

__device__ __forceinline__ int lane_id() { int l; asm volatile("v_mbcnt_lo_u32_b32 %0, -1, 0\n\tv_mbcnt_hi_u32_b32 %0, -1, %0" : "=v"(l)); return l; }
__device__ __forceinline__ bf16_t f2bf(float x) { unsigned u = __float_as_uint(x); u += 0x7fffu + ((u >> 16) & 1u); return (bf16_t)(u >> 16); }
__device__ __forceinline__ float bf2f(unsigned short b) { return __uint_as_float(((unsigned)b) << 16); }
__device__ __forceinline__ float bflo(unsigned w) { return __uint_as_float(w << 16); }
__device__ __forceinline__ float bfhi(unsigned w) { return __uint_as_float(w & 0xffff0000u); }
__device__ __forceinline__ u32x4 pack8(f32x4 a, f32x4 b) { u32x4 w; w.x = cvt_pk_bf16(a[0], a[1]); w.y = cvt_pk_bf16(a[2], a[3]); w.z = cvt_pk_bf16(b[0], b[1]); w.w = cvt_pk_bf16(b[2], b[3]); return w; }
__device__ __forceinline__ u32x2 pack4(f32x4 a) { u32x2 w; w.x = cvt_pk_bf16(a[0], a[1]); w.y = cvt_pk_bf16(a[2], a[3]); return w; }

struct EpiQKP {
    static constexpr bool PERM = true, AFTER_DRAIN = false;
    unsigned char* ws; const float *qkg  , *cosT, *sinT;
    __device__ __forceinline__ void operator()(f32x4 (&acc)[2][2][4][2], const Unit& u, int wr, int wc, int fr, int fq) const {
        const int kind = u.pn >> 1;
        bf16_t* base = (bf16_t*)(ws + (kind == 0 ? WS_Q : (kind == 1 ? WS_K : WS_ZP)));
        const int colbase = (u.pn & 1) * 256 + wc * 64, i0 = 8 * fq;
        if (kind < 2) {
            const float* g = qkg + kind * 64;
            const float osc = kind == 0 ? QSCALE : 1.0f;
            const f32x4 g00 = *(const f32x4*)(g + i0), g01 = *(const f32x4*)(g + i0 + 4), g10 = *(const f32x4*)(g + 32 + i0), g11 = *(const f32x4*)(g + 32 + i0 + 4);
#pragma unroll
            for (int ai = 0; ai < 2; ++ai)
#pragma unroll
                for (int m = 0; m < 4; ++m) {
                    const int row = u.pm * 256 + ai * 128 + wr * 64 + m * 16 + fr;
                    const int pos = row < NPROMPT ? (row & (SEQP - 1)) : (row & (SEQS - 1));
                    const f32x4 a00 = acc[ai][0][m][0], a01 = acc[ai][0][m][1], a10 = acc[ai][1][m][0], a11 = acc[ai][1][m][1];
                    f32x4 sq = a00 * a00 + a01 * a01 + a10 * a10 + a11 * a11;
                    float ss = (sq[0] + sq[1]) + (sq[2] + sq[3]);
                    ss += __shfl_xor(ss, 16); ss += __shfl_xor(ss, 32);
                    const float rstd = rsqrtf(ss * (1.0f / 64.0f) + EPSV) * osc;
                    const f32x4 cs0 = *(const f32x4*)(cosT + pos * 32 + i0), sn0 = *(const f32x4*)(sinT + pos * 32 + i0);
                    const f32x4 cs1 = *(const f32x4*)(cosT + pos * 32 + i0 + 4), sn1 = *(const f32x4*)(sinT + pos * 32 + i0 + 4);
                    const f32x4 y00 = a00 * rstd * g00, y01 = a01 * rstd * g01, y10 = a10 * rstd * g10, y11 = a11 * rstd * g11;
                    bf16_t* rp = base + (size_t)row * 512 + colbase + i0;
                    *(u32x4*)(rp) = pack8(y00 * cs0 - y10 * sn0, y01 * cs1 - y11 * sn1);
                    *(u32x4*)(rp + 32) = pack8(y10 * cs0 + y00 * sn0, y11 * cs1 + y01 * sn1);
                    asm volatile("" ::: "memory");
                }
        } else {
#pragma unroll
            for (int ai = 0; ai < 2; ++ai)
#pragma unroll
                for (int m = 0; m < 4; ++m) {
                    const int row = u.pm * 256 + ai * 128 + wr * 64 + m * 16 + fr;
                    bf16_t* rp = base + (size_t)row * 512 + colbase + i0;
#pragma unroll
                    for (int bj = 0; bj < 2; ++bj) *(u32x4*)(rp + 32 * bj) = pack8(acc[ai][bj][m][0], acc[ai][bj][m][1]);
                }
        }
    }
};
struct EpiVT {
    static constexpr bool PERM = true, AFTER_DRAIN = false;
    bf16_t* vT;
    __device__ __forceinline__ void operator()(f32x4 (&acc)[2][2][4][2], const Unit& u, int wr, int wc, int fr, int fq) const {
#pragma unroll
        for (int ai = 0; ai < 2; ++ai)
#pragma unroll
            for (int m = 0; m < 4; ++m) {
                const int row = u.pm * 256 + ai * 128 + wr * 64 + m * 16 + fr;
                bf16_t* rp = vT + (size_t)row * MTOK + (size_t)u.pn * 256 + wc * 32 + 16 * (fq >> 1) + 4 * (fq & 1);
#pragma unroll
                for (int bj = 0; bj < 2; ++bj)
#pragma unroll
                    for (int n = 0; n < 2; ++n) *(u32x2*)(rp + 128 * bj + 8 * n) = pack4(acc[ai][bj][m][n]);
            }
    }
};
struct EpiRes1 {
    static constexpr bool PERM = true, AFTER_DRAIN = false;
    const float *xp, *xs; bf16_t* xb; float* rss;
    __device__ __forceinline__ void operator()(f32x4 (&acc)[2][2][4][2], const Unit& u, int wr, int wc, int fr, int fq) const {
        const int col0 = u.pn * 256 + wc * 32 + 8 * fq;
#pragma unroll
        for (int ai = 0; ai < 2; ++ai)
#pragma unroll
            for (int m = 0; m < 4; ++m) {
                const int row = u.pm * 256 + ai * 128 + wr * 64 + m * 16 + fr;
                const float* xr = (row < NPROMPT ? xp + (size_t)row * DM : xs + (size_t)(row - NPROMPT) * DM) + col0;
                bf16_t* brow = xb + (size_t)row * DM + col0;
                float ss = 0.f;
#pragma unroll
                for (int bj = 0; bj < 2; ++bj) {
                    const f32x4 a = acc[ai][bj][m][0] + *(const f32x4*)(xr + 128 * bj), b = acc[ai][bj][m][1] + *(const f32x4*)(xr + 128 * bj + 4);
                    *(u32x4*)(brow + 128 * bj) = pack8(a, b);
                    ss += (a[0] * a[0] + a[1] * a[1]) + (a[2] * a[2] + a[3] * a[3]) + (b[0] * b[0] + b[1] * b[1]) + (b[2] * b[2] + b[3] * b[3]);
                }
                ss += __shfl_xor(ss, 16); ss += __shfl_xor(ss, 32);
                if (fq == 0) atomicAdd(rss + row, ss);
                asm volatile("" ::: "memory");
            }
    }
};
struct EpiRes2 {
    static constexpr bool PERM = true, AFTER_DRAIN = false;
    const bf16_t* xb; float* out;
    __device__ __forceinline__ void operator()(f32x4 (&acc)[2][2][4][2], const Unit& u, int wr, int wc, int fr, int fq) const {
        const int col0 = u.pn * 256 + wc * 32 + 8 * fq;
#pragma unroll
        for (int ai = 0; ai < 2; ++ai)
#pragma unroll
            for (int m = 0; m < 4; ++m) {
                const int row = u.pm * 256 + ai * 128 + wr * 64 + m * 16 + fr;
                float* orow = out + (size_t)row * DM + col0; const bf16_t* brow = xb + (size_t)row * DM + col0;
#pragma unroll
                for (int bj = 0; bj < 2; ++bj) {
                    const u32x4 w = *(const u32x4*)(brow + 128 * bj);
                    const f32x4 a = acc[ai][bj][m][0] + (f32x4){bflo(w.x), bfhi(w.x), bflo(w.y), bfhi(w.y)}, b = acc[ai][bj][m][1] + (f32x4){bflo(w.z), bfhi(w.z), bflo(w.w), bfhi(w.w)};
                    *(f32x4*)(orow + 128 * bj) = a; *(f32x4*)(orow + 128 * bj + 4) = b;
                }
                asm volatile("" ::: "memory");
            }
    }
};
__device__ __forceinline__ float dpp_ror1(float v) { return __builtin_bit_cast(float, __builtin_amdgcn_update_dpp(0, __builtin_bit_cast(int, v), 0x121, 0xf, 0xf, false)); }
__device__ __forceinline__ float dpp_ror15(float v) { return __builtin_bit_cast(float, __builtin_amdgcn_update_dpp(0, __builtin_bit_cast(int, v), 0x12F, 0xf, 0xf, false)); }
struct EpiConvGate {
    static constexpr bool PERM = true, AFTER_DRAIN = false;
    const float *rss, *convw, *convb; bf16_t* act; LAS float* edge;
    template <bool BND> __device__ __forceinline__ void conv_gate(f32x4 (&acc)[2][2][4][2], const Unit& u, int wr, int wc, int fr, int fq, int tok0, int pcol) const {
        const int fcol = u.pn * 128 + pcol;
#pragma unroll
        for (int n = 0; n < 2; ++n) {
            f32x4 w0[2], w1[2], w2[2], bb[2];
#pragma unroll
            for (int bj = 0; bj < 2; ++bj) { const int c = bj * DFF + fcol + 4 * n;
                w0[bj] = *(const f32x4*)(convw + c); w1[bj] = *(const f32x4*)(convw + 2 * DFF + c); w2[bj] = *(const f32x4*)(convw + 4 * DFF + c); bb[bj] = *(const f32x4*)(convb + c); }
#pragma unroll
            for (int ai = 0; ai < 2; ++ai) {
                const int blk = 2 * ai + wr;
                f32x4 pe[2], ne[2];
#pragma unroll
                for (int bj = 0; bj < 2; ++bj) {
                    pe[bj] = blk > 0 ? *(const LAS f32x4*)(edge + ((blk - 1) * 2 + 1) * 256 + 128 * bj + pcol + 4 * n) : (f32x4){0.f, 0.f, 0.f, 0.f};
                    ne[bj] = blk < 3 ? *(const LAS f32x4*)(edge + ((blk + 1) * 2 + 0) * 256 + 128 * bj + pcol + 4 * n) : (f32x4){0.f, 0.f, 0.f, 0.f};
                }
#pragma unroll
                for (int m = 0; m < 4; ++m) {
                    const int r = ai * 128 + wr * 64 + m * 16 + fr, tok = tok0 + r;
                    bool isfirst = false, islast = false;
                    if (BND) { const int S1 = (tok < NPROMPT ? SEQP : SEQS) - 1, pos = tok & S1; isfirst = pos == 0; islast = pos == S1; }
                    f32x4 cv[2];
#pragma unroll
                    for (int bj = 0; bj < 2; ++bj) {
                        const f32x4 cur = acc[ai][bj][m][n];
                        const f32x4 ups = m > 0 ? acc[ai][bj][m > 0 ? m - 1 : 0][n] : pe[bj];
                        const f32x4 dns = m < 3 ? acc[ai][bj][m < 3 ? m + 1 : 3][n] : ne[bj];
                        f32x4 prev, next;
#pragma unroll
                        for (int j = 0; j < 4; ++j) {
                            const float t1 = fr == 15 ? ups[j] : cur[j]; float pv = dpp_ror1(t1);
                            const float t2 = fr == 0 ? dns[j] : cur[j]; float nx = dpp_ror15(t2);
                            if (BND) { prev[j] = isfirst ? 0.f : pv; next[j] = islast ? 0.f : nx; } else { prev[j] = pv; next[j] = nx; }
                        }
                        cv[bj] = w0[bj] * prev + w1[bj] * cur + w2[bj] * next + bb[bj];
                    }
                    f32x4 a;
#pragma unroll
                    for (int j = 0; j < 4; ++j) { const float g = cv[0][j]; const float sg = __builtin_amdgcn_rcpf(1.0f + __builtin_amdgcn_exp2f(-1.4426950408889634f * g)); a[j] = g * sg * cv[1][j]; }
                    if (r >= 1 && r <= 254 && (!BND || tok < MTOK)) *(u32x2*)(act + (size_t)tok * DFF + fcol + 4 * n) = pack4(a);
                    asm volatile("" ::: "memory");
                }
            }
        }
    }
    __device__ __forceinline__ void operator()(f32x4 (&acc)[2][2][4][2], const Unit& u, int wr, int wc, int fr, int fq) const {
        asm volatile("" : "+v"(fr), "+v"(fq));
        const int tok0 = 254 * u.pm - 1;
        const int pcol = wc * 32 + 8 * fq;
        const bool bnd = (tok0 < 0) || (((tok0 & (SEQP - 1)) + 256) >= SEQP) || (tok0 + 256 > MTOK);
#pragma unroll
        for (int ai = 0; ai < 2; ++ai)
#pragma unroll
            for (int m = 0; m < 4; ++m) {
                const int tok = tok0 + ai * 128 + wr * 64 + m * 16 + fr;
                if (bnd) {
                    const bool valid = (tok >= 0) && (tok < MTOK);
                    float rs = 0.f; if (valid) rs = rsqrtf(rss[tok] * (1.0f / 1024.0f) + EPSV);
#pragma unroll
                    for (int bj = 0; bj < 2; ++bj)
#pragma unroll
                        for (int n = 0; n < 2; ++n) { f32x4 x = acc[ai][bj][m][n] * rs;
#pragma unroll
                            for (int j = 0; j < 4; ++j) x[j] = valid ? x[j] : 0.f;
                            acc[ai][bj][m][n] = x; }
                } else {
                    const float rs = rsqrtf(rss[tok] * (1.0f / 1024.0f) + EPSV);
#pragma unroll
                    for (int bj = 0; bj < 2; ++bj)
#pragma unroll
                        for (int n = 0; n < 2; ++n) acc[ai][bj][m][n] = acc[ai][bj][m][n] * rs;
                }
            }
#pragma unroll
        for (int ai = 0; ai < 2; ++ai) {
            const int blk = 2 * ai + wr;
            if (fr == 0) {
#pragma unroll
                for (int bj = 0; bj < 2; ++bj)
#pragma unroll
                    for (int n = 0; n < 2; ++n) *(LAS f32x4*)(edge + (blk * 2 + 0) * 256 + 128 * bj + pcol + 4 * n) = acc[ai][bj][0][n];
            }
            if (fr == 15) {
#pragma unroll
                for (int bj = 0; bj < 2; ++bj)
#pragma unroll
                    for (int n = 0; n < 2; ++n) *(LAS f32x4*)(edge + (blk * 2 + 1) * 256 + 128 * bj + pcol + 4 * n) = acc[ai][bj][3][n];
            }
        }
        asm volatile("s_waitcnt lgkmcnt(0)\n\ts_barrier" ::: "memory");
        if (bnd) conv_gate<true>(acc, u, wr, wc, fr, fq, tok0, pcol); else conv_gate<false>(acc, u, wr, wc, fr, fq, tok0, pcol);
    }
};

#define XB_TMO      128
#define XB_XCNT(j)  (256  + 64 * (j))
#define XB_XSUB(j)  (1280 + 64 * (j))
#define XB_XGEN(j)  (2304 + 64 * (j))
#define XB_TOP      3328
#define XB_TOPGEN   3392
#define XCD_BAR_WORDS 3456
#define XB_SPIN_CAP (1u << 18)

__device__ __forceinline__ unsigned xb_ld(unsigned* p)              { return __hip_atomic_load(p, __ATOMIC_RELAXED, __HIP_MEMORY_SCOPE_AGENT); }
__device__ __forceinline__ unsigned xb_add(unsigned* p, unsigned v) { return __hip_atomic_fetch_add(p, v, __ATOMIC_RELAXED, __HIP_MEMORY_SCOPE_AGENT); }
__device__ __forceinline__ unsigned xb_xcc_id() { return (unsigned)__builtin_amdgcn_s_getreg((3 << 11) | 20) & 0xFu; }
#define XB_SPIN(cond, bar) do { unsigned _sp = 0; while (cond) { __builtin_amdgcn_s_sleep(1); \
    if ((++_sp & 255u) == 0u) { if (xb_ld(&(bar)[XB_TMO])) break; if (_sp > XB_SPIN_CAP) { atomicAdd(&(bar)[XB_TMO], 1u); break; } } } } while (0)

struct XcdBarrier {
    unsigned* bar; unsigned x;
    volatile LAS unsigned* st;
};

__device__ __forceinline__ XcdBarrier xcd_barrier_post(unsigned* bar, volatile LAS unsigned* st) {
    XcdBarrier b; b.bar = bar; b.x = xb_xcc_id(); b.st = st;
    if (threadIdx.x == 0) (void)xb_add(&bar[XB_XCNT(b.x)], 1u);
    return b;
}
__device__ __forceinline__ void xcd_barrier_complete(unsigned* bar, unsigned x, unsigned& nloc, unsigned& nx) {
    const unsigned G = gridDim.x * gridDim.y * gridDim.z;
    unsigned sum, cnt, mine, sp = 0u;
    for (;;) {
        sum = 0u; cnt = 0u; mine = 0u;
#pragma unroll
        for (unsigned j = 0; j < 16; ++j) { const unsigned c = xb_ld(&bar[XB_XCNT(j)]); sum += c; cnt += (c > 0u) ? 1u : 0u; mine = (j == x) ? c : mine; }
        if (sum == G) break;
        __builtin_amdgcn_s_sleep(1);
        if ((++sp & 255u) == 0u) { if (xb_ld(&bar[XB_TMO])) break; if (sp > XB_SPIN_CAP) { atomicAdd(&bar[XB_TMO], 1u); break; } }
    }
    nloc = mine > 0u ? mine : 1u; nx = cnt > 0u ? cnt : 1u;
}

__device__ __forceinline__ void xcd_barrier(const XcdBarrier& b) {
    asm volatile("s_waitcnt vmcnt(0)" ::: "memory");
    __syncthreads();
    if (threadIdx.x == 0) {
        unsigned* bar = b.bar;
        __builtin_amdgcn_s_waitcnt(0);
        unsigned nloc = b.st[0], nx = b.st[1];
        if (nloc == 0u) { xcd_barrier_complete(bar, b.x, nloc, nx); b.st[0] = nloc; b.st[1] = nx; }
        const unsigned old = xb_add(&bar[XB_XSUB(b.x)], 1u);
        const unsigned gen = old / nloc;
        if (old + 1u == (gen + 1u) * nloc) {
            __builtin_amdgcn_fence(__ATOMIC_RELEASE, "agent");
            asm volatile("s_waitcnt vmcnt(0)" ::: "memory");
            const unsigned og = xb_add(&bar[XB_TOP], 1u);
            const unsigned tg = og / nx;
            if (og + 1u == (tg + 1u) * nx) xb_add(&bar[XB_TOPGEN], 1u);
            else XB_SPIN(xb_ld(&bar[XB_TOPGEN]) == tg, bar);
            __builtin_amdgcn_fence(__ATOMIC_ACQUIRE, "agent");
            xb_add(&bar[XB_XGEN(b.x)], 1u);
            asm volatile("s_waitcnt vmcnt(0)" ::: "memory");
        } else {
            XB_SPIN(xb_ld(&bar[XB_XGEN(b.x)]) == gen, bar);
            __builtin_amdgcn_fence(__ATOMIC_ACQUIRE, "agent");
            asm volatile("s_waitcnt vmcnt(0)" ::: "memory");
        }
    }
    __syncthreads();
}

__device__ __forceinline__ void p0_prologue(const Params& p, LAS unsigned char* lds, const int wave_s) {
    int tid_ = wave_s * 64 + lane_id(); asm volatile("" : "+v"(tid_));
    const int tid = tid_, G = gridDim.x, gt = blockIdx.x * 512 + tid, GT = G * 512, lane = tid & 63, wid = tid >> 6;
    unsigned char* ws = p.ws;
    bf16_t* WQKP = (bf16_t*)(ws + WS_WQKP); bf16_t* WV = (bf16_t*)(ws + WS_WV); bf16_t* WOUT = (bf16_t*)(ws + WS_WOUT); bf16_t* WUP = (bf16_t*)(ws + WS_WUP); bf16_t* WDN = (bf16_t*)(ws + WS_WDN);
    LAS float* tile = (LAS float*)lds;
    for (int t = blockIdx.x; t < 2752; t += G) {
        const float* src; int ld, k0, n0, kind;
        if (t < 512) { kind = 0; k0 = (t >> 5) * 64; n0 = (t & 31) * 64; src = p.in[I_WIN]; ld = 2048; }
        else if (t < 640) { const int u = t - 512; kind = 1; k0 = (u >> 4) * 64; n0 = (u & 15) * 64; src = p.in[I_WOUT]; ld = 1024; }
        else if (t < 2048) { const int u = t - 640; kind = 2; k0 = (u / 88) * 64; n0 = (u % 88) * 64; src = p.in[I_WUP]; ld = 5632; }
        else { const int u = t - 2048; kind = 3; k0 = (u >> 4) * 64; n0 = (u & 15) * 64; src = p.in[I_WDOWN]; ld = 1024; }
#pragma unroll
        for (int i = 0; i < 8; ++i) { const int e = tid + i * 512, kk = e >> 6, nn = e & 63;
            float v = src[(size_t)(k0 + kk) * ld + n0 + nn];
            if (kind == 1) v *= p.in[I_SUBG][(k0 + kk) & 127] * 0.8f;
            if (kind == 2) v *= p.in[I_N2G][k0 + kk];
            tile[kk * 65 + nn] = v; }
        __syncthreads();
#pragma unroll
        for (int i = 0; i < 8; ++i) { const int e = tid + i * 512, nn = e >> 6, kk = e & 63, n = n0 + nn; bf16_t* dst;
            if (kind == 0) {
                if (n < 1024 || n >= 1536) { const int L = n < 1024 ? n : n - 512; const int prow = (L & ~255) + ((L >> 5) & 1) * 128 + ((L >> 6) & 3) * 32 + (L & 31); dst = WQKP + (size_t)prow * 1024 + k0 + kk; }
                else dst = WV + (size_t)(n - 1024) * 1024 + k0 + kk;
            } else if (kind == 1) dst = WOUT + (size_t)n * 1024 + k0 + kk;
            else if (kind == 2) { const int f = n < DFF ? n : n - DFF; const int prow = (f >> 7) * 256 + (n < DFF ? 0 : 128) + (f & 127); dst = WUP + (size_t)prow * 1024 + k0 + kk; }
            else dst = WDN + (size_t)n * DFF + k0 + kk;
            *dst = f2bf(tile[kk * 65 + nn]); }
        __syncthreads();
    }
    for (int o = gt; o < 128 * 1024; o += GT) {
        const int n = o & 1023, c = o >> 10;
        const float* wo = p.in[I_WOUT] + (size_t)512 * 1024 + n;
        float a0 = 0.f, a1 = 0.f, a2 = 0.f, a3 = 0.f;
        const float* wp = p.in[I_WPOOL] + (size_t)c * 128; const float* ps = p.in[I_PSCALE];
#pragma unroll 8
        for (int e = 0; e < 128; ++e) {
            a0 += wp[e] * ps[e] * wo[(size_t)e * 1024];
            a1 += wp[16384 + e] * ps[128 + e] * wo[(size_t)(128 + e) * 1024];
            a2 += wp[32768 + e] * ps[256 + e] * wo[(size_t)(256 + e) * 1024];
            a3 += wp[49152 + e] * ps[384 + e] * wo[(size_t)(384 + e) * 1024];
        }
        bf16_t* dst = WOUT + (size_t)n * 1024 + 512 + c;
        dst[0] = f2bf(a0); dst[128] = f2bf(a1); dst[256] = f2bf(a2); dst[384] = f2bf(a3);
    }
    float* cosT = (float*)(ws + WS_COS); float* sinT = (float*)(ws + WS_SIN);
    for (int o = gt; o < 8192 * 32; o += GT) {
        const int s = o >> 5, i = o & 31;
        const float inv = exp2f(-(float)i * (13.287712379549449f / 32.0f));
        const float ang = (float)s * inv;
        const double rev = (double)ang * 0.15915494309189535; const float fr = (float)(rev - __builtin_rint(rev));
        cosT[o] = __builtin_amdgcn_cosf(fr); sinT[o] = __builtin_amdgcn_sinf(fr);
    }
    float* rss = (float*)(ws + WS_RSS);
    for (int o = gt; o < MTOK; o += GT) rss[o] = 0.f;
    if (gt < 128) ((float*)(ws + WS_QKG))[gt] = gt < 64 ? p.in[I_QG][gt] : p.in[I_KG][gt - 64];
    bf16_t* H = (bf16_t*)(ws + WS_H);
    f32x4 g1[4];
#pragma unroll
    for (int i = 0; i < 4; ++i) g1[i] = *(const f32x4*)(p.in[I_N1G] + lane * 4 + 256 * i);
    for (int row = blockIdx.x * 8 + wid; row < MTOK; row += G * 8) {
        const float* xr = (row < NPROMPT ? p.in[I_XP] + (size_t)row * DM : p.in[I_XS] + (size_t)(row - NPROMPT) * DM) + lane * 4;
        f32x4 v[4]; float ss = 0.f;
#pragma unroll
        for (int i = 0; i < 4; ++i) { v[i] = *(const f32x4*)(xr + 256 * i); ss += (v[i][0] * v[i][0] + v[i][1] * v[i][1]) + (v[i][2] * v[i][2] + v[i][3] * v[i][3]); }
#pragma unroll
        for (int o = 1; o < 64; o <<= 1) ss += __shfl_xor(ss, o);
        const float rstd = rsqrtf(ss * (1.0f / 1024.0f) + EPSV);
        bf16_t* hr = H + (size_t)row * DM + lane * 4;
#pragma unroll
        for (int i = 0; i < 4; ++i) *(u32x2*)(hr + 256 * i) = pack4(v[i] * rstd * g1[i]);
    }
}

__device__ __forceinline__ void pool_phase(const bf16_t* zp, bf16_t* mixed, const int wave_s) {
    const int lane = lane_id(), c0 = lane * 8, half = 1 << (lane >> 4);
    for (int r = blockIdx.x * 8 + wave_s; r < MTOK / 64; r += gridDim.x * 8) {
        const int tok_base = r * 64, S = tok_base < NPROMPT ? SEQP : SEQS, pos0 = tok_base & (S - 1);
        const bf16_t* zs = zp + (size_t)(tok_base - pos0) * 512 + c0;
        bf16_t* ms = mixed + (size_t)(tok_base - pos0) * DM + 512 + c0;
        float s0 = 0.f, s1 = 0.f, s2 = 0.f, s3 = 0.f, s4 = 0.f, s5 = 0.f, s6 = 0.f, s7 = 0.f;
#define POOL_ACC(V_, sg) do { s0 += sg bflo(V_.x); s1 += sg bfhi(V_.x); s2 += sg bflo(V_.y); s3 += sg bfhi(V_.y); s4 += sg bflo(V_.z); s5 += sg bfhi(V_.z); s6 += sg bflo(V_.w); s7 += sg bfhi(V_.w); } while (0)
#pragma unroll
        for (int d = -8; d < 8; ++d) { const int j = pos0 + d; if (d >= -half && d < half && j >= 0 && j < S) { const u32x4 w = *(const u32x4*)(zs + (size_t)j * 512); POOL_ACC(w, +); } }
#pragma unroll 4
        for (int i = 0; i < 64; ++i) {
            const int sp = pos0 + i, lo = max(sp - half, 0), hi = min(sp + half - 1, S - 1);
            const float ic = 1.0f / (float)(hi - lo + 1);
            const u32x4 w = *(const u32x4*)(zs + (size_t)sp * 512);
            u32x4 o;
            o.x = cvt_pk_bf16(s0 * ic - bflo(w.x), s1 * ic - bfhi(w.x)); o.y = cvt_pk_bf16(s2 * ic - bflo(w.y), s3 * ic - bfhi(w.y));
            o.z = cvt_pk_bf16(s4 * ic - bflo(w.z), s5 * ic - bfhi(w.z)); o.w = cvt_pk_bf16(s6 * ic - bflo(w.w), s7 * ic - bfhi(w.w));
            *(u32x4*)(ms + (size_t)sp * DM) = o;
            const int jn = sp + half, jo = sp - half;
            if (jn < S) { const u32x4 wn = *(const u32x4*)(zs + (size_t)jn * 512); POOL_ACC(wn, +); }
            if (jo >= 0) { const u32x4 wo = *(const u32x4*)(zs + (size_t)jo * 512); POOL_ACC(wo, -); }
        }
    }
}

#define MFMA32(a, b, c) __builtin_amdgcn_mfma_f32_32x32x16_bf16((a), (b), (c), 0, 0, 0)
constexpr int KROW = 256, VROW = 128, KBUF = 64 * KROW, VBUF = 128 * VROW, ABUF = KBUF + VBUF, QROW = 272;
__device__ __forceinline__ bf16x8 packp(const f32x16& x, int s) {
    u32x4 w;
    w.x = cvt_pk_bf16(x[8 * s + 0], x[8 * s + 1]); w.y = cvt_pk_bf16(x[8 * s + 2], x[8 * s + 3]); w.z = cvt_pk_bf16(x[8 * s + 4], x[8 * s + 5]); w.w = cvt_pk_bf16(x[8 * s + 6], x[8 * s + 7]);
    return __builtin_bit_cast(bf16x8, w);
}
__device__ __forceinline__ void attn_phase_online(LAS unsigned char* lds, const bf16_t* q, const bf16_t* k, const bf16_t* vT, bf16_t* mixed, float lam, const int wave_s) {
    int tid_ = wave_s * 64 + lane_id(); asm volatile("" : "+v"(tid_));
    const int tid = tid_, lane = tid & 63, r32 = lane & 31, hi = lane >> 5, wid = __builtin_amdgcn_readfirstlane(tid >> 6), G = gridDim.x;
    unsigned koff[2], voff[2];
#pragma unroll
    for (int i = 0; i < 2; ++i) {
        const int kr = 4 * (2 * wid + i) + (lane >> 4), kc = (lane & 15) ^ (kr & 15); koff[i] = (unsigned)(kr * 512 + kc * 8) * 2u;
        const int vd = 8 * (2 * wid + i) + (lane >> 3), vc = (lane & 7) ^ ((vd >> 1) & 7); voff[i] = (unsigned)(vd * MTOK + vc * 8) * 2u;
    }
    const int kx = r32 & 15, vx = (r32 >> 1) & 7;
    const unsigned lds0 = (unsigned)(size_t)lds;
#define ATT_DMA1(sbase, voff_, ldsdst) do { unsigned keep_; asm volatile("s_mov_b32 %0, m0\n\ts_mov_b32 m0, %3\n\ts_nop 0\n\tglobal_load_lds_dwordx4 %1, %2\n\ts_mov_b32 m0, %0" : "=&s"(keep_) : "v"(voff_), "s"(sbase), "s"(ldsdst) : "memory"); } while (0)
#define ATT_DMA(buf, kp, vp) do { _Pragma("unroll") for (int _i = 0; _i < 2; ++_i) { \
        ATT_DMA1((kp), koff[_i], lds0 + (unsigned)((buf) + (2 * wid + _i) * 1024)); \
        ATT_DMA1((vp), voff[_i], lds0 + (unsigned)((buf) + KBUF + (2 * wid + _i) * 1024)); } } while (0)
    for (int U = blockIdx.x; U < 2048; U += G) {
        const int rnd = U >> 8, cc = U & 255, x = cc & 7, jj = cc >> 3;
        int S, tok0, h, qb;
        if (rnd < 4) { const int pair = 4 * x + rnd; S = SEQS; tok0 = NPROMPT + (pair >> 2) * SEQS; h = pair & 3; qb = jj; }
        else { const int pair = 8 * x + 2 * (rnd - 4) + (jj >> 4); S = SEQP; tok0 = (pair >> 2) * SEQP; h = pair & 3; qb = jj & 15; }
        const bf16_t* Kg = k + (size_t)tok0 * 512 + h * 128;
        const bf16_t* Vg = vT + (size_t)(h * 128) * MTOK + tok0;
        const int NT = S / 64;
        const size_t qrow = (size_t)tok0 + qb * 256 + wid * 32 + r32;
        ATT_DMA(0, Kg, Vg);
        LAS unsigned char* Qs = lds + 2 * ABUF + wid * (32 * QROW) + r32 * QROW + hi * 16;
#pragma unroll
        for (int m = 0; m < 2; ++m)
#pragma unroll
            for (int d0 = 0; d0 < 4; ++d0) *(LAS bf16x8*)(Qs + m * 128 + d0 * 32) = *(const bf16x8*)(q + qrow * 512 + h * 128 + m * 64 + d0 * 16 + hi * 8);
        f32x16 o[2][4];
#pragma unroll
        for (int m = 0; m < 2; ++m)
#pragma unroll
            for (int db = 0; db < 4; ++db)
#pragma unroll
                for (int i = 0; i < 16; ++i) o[m][db][i] = 0.f;
        float mu[2] = {-1e30f, -1e30f}, l[2] = {0.f, 0.f};
        asm volatile("s_waitcnt vmcnt(0)" ::: "memory");
        __syncthreads();
        for (int t = 0; t < NT; ++t) {
            const int cb = (t & 1) * ABUF, nb = ((t + 1) & 1) * ABUF;
            if (t + 1 < NT) ATT_DMA(nb, Kg + (size_t)(t + 1) * 64 * 512, Vg + (t + 1) * 64);
            const LAS unsigned char* Kb = lds + cb + r32 * KROW;
            const LAS unsigned char* Vb = lds + cb + KBUF + r32 * VROW;
#pragma unroll
            for (int m = 0; m < 2; ++m) {
                f32x16 s0, s1;
#pragma unroll
                for (int i = 0; i < 16; ++i) { s0[i] = 0.f; s1[i] = 0.f; }
#pragma unroll
                for (int d0 = 0; d0 < 4; ++d0) {
                    const int kpos = ((m * 8 + d0 * 2 + hi) ^ kx) * 16;
                    const bf16x8 k0 = *(const LAS bf16x8*)(Kb + kpos), k1 = *(const LAS bf16x8*)(Kb + 32 * KROW + kpos);
                    const bf16x8 qv = *(const LAS bf16x8*)(Qs + m * 128 + d0 * 32);
                    s0 = MFMA32(k0, qv, s0); s1 = MFMA32(k1, qv, s1);
                    if (d0 == 1) __builtin_amdgcn_sched_barrier(0);
                }
                __builtin_amdgcn_sched_barrier(0);
                float mx = fmaxf(s0[0], s1[0]);
#pragma unroll
                for (int i = 1; i < 16; ++i) mx = fmaxf(mx, fmaxf(s0[i], s1[i]));
                mx = fmaxf(mx, __shfl_xor(mx, 32));
                const bool need = mx > mu[m] + 8.0f;
                if (__builtin_amdgcn_ballot_w64(need) != 0ull) {
                    const float nm = need ? mx : mu[m];
                    const float alpha = __builtin_amdgcn_exp2f(mu[m] - nm);
                    mu[m] = nm; l[m] *= alpha;
#pragma unroll
                    for (int db = 0; db < 4; ++db)
#pragma unroll
                        for (int i = 0; i < 16; ++i) o[m][db][i] *= alpha;
                }
                const float mm = mu[m];
                float ls = 0.f;
#pragma unroll
                for (int i = 0; i < 16; ++i) { s0[i] = __builtin_amdgcn_exp2f(s0[i] - mm); s1[i] = __builtin_amdgcn_exp2f(s1[i] - mm); ls += s0[i] + s1[i]; }
                l[m] += ls;
                const bf16x8 p0 = packp(s0, 0), p1 = packp(s0, 1), p2 = packp(s1, 0), p3 = packp(s1, 1);
                __builtin_amdgcn_sched_barrier(0);
#pragma unroll
                for (int db = 0; db < 4; ++db) {
                    const LAS unsigned char* vb = Vb + db * 32 * VROW;
                    const bf16x8 v0 = *(const LAS bf16x8*)(vb + ((0 + hi) ^ vx) * 16), v1 = *(const LAS bf16x8*)(vb + ((2 + hi) ^ vx) * 16), v2 = *(const LAS bf16x8*)(vb + ((4 + hi) ^ vx) * 16), v3 = *(const LAS bf16x8*)(vb + ((6 + hi) ^ vx) * 16);
                    o[m][db] = MFMA32(v0, p0, o[m][db]); o[m][db] = MFMA32(v1, p1, o[m][db]); o[m][db] = MFMA32(v2, p2, o[m][db]); o[m][db] = MFMA32(v3, p3, o[m][db]);
                    __builtin_amdgcn_sched_barrier(0);
                }
            }
            asm volatile("s_waitcnt vmcnt(0)" ::: "memory");
            __syncthreads();
        }
        const float l0 = l[0] + __shfl_xor(l[0], 32), l1 = l[1] + __shfl_xor(l[1], 32);
        const float c0 = 1.0f / l0, c1 = lam / l1;
        float ss = 0.f;
#pragma unroll
        for (int db = 0; db < 4; ++db)
#pragma unroll
            for (int i = 0; i < 16; ++i) { const float v = o[0][db][i] * c0 - o[1][db][i] * c1; o[0][db][i] = v; ss += v * v; }
        ss += __shfl_xor(ss, 32);
        const float rstd = rsqrtf(ss * (1.0f / 128.0f) + EPSV);
        bf16_t* orow = mixed + qrow * DM + h * 128 + 4 * hi;
#pragma unroll
        for (int db = 0; db < 4; ++db)
#pragma unroll
            for (int i4 = 0; i4 < 4; ++i4) {
                u32x2 w; w.x = cvt_pk_bf16(o[0][db][4 * i4] * rstd, o[0][db][4 * i4 + 1] * rstd); w.y = cvt_pk_bf16(o[0][db][4 * i4 + 2] * rstd, o[0][db][4 * i4 + 3] * rstd);
                *(u32x2*)(orow + 32 * db + 8 * i4) = w;
            }
    }
}


__device__ __forceinline__ void attn_phase_fast(LAS unsigned char* lds, const bf16_t* q, const bf16_t* k, const bf16_t* vT, bf16_t* mixed, float lam, const int wave_s) {
    int tid_ = wave_s * 64 + lane_id(); asm volatile("" : "+v"(tid_));
    const int wid = __builtin_amdgcn_readfirstlane(tid_ >> 6), G = gridDim.x;
    const unsigned lds0 = (unsigned)(size_t)lds;
    if (wid >= 4) __builtin_amdgcn_s_setprio(1);
    for (int U = blockIdx.x; U < 2048; U += G) {
        int lane_ = tid_ & 63; asm volatile("" : "+v"(lane_));
        const int lane = lane_, r32 = lane & 31, hi = lane >> 5;
        unsigned koff[2], voff[2];
#pragma unroll
        for (int i = 0; i < 2; ++i) {
            const int kr = 4 * (2 * wid + i) + (lane >> 4), kc = (lane & 15) ^ (kr & 15); koff[i] = (unsigned)(kr * 512 + kc * 8) * 2u;
            const int vd = 8 * (2 * wid + i) + (lane >> 3), vc = (lane & 7) ^ ((vd >> 1) & 7); voff[i] = (unsigned)(vd * MTOK + vc * 8) * 2u;
        }
        const int kx = r32 & 15, vx = (r32 >> 1) & 7;
        const int rnd = U >> 8, cc = U & 255, x = cc & 7, jj = cc >> 3;
        int S, tok0, h, qb;
        if (rnd < 4) { const int pair = 4 * x + rnd; S = SEQS; tok0 = NPROMPT + (pair >> 2) * SEQS; h = pair & 3; qb = jj; }
        else { const int pair = 8 * x + 2 * (rnd - 4) + (jj >> 4); S = SEQP; tok0 = (pair >> 2) * SEQP; h = pair & 3; qb = jj & 15; }
        const bf16_t* Kg = k + (size_t)tok0 * 512 + h * 128;
        const bf16_t* Vg = vT + (size_t)(h * 128) * MTOK + tok0;
        const int NT = S / 64;
        const size_t qrow = (size_t)tok0 + qb * 256 + wid * 32 + r32;
        ATT_DMA(0, Kg, Vg);
        LAS unsigned char* Qs = lds + 2 * ABUF + wid * (32 * QROW) + r32 * QROW + hi * 16;
#pragma unroll
        for (int m = 0; m < 2; ++m)
#pragma unroll
            for (int d0 = 0; d0 < 4; ++d0) *(LAS bf16x8*)(Qs + m * 128 + d0 * 32) = *(const bf16x8*)(q + qrow * 512 + h * 128 + m * 64 + d0 * 16 + hi * 8);
        f32x16 o[2][4];
#pragma unroll
        for (int m = 0; m < 2; ++m)
#pragma unroll
            for (int db = 0; db < 4; ++db)
#pragma unroll
                for (int i = 0; i < 16; ++i) o[m][db][i] = 0.f;
        float l[2] = {0.f, 0.f};
        asm volatile("s_waitcnt vmcnt(0)" ::: "memory");
        __syncthreads();
        for (int t = 0; t < NT; ++t) {
            const int cb = (t & 1) * ABUF, nb = ((t + 1) & 1) * ABUF;
            int ln = lane; asm volatile("" : "+v"(ln));
            const int r32 = ln & 31, hi = ln >> 5, kx = r32 & 15, vx = (r32 >> 1) & 7;
            if (t + 1 < NT) {
                unsigned koff[2], voff[2];
#pragma unroll
                for (int i = 0; i < 2; ++i) {
                    const int kr = 4 * (2 * wid + i) + (ln >> 4), kc = (ln & 15) ^ (kr & 15); koff[i] = (unsigned)(kr * 512 + kc * 8) * 2u;
                    const int vd = 8 * (2 * wid + i) + (ln >> 3), vc = (ln & 7) ^ ((vd >> 1) & 7); voff[i] = (unsigned)(vd * MTOK + vc * 8) * 2u;
                }
                ATT_DMA(nb, Kg + (size_t)(t + 1) * 64 * 512, Vg + (t + 1) * 64);
            }
            const LAS unsigned char* Qs = lds + 2 * ABUF + wid * (32 * QROW) + r32 * QROW + hi * 16;
            int kxh = (kx >> 1) << 5, vxh = (vx >> 1) << 5, kq = cb + r32 * KROW + ((hi ^ (kx & 1)) << 4), vq = cb + KBUF + r32 * VROW + ((hi ^ (vx & 1)) << 4);
            asm volatile("" : "+v"(kxh), "+v"(vxh), "+v"(kq), "+v"(vq));
            const LAS unsigned char* Kb = lds + kq;
            const LAS unsigned char* Vb = lds + vq;
#pragma unroll
            for (int m = 0; m < 2; ++m) {
                f32x16 s0, s1;
#pragma unroll
                for (int i = 0; i < 16; ++i) { s0[i] = 0.f; s1[i] = 0.f; }
#pragma unroll
                for (int d0 = 0; d0 < 4; ++d0) {
                    const int kpos = ((m * 4 + d0) << 5) ^ kxh;
                    const bf16x8 k0 = *(const LAS bf16x8*)(Kb + kpos), k1 = *(const LAS bf16x8*)(Kb + 32 * KROW + kpos);
                    const bf16x8 qv = *(const LAS bf16x8*)(Qs + m * 128 + d0 * 32);
                    s0 = MFMA32(k0, qv, s0); s1 = MFMA32(k1, qv, s1);
                    if (d0 == 1) __builtin_amdgcn_sched_barrier(0);
                }
                __builtin_amdgcn_sched_barrier(0);
                float ls = 0.f, ls2 = 0.f;
#pragma unroll
                for (int i = 0; i < 16; ++i) { float e0 = __builtin_amdgcn_exp2f(s0[i]), e1 = __builtin_amdgcn_exp2f(s1[i]); asm volatile("" : "+v"(e0), "+v"(e1)); s0[i] = e0; s1[i] = e1; ls += e0; ls2 += e1; }
                ls += ls2;
                l[m] += ls;
                const bf16x8 p0 = packp(s0, 0), p1 = packp(s0, 1), p2 = packp(s1, 0), p3 = packp(s1, 1);
                __builtin_amdgcn_sched_barrier(0);
#pragma unroll
                for (int db = 0; db < 4; ++db) {
                    const LAS unsigned char* vb = Vb + db * 32 * VROW;
                    const bf16x8 v0 = *(const LAS bf16x8*)(vb + (0 ^ vxh)), v1 = *(const LAS bf16x8*)(vb + (32 ^ vxh)), v2 = *(const LAS bf16x8*)(vb + (64 ^ vxh)), v3 = *(const LAS bf16x8*)(vb + (96 ^ vxh));
                    o[m][db] = MFMA32(v0, p0, o[m][db]); o[m][db] = MFMA32(v1, p1, o[m][db]); o[m][db] = MFMA32(v2, p2, o[m][db]); o[m][db] = MFMA32(v3, p3, o[m][db]);
                    if (db == 1) __builtin_amdgcn_sched_barrier(0);
                }
                __builtin_amdgcn_sched_barrier(0);
            }
            asm volatile("s_waitcnt vmcnt(0)" ::: "memory");
            __syncthreads();
        }
        const float l0 = l[0] + __shfl_xor(l[0], 32), l1 = l[1] + __shfl_xor(l[1], 32);
        const float c0 = 1.0f / l0, c1 = lam / l1;
        float ss = 0.f;
#pragma unroll
        for (int db = 0; db < 4; ++db)
#pragma unroll
            for (int i = 0; i < 16; ++i) { const float v = o[0][db][i] * c0 - o[1][db][i] * c1; o[0][db][i] = v; ss += v * v; }
        ss += __shfl_xor(ss, 32);
        const float rstd = rsqrtf(ss * (1.0f / 128.0f) + EPSV);
        int lane2 = lane_id(); asm volatile("" : "+v"(lane2));
        bf16_t* orow = mixed + ((size_t)tok0 + qb * 256 + wid * 32 + (lane2 & 31)) * DM + h * 128 + 4 * (lane2 >> 5);
#pragma unroll
        for (int db = 0; db < 4; ++db)
#pragma unroll
            for (int i4 = 0; i4 < 4; ++i4) {
                u32x2 w; w.x = cvt_pk_bf16(o[0][db][4 * i4] * rstd, o[0][db][4 * i4 + 1] * rstd); w.y = cvt_pk_bf16(o[0][db][4 * i4 + 2] * rstd, o[0][db][4 * i4 + 3] * rstd);
                *(u32x2*)(orow + 32 * db + 8 * i4) = w;
            }
    }
    __builtin_amdgcn_s_setprio(0);
}


__global__ void __launch_bounds__(512) fwd_megakernel(Params p) {
    extern __shared__ __attribute__((aligned(16))) unsigned char lds_raw[];
    LAS unsigned char* lds = (LAS unsigned char*)lds_raw;
    cg::grid_group grid = cg::this_grid();
    unsigned char* ws = p.ws;
    const int G = gridDim.x, c = blockIdx.x;
    const int wave_s = __builtin_amdgcn_readfirstlane((int)threadIdx.x >> 6);
    bf16_t* WQKP = (bf16_t*)(ws + WS_WQKP); bf16_t* WV = (bf16_t*)(ws + WS_WV); bf16_t* WOUT = (bf16_t*)(ws + WS_WOUT); bf16_t* WUP = (bf16_t*)(ws + WS_WUP); bf16_t* WDN = (bf16_t*)(ws + WS_WDN);
    float* cosT = (float*)(ws + WS_COS); float* sinT = (float*)(ws + WS_SIN); float* rss = (float*)(ws + WS_RSS);
    bf16_t* Q = (bf16_t*)(ws + WS_Q); bf16_t* Kt = (bf16_t*)(ws + WS_K); bf16_t* VT = (bf16_t*)(ws + WS_VT); bf16_t* ZP = (bf16_t*)(ws + WS_ZP);
    bf16_t* H = (bf16_t*)(ws + WS_H); bf16_t* MIX = H; bf16_t* XB = (bf16_t*)(ws + WS_XB); bf16_t* ACT = (bf16_t*)(ws + WS_ACT);

    volatile LAS unsigned* xb_st = (volatile LAS unsigned*)(lds + LDS_STAGE + LDS_EDGE);
    if (threadIdx.x < 4) xb_st[threadIdx.x] = 0u;
    __syncthreads();
    const XcdBarrier xbar = xcd_barrier_post((unsigned*)(ws + WS_BAR), xb_st);
#ifndef SKIP_P0
    p0_prologue(p, lds, wave_s);
#endif
    grid.sync();
#ifndef SKIP_P1
    {
        pg8::Gemm g{H, WQKP, MTOK, 1536, DM}; pg8::StaticOrder S; S.init(MTOK, 1536, G, c);
        EpiQKP E{ws, (const float*)(ws + WS_QKG), cosT, sinT};
        pg8::gemm_phase<EpiQKP, pg8::StaticOrder, true, true>(lds, g, S, E, wave_s);
    }
    {
        pg8::Gemm g{WV, H, 512, MTOK, DM}; pg8::StaticOrder S; S.init(512, MTOK, G, c);
        EpiVT E{VT};
        pg8::gemm_phase<EpiVT, pg8::StaticOrder, true, true>(lds, g, S, E, wave_s);
    }
#endif
    xcd_barrier(xbar);
#ifndef SKIP_P2
    pool_phase(ZP, MIX, wave_s);
    {
        float d1 = 0.f, d2 = 0.f;
        for (int i = 0; i < 64; ++i) { d1 += p.in[I_LQ1][i] * p.in[I_LK1][i]; d2 += p.in[I_LQ2][i] * p.in[I_LK2][i]; }
        const float lam = __builtin_bit_cast(float, __builtin_amdgcn_readfirstlane(__builtin_bit_cast(int, __expf(d1) - __expf(d2) + 0.2f)));
        float gq = 0.f, gk = 0.f;
        for (int i = 0; i < 64; ++i) { gq = fmaxf(gq, fabsf(p.in[I_QG][i])); gk = fmaxf(gk, fabsf(p.in[I_KG][i])); }
        const float bound = 64.0f * QSCALE * gq * gk;
        if (bound < 100.0f) attn_phase_fast(lds, Q, Kt, VT, MIX, lam, wave_s);
        else attn_phase_online(lds, Q, Kt, VT, MIX, lam, wave_s);
    }
#endif
    xcd_barrier(xbar);
#ifndef SKIP_P3
    {
        pg8::Gemm g{MIX, WOUT, MTOK, DM, DM}; pg8::StaticOrder S; S.init(MTOK, DM, G, c);
        EpiRes1 E{p.in[I_XP], p.in[I_XS], XB, rss};
        pg8::gemm_phase<EpiRes1, pg8::StaticOrder, true, true>(lds, g, S, E, wave_s);
    }
#endif
    xcd_barrier(xbar);
#ifndef SKIP_P4
    {
        pg8::Gemm g{XB, WUP, MTOK, 2 * DFF, DM}; pg8::StaticOrder S; S.init_tiles(517, 22, G, c, 1);
        EpiConvGate E{rss, p.in[I_CONVW], p.in[I_CONVB], ACT, (LAS float*)(lds + LDS_STAGE)};
        pg8::gemm_phase<EpiConvGate, pg8::StaticOrder, true, true>(lds, g, S, E, wave_s);
    }
#endif
    xcd_barrier(xbar);
#ifndef SKIP_P5
    {
        pg8::Gemm g{ACT, WDN, MTOK, DM, DFF}; pg8::StaticOrder S; S.init(MTOK, DM, G, c);
        EpiRes2 E{XB, p.out};
        pg8::gemm_phase<EpiRes2, pg8::StaticOrder, true, true>(lds, g, S, E, wave_s);
    }
#endif
}

extern "C" void kernel_launch(void* const* d_in, const int* in_sizes, int n_in, void* d_out, int out_size, void* d_ws, size_t ws_size, hipStream_t stream) {
    static int grid_blocks = 0;
    if (grid_blocks == 0) {
        if (n_in != 19 || ws_size < WS_END) { fprintf(stderr, "kernel_launch: unexpected n_in %d / ws_size %zu (need %zu)\n", n_in, ws_size, (size_t)WS_END); grid_blocks = -1; return; }
        int dev = 0, cus = 0, per_cu = 0;
        (void)hipGetDevice(&dev);
        (void)hipDeviceGetAttribute(&cus, hipDeviceAttributeMultiprocessorCount, dev);
        if (hipFuncSetAttribute((const void*)fwd_megakernel, hipFuncAttributeMaxDynamicSharedMemorySize, LDS_TOTAL) != hipSuccess) { fprintf(stderr, "kernel_launch: hipFuncSetAttribute failed\n"); grid_blocks = -1; return; }
        if (hipOccupancyMaxActiveBlocksPerMultiprocessor(&per_cu, (const void*)fwd_megakernel, 512, LDS_TOTAL) != hipSuccess || per_cu < 1) { fprintf(stderr, "kernel_launch: occupancy query failed (%d)\n", per_cu); (void)hipGetLastError(); per_cu = 1; }
        grid_blocks = cus * per_cu;
    }
    if (grid_blocks < 0) return;
    if (hipMemsetAsync((char*)d_ws + WS_BAR, 0, XCD_BAR_WORDS * sizeof(unsigned), stream) != hipSuccess) { fprintf(stderr, "kernel_launch: hipMemsetAsync of the barrier words failed\n"); return; }
    Params p{};
    for (int i = 0; i < 19; ++i) p.in[i] = (const float*)d_in[i];
    p.out = (float*)d_out; p.ws = (unsigned char*)d_ws;
    void* args[] = {&p};
    hipError_t e = hipLaunchCooperativeKernel((const void*)fwd_megakernel, dim3(grid_blocks), dim3(512), args, LDS_TOTAL, stream);
    if (e != hipSuccess) fprintf(stderr, "cooperative launch failed: %s (grid %d)\n", hipGetErrorString(e), grid_blocks);
}
```

```cpp
#include <hip/hip_runtime.h>
#include <hip/hip_cooperative_groups.h>
#include <cstdio>
#include <cstdint>
namespace cg = cooperative_groups;

namespace pg8 {
#define PG8_LAS __attribute__((address_space(3)))
typedef unsigned short bf16_t;
typedef short bf16x8 __attribute__((ext_vector_type(8)));
typedef float f32x4 __attribute__((ext_vector_type(4)));
typedef unsigned u32x4 __attribute__((ext_vector_type(4)));
constexpr int BM = 256, BK = 64, HALF = 128, HTB = HALF * BK * 2  , STAGE_BYTES = 8 * HTB, NXCD = 8, WGM = 8;

__host__ __device__ __forceinline__ int lds_byte(int r, int c) { const int st = (r >> 4) * 2 + (c >> 5), rr = r & 15, cc = c & 31, ob = rr * 64 + cc * 2; return st * 1024 + (ob ^ (((ob >> 9) & 1) << 5)); }
__host__ __device__ __forceinline__ void stage_rc(int b, int& R, int& C) { const int st = b / 1024, sb = b % 1024, swz = sb ^ (((sb >> 9) & 1) << 5); R = (st >> 1) * 16 + swz / 64; C = (st & 1) * 32 + (swz % 64) / 2; }
__host__ __device__ __forceinline__ int perm32(int rho) { const int n = rho >> 4, i = rho & 15; return 8 * (i >> 2) + 4 * n + (i & 3); }

struct Unit { int pm, pn; };
struct Gemm { const bf16_t* A; const bf16_t* Bt; int M, N, K; };

struct StaticOrder {
    int nM, nN, nwg, G, c; int halo;
    __host__ __device__ void init_tiles(int nM_, int nN_, int G_, int c_, int halo_) { nM = nM_; nN = nN_; nwg = nM * nN; G = G_; c = c_; halo = halo_; }
    __device__ __forceinline__ long a_off(int pm, int K) const { return halo ? ((long)254 * pm - 1) * (long)K * 2 : (long)pm * 256 * (long)K * 2; }
    __host__ __device__ void init(int M, int N, int G_, int c_) { nM = M / BM; nN = N / BM; nwg = nM * nN; G = G_; c = c_; halo = 0; }
    __host__ __device__ bool next(int i, Unit& u) const {
        const long L = (long)i * G + c; if (L >= nwg) return false;
        int wgid = (int)L; { const int q = nwg / NXCD, r = nwg % NXCD, xcd = wgid % NXCD, off = wgid / NXCD; wgid = (xcd < r ? xcd * (q + 1) : r * (q + 1) + (xcd - r) * q) + off; }
        const int nig = WGM * nN, gid = wgid / nig, fm = gid * WGM, gsz = (nM - fm) < WGM ? (nM - fm) : WGM;
        u.pm = fm + ((wgid % nig) % gsz); u.pn = (wgid % nig) / gsz; return true;
    }
    __device__ __forceinline__ void a_ready(const Unit&) const {}
    __device__ __forceinline__ void done(const Unit&) const {}
};
__device__ __forceinline__ unsigned cvt_pk_bf16(float lo, float hi) { unsigned r; asm volatile("v_cvt_pk_bf16_f32 %0, %1, %2" : "=v"(r) : "v"(lo), "v"(hi)); return r; }
typedef float f32x2 __attribute__((ext_vector_type(2)));
typedef float f32x2 __attribute__((ext_vector_type(2)));
template <class Epi, class Sched, bool ALIGN_EPI = false, bool SP2 = false>
__device__ __forceinline__ void gemm_phase(PG8_LAS unsigned char* lds, const Gemm g, const Sched& S, const Epi& E, const int wave_s) {
    int tid_; asm volatile("v_mbcnt_lo_u32_b32 %0, -1, 0\n\tv_mbcnt_hi_u32_b32 %0, -1, %0" : "=v"(tid_)); tid_ += wave_s * 64;
    const int tid = tid_, wid = __builtin_amdgcn_readfirstlane(tid >> 6), lane = tid & 63, wr = wid >> 2, wc = wid & 3, fr = lane & 15, fq = lane >> 4;
    const int K = g.K, nt = K / BK;
    unsigned voffA[2], voffB[2];
#pragma unroll
    for (int i = 0; i < 2; ++i) { int R, C; stage_rc(tid * 16 + i * 8192, R, C); const int Rb = Epi::PERM ? ((R & ~31) + perm32(R & 31)) : R;
        voffA[i] = (unsigned)(R * K + C) * 2u; voffB[i] = (unsigned)(Rb * K + C) * 2u; }
    const size_t kstep = (size_t)(BK * 2);
    const size_t hstep = (size_t)HALF * K * 2;
    const size_t tstep = 2 * hstep;
    const unsigned ldsw = (unsigned)wid * 1024u;
    const int aoff = lds_byte(wr * 64 + fr, fq * 8), boff = lds_byte(wc * 32 + fr, fq * 8);
#define PG8_SA(b, h) (((b) * 2 + (h)) * HTB)
#define PG8_SB(b, h) ((4 + (b) * 2 + (h)) * HTB)
#define PG8_STAGE(bufoff, gbase, voff) do { _Pragma("unroll") for (int _i = 0; _i < 2; ++_i) \
        __builtin_amdgcn_global_load_lds((const unsigned*)((const char*)(gbase) + (voff)[_i]), (PG8_LAS unsigned*)(lds + (bufoff) + ldsw + _i * 8192), 16, 0, 0); } while (0)
#define PG8_LDA(dst, b, h) do { _Pragma("unroll") for (int m = 0; m < 4; ++m) _Pragma("unroll") for (int k = 0; k < 2; ++k) dst[m][k] = *(const PG8_LAS bf16x8*)(lds + PG8_SA(b, h) + aoff + m * 2048 + k * 1024); } while (0)
#define PG8_LDB(dst, b, h) do { _Pragma("unroll") for (int n = 0; n < 2; ++n) _Pragma("unroll") for (int k = 0; k < 2; ++k) dst[n][k] = *(const PG8_LAS bf16x8*)(lds + PG8_SB(b, h) + boff + n * 2048 + k * 1024); } while (0)
#define PG8_MMA(ai, bj, At, Bt) do { __builtin_amdgcn_s_setprio(1); _Pragma("unroll") for (int m = 0; m < 4; ++m) _Pragma("unroll") for (int n = 0; n < 2; ++n) _Pragma("unroll") for (int k = 0; k < 2; ++k) \
        acc[ai][bj][m][n] = __builtin_amdgcn_mfma_f32_16x16x32_bf16(Bt[n][k], At[m][k], acc[ai][bj][m][n], 0, 0, 0); __builtin_amdgcn_s_setprio(0); } while (0)
#define PG8_WAIT_V(n) asm volatile("s_waitcnt vmcnt(" #n ")" ::: "memory")
#define PG8_WAIT_L(n) asm volatile("s_waitcnt lgkmcnt(" #n ")" ::: "memory")
#define PG8_BAR __builtin_amdgcn_s_barrier()
#define PG8_SCHED __builtin_amdgcn_sched_barrier(0)
    Unit cur, nxt; int ui = 0;
    if (!S.next(0, cur)) return;
    f32x4 acc[2][2][4][2];
#pragma unroll
    for (int a = 0; a < 2; ++a)
#pragma unroll
        for (int b = 0; b < 2; ++b)
#pragma unroll
            for (int m = 0; m < 4; ++m)
#pragma unroll
                for (int n = 0; n < 2; ++n) acc[a][b][m][n] = (f32x4){0.f, 0.f, 0.f, 0.f};
    bf16x8 At[4][2], B0[2][2], B1[2][2];
    const char* cA = (const char*)g.A + S.a_off(cur.pm, K); const char* cB = (const char*)g.Bt + (size_t)cur.pn * tstep;
    S.a_ready(cur);
    if constexpr (SP2) {
        PG8_STAGE(PG8_SB(0, 0), cB, voffB); PG8_STAGE(PG8_SB(0, 1), cB + hstep, voffB); PG8_STAGE(PG8_SA(0, 0), cA, voffA); PG8_STAGE(PG8_SA(0, 1), cA + hstep, voffA);
        if (wr == 1) PG8_BAR;
        PG8_WAIT_V(2); PG8_BAR;
        PG8_STAGE(PG8_SB(1, 0), cB + kstep, voffB); PG8_STAGE(PG8_SA(1, 0), cA + kstep, voffA); PG8_STAGE(PG8_SB(1, 1), cB + hstep + kstep, voffB);
        PG8_WAIT_V(6); PG8_BAR;
    } else {
        PG8_STAGE(PG8_SB(0, 0), cB, voffB); PG8_STAGE(PG8_SA(0, 0), cA, voffA); PG8_STAGE(PG8_SB(0, 1), cB + hstep, voffB); PG8_STAGE(PG8_SA(0, 1), cA + hstep, voffA);
        if (wr == 1) PG8_BAR;
        PG8_WAIT_V(4); PG8_BAR;
        PG8_STAGE(PG8_SB(1, 0), cB + kstep, voffB); PG8_STAGE(PG8_SA(1, 0), cA + kstep, voffA); PG8_STAGE(PG8_SB(1, 1), cB + hstep + kstep, voffB);
        PG8_WAIT_V(6); PG8_BAR;
    }
    for (;;) {
        const bool has_next = S.next(ui + 1, nxt);
        const char* nA = has_next ? (const char*)g.A + S.a_off(nxt.pm, K) : cA; const char* nB = has_next ? (const char*)g.Bt + (size_t)nxt.pn * tstep : cB;
        for (int t = 0; t < nt; t += 2) {
            const bool last = (t == nt - 2);
            const char* a1 = cA + (size_t)(t + 1) * kstep;
            const char* a2 = last ? nA : cA + (size_t)(t + 2) * kstep; const char* b2 = last ? nB : cB + (size_t)(t + 2) * kstep;
            const char* a3 = a2 + kstep; const char* b3 = b2 + kstep;
            if (last && has_next) S.a_ready(nxt);
            if constexpr (SP2) {
            PG8_LDB(B0, 0, 0); PG8_LDB(B1, 0, 1); PG8_SCHED; PG8_LDA(At, 0, 0); PG8_STAGE(PG8_SA(1, 1), a1 + hstep, voffA);
            PG8_WAIT_V(8); PG8_WAIT_L(0); PG8_BAR; PG8_MMA(0, 0, At, B0); PG8_MMA(0, 1, At, B1); PG8_BAR; PG8_SCHED;
            PG8_LDA(At, 0, 1); PG8_STAGE(PG8_SB(0, 0), b2, voffB); PG8_STAGE(PG8_SB(0, 1), b2 + hstep, voffB); PG8_STAGE(PG8_SA(0, 0), a2, voffA);
            PG8_WAIT_V(8); PG8_WAIT_L(0); PG8_BAR; PG8_MMA(1, 0, At, B0); PG8_MMA(1, 1, At, B1); PG8_BAR; PG8_SCHED;
            PG8_LDB(B0, 1, 0); PG8_LDB(B1, 1, 1); PG8_SCHED; PG8_LDA(At, 1, 0); PG8_STAGE(PG8_SA(0, 1), a2 + hstep, voffA);
            PG8_WAIT_V(8); PG8_WAIT_L(0); PG8_BAR; PG8_MMA(0, 0, At, B0); PG8_MMA(0, 1, At, B1); PG8_BAR; PG8_SCHED;
            PG8_LDA(At, 1, 1); PG8_STAGE(PG8_SB(1, 0), b3, voffB); PG8_STAGE(PG8_SB(1, 1), b3 + hstep, voffB); PG8_STAGE(PG8_SA(1, 0), a3, voffA);
            PG8_WAIT_V(8); PG8_WAIT_L(0); PG8_BAR; PG8_MMA(1, 0, At, B0); PG8_MMA(1, 1, At, B1); PG8_BAR; PG8_SCHED;
            } else {
            PG8_LDB(B0, 0, 0); PG8_SCHED; PG8_LDA(At, 0, 0); PG8_STAGE(PG8_SA(1, 1), a1 + hstep, voffA);
            PG8_WAIT_L(8); PG8_BAR; PG8_WAIT_L(0); PG8_MMA(0, 0, At, B0); PG8_BAR; PG8_SCHED;
            PG8_LDB(B1, 0, 1); PG8_STAGE(PG8_SB(0, 0), b2, voffB);
            PG8_BAR; PG8_WAIT_L(0); PG8_MMA(0, 1, At, B1); PG8_BAR;
            PG8_LDA(At, 0, 1); PG8_STAGE(PG8_SA(0, 0), a2, voffA);
            PG8_BAR; PG8_WAIT_L(0); PG8_MMA(1, 0, At, B0); PG8_BAR; PG8_SCHED;
            PG8_STAGE(PG8_SB(0, 1), b2 + hstep, voffB);
            PG8_WAIT_V(6); PG8_BAR; PG8_MMA(1, 1, At, B1); PG8_BAR;
            PG8_LDB(B0, 1, 0); PG8_SCHED; PG8_LDA(At, 1, 0); PG8_STAGE(PG8_SA(0, 1), a2 + hstep, voffA);
            PG8_WAIT_L(8); PG8_BAR; PG8_WAIT_L(0); PG8_MMA(0, 0, At, B0); PG8_BAR; PG8_SCHED;
            PG8_LDB(B1, 1, 1); PG8_STAGE(PG8_SB(1, 0), b3, voffB);
            PG8_BAR; PG8_WAIT_L(0); PG8_MMA(0, 1, At, B1); PG8_BAR;
            PG8_LDA(At, 1, 1); PG8_STAGE(PG8_SA(1, 0), a3, voffA);
            PG8_BAR; PG8_WAIT_L(0); PG8_MMA(1, 0, At, B0); PG8_BAR; PG8_SCHED;
            PG8_STAGE(PG8_SB(1, 1), b3 + hstep, voffB);
            PG8_WAIT_V(6); PG8_BAR; PG8_MMA(1, 1, At, B1); PG8_BAR;
            }
        }
        if constexpr (ALIGN_EPI) { if (wr == 0) PG8_BAR; }
        if constexpr (!Epi::AFTER_DRAIN) { E(acc, cur, wr, wc, fr, fq); S.done(cur); }
        if (!has_next) break;
#pragma unroll
        for (int a = 0; a < 2; ++a)
#pragma unroll
            for (int b = 0; b < 2; ++b)
#pragma unroll
                for (int m = 0; m < 4; ++m)
#pragma unroll
                    for (int n = 0; n < 2; ++n) acc[a][b][m][n] = (f32x4){0.f, 0.f, 0.f, 0.f};
        cur = nxt; cA = nA; cB = nB; ++ui;
        if constexpr (ALIGN_EPI) { if (wr == 1) PG8_BAR; }
    }
    PG8_WAIT_V(0);
    if constexpr (!ALIGN_EPI) { if (wr == 0) PG8_BAR; }
    PG8_BAR;
    if constexpr (Epi::AFTER_DRAIN) { E.fused(acc, cur, wr, wc, fr, fq, lds, wid, lane); S.done(cur); }
#undef PG8_SA
#undef PG8_SB
#undef PG8_STAGE
#undef PG8_LDA
#undef PG8_LDB
#undef PG8_MMA
#undef PG8_WAIT_V
#undef PG8_WAIT_L
#undef PG8_BAR
#undef PG8_SCHED
}
}

using pg8::bf16_t; using pg8::bf16x8; using pg8::f32x4; using pg8::u32x4; using pg8::Unit; using pg8::cvt_pk_bf16;
#define LAS __attribute__((address_space(3)))
typedef float f32x16 __attribute__((ext_vector_type(16)));
typedef unsigned u32x2 __attribute__((ext_vector_type(2)));
constexpr int DM = 1024, MTOK = 131072, NPROMPT = 65536, SEQP = 4096, SEQS = 8192, DFF = 2816;
constexpr float EPSV = 1e-6f;
constexpr float QSCALE = 0.125f * 1.4426950408889634f;
constexpr size_t MiB = 1024 * 1024;
constexpr size_t WS_WQKP = 0, WS_WV = 3 * MiB, WS_WOUT = 4 * MiB, WS_WUP = 6 * MiB, WS_WDN = 17 * MiB, WS_COS = 23 * MiB, WS_SIN = 24 * MiB, WS_RSS = 25 * MiB, WS_QKG = 25 * MiB + 768 * 1024, WS_BAR = 25 * MiB + 832 * 1024,
                 WS_XB = 26 * MiB, WS_Q = WS_XB, WS_K = WS_XB + 128 * MiB, WS_ACT = 282 * MiB, WS_VT = WS_ACT, WS_ZP = WS_ACT + 128 * MiB, WS_H = WS_ACT + 256 * MiB,
                 WS_END = WS_ACT + 704 * MiB;
constexpr int LDS_STAGE = 131072, LDS_EDGE = 8192, LDS_TOTAL = 147456;

struct Params {
    const float* in[19];
    float* out;
    unsigned char* ws;
};
enum { I_XP = 0, I_XS, I_N1G, I_WIN, I_QG, I_KG, I_LQ1, I_LK1, I_LQ2, I_LK2, I_SUBG, I_WPOOL, I_PSCALE, I_WOUT, I_N2G, I_WUP, I_CONVW, I_CONVB, I_WDOWN };

__device__ __forceinline__ int lane_id() { int l; asm volatile("v_mbcnt_lo_u32_b32 %0, -1, 0\n\tv_mbcnt_hi_u32_b32 %0, -1, %0" : "=v"(l)); return l; }
__device__ __forceinline__ bf16_t f2bf(float x) { unsigned u = __float_as_uint(x); u += 0x7fffu + ((u >> 16) & 1u); return (bf16_t)(u >> 16); }
__device__ __forceinline__ float bf2f(unsigned short b) { return __uint_as_float(((unsigned)b) << 16); }
__device__ __forceinline__ float bflo(unsigned w) { return __uint_as_float(w << 16); }
__device__ __forceinline__ float bfhi(unsigned w) { return __uint_as_float(w & 0xffff0000u); }
__device__ __forceinline__ u32x4 pack8(f32x4 a, f32x4 b) { u32x4 w; w.x = cvt_pk_bf16(a[0], a[1]); w.y = cvt_pk_bf16(a[2], a[3]); w.z = cvt_pk_bf16(b[0], b[1]); w.w = cvt_pk_bf16(b[2], b[3]); return w; }
__device__ __forceinline__ u32x2 pack4(f32x4 a) { u32x2 w; w.x = cvt_pk_bf16(a[0], a[1]); w.y = cvt_pk_bf16(a[2], a[3]); return w; }

struct EpiQKP {
    static constexpr bool PERM = true, AFTER_DRAIN = false;
    unsigned char* ws; const float *qkg  , *cosT, *sinT;
    __device__ __forceinline__ void operator()(f32x4 (&acc)[2][2][4][2], const Unit& u, int wr, int wc, int fr, int fq) const {
        asm volatile("" : "+v"(fr), "+v"(fq));
        const int kind = u.pn >> 1;
        bf16_t* base = (bf16_t*)(ws + (kind == 0 ? WS_Q : (kind == 1 ? WS_K : WS_ZP)));
        const int colbase = (u.pn & 1) * 256 + wc * 64, i0 = 8 * fq;
        if (kind < 2) {
            const float* g = qkg + kind * 64;
            const float osc = kind == 0 ? QSCALE : 1.0f;
            const f32x4 g00 = *(const f32x4*)(g + i0), g01 = *(const f32x4*)(g + i0 + 4), g10 = *(const f32x4*)(g + 32 + i0), g11 = *(const f32x4*)(g + 32 + i0 + 4);
#define QKP_LD(m) const int row##m = u.pm * 256 + ai * 128 + wr * 64 + (m) * 16 + fr; const int pos##m = row##m < NPROMPT ? (row##m & (SEQP - 1)) : (row##m & (SEQS - 1)); \
            const f32x4 cs0_##m = *(const f32x4*)(cosT + pos##m * 32 + i0), sn0_##m = *(const f32x4*)(sinT + pos##m * 32 + i0), cs1_##m = *(const f32x4*)(cosT + pos##m * 32 + i0 + 4), sn1_##m = *(const f32x4*)(sinT + pos##m * 32 + i0 + 4);
#define QKP_DO(m) { const f32x4 a00 = acc[ai][0][m][0], a01 = acc[ai][0][m][1], a10 = acc[ai][1][m][0], a11 = acc[ai][1][m][1]; \
                f32x4 sq = a00 * a00 + a01 * a01 + a10 * a10 + a11 * a11; float ss = (sq[0] + sq[1]) + (sq[2] + sq[3]); \
                ss += __shfl_xor(ss, 16); ss += __shfl_xor(ss, 32); const float rstd = rsqrtf(ss * (1.0f / 64.0f) + EPSV) * osc; \
                const f32x4 y00 = a00 * rstd * g00, y01 = a01 * rstd * g01, y10 = a10 * rstd * g10, y11 = a11 * rstd * g11; \
                bf16_t* rp = base + (size_t)row##m * 512 + colbase + i0; \
                *(u32x4*)(rp) = pack8(y00 * cs0_##m - y10 * sn0_##m, y01 * cs1_##m - y11 * sn1_##m); \
                *(u32x4*)(rp + 32) = pack8(y10 * cs0_##m + y00 * sn0_##m, y11 * cs1_##m + y01 * sn1_##m); }
#pragma unroll
            for (int ai = 0; ai < 2; ++ai) {
                QKP_LD(0) QKP_LD(1) QKP_LD(2) QKP_LD(3)
                QKP_DO(0) QKP_DO(1) QKP_DO(2) QKP_DO(3)
                asm volatile("" ::: "memory");
            }
        } else {
#pragma unroll
            for (int ai = 0; ai < 2; ++ai)
#pragma unroll
                for (int m = 0; m < 4; ++m) {
                    const int row = u.pm * 256 + ai * 128 + wr * 64 + m * 16 + fr;
                    bf16_t* rp = base + (size_t)row * 512 + colbase + i0;
#pragma unroll
                    for (int bj = 0; bj < 2; ++bj) *(u32x4*)(rp + 32 * bj) = pack8(acc[ai][bj][m][0], acc[ai][bj][m][1]);
                }
        }
    }
};
struct EpiVT {
    static constexpr bool PERM = true, AFTER_DRAIN = false;
    bf16_t* vT;
    __device__ __forceinline__ void operator()(f32x4 (&acc)[2][2][4][2], const Unit& u, int wr, int wc, int fr, int fq) const {
        asm volatile("" : "+v"(fr), "+v"(fq));
#pragma unroll
        for (int ai = 0; ai < 2; ++ai)
#pragma unroll
            for (int m = 0; m < 4; ++m) {
                const int row = u.pm * 256 + ai * 128 + wr * 64 + m * 16 + fr;
                bf16_t* rp = vT + (size_t)row * MTOK + (size_t)u.pn * 256 + wc * 32 + 16 * (fq >> 1) + 4 * (fq & 1);
#pragma unroll
                for (int bj = 0; bj < 2; ++bj)
#pragma unroll
                    for (int n = 0; n < 2; ++n) *(u32x2*)(rp + 128 * bj + 8 * n) = pack4(acc[ai][bj][m][n]);
            }
    }
};
struct EpiRes1 {
    static constexpr bool PERM = true, AFTER_DRAIN = false;
    const float *xp, *xs; bf16_t* xb; float* rss;
    __device__ __forceinline__ void operator()(f32x4 (&acc)[2][2][4][2], const Unit& u, int wr, int wc, int fr, int fq) const {
        asm volatile("" : "+v"(fr), "+v"(fq));
        const int col0 = u.pn * 256 + wc * 32 + 8 * fq;
#define RES1_LD(m) const int row##m = u.pm * 256 + ai * 128 + wr * 64 + (m) * 16 + fr; \
        const float* xr##m = (row##m < NPROMPT ? xp + (size_t)row##m * DM : xs + (size_t)(row##m - NPROMPT) * DM) + col0; \
        const f32x4 xa##m = *(const f32x4*)(xr##m), xb_##m = *(const f32x4*)(xr##m + 4), xc##m = *(const f32x4*)(xr##m + 128), xd##m = *(const f32x4*)(xr##m + 132);
#define RES1_DO(m) { bf16_t* brow = xb + (size_t)row##m * DM + col0; \
            const f32x4 a = acc[ai][0][m][0] + xa##m, b = acc[ai][0][m][1] + xb_##m, c = acc[ai][1][m][0] + xc##m, d = acc[ai][1][m][1] + xd##m; \
            *(u32x4*)(brow) = pack8(a, b); *(u32x4*)(brow + 128) = pack8(c, d); \
            f32x4 sq = a * a + b * b + c * c + d * d; float ss = (sq[0] + sq[1]) + (sq[2] + sq[3]); \
            ss += __shfl_xor(ss, 16); ss += __shfl_xor(ss, 32); if (fq == 0) atomicAdd(rss + row##m, ss); }
#pragma unroll
        for (int ai = 0; ai < 2; ++ai) {
            RES1_LD(0) RES1_LD(1) RES1_LD(2) RES1_LD(3)
            RES1_DO(0) RES1_DO(1) RES1_DO(2) RES1_DO(3)
            asm volatile("" ::: "memory");
        }
    }
};
struct EpiRes2 {
    static constexpr bool PERM = true, AFTER_DRAIN = false;
    const bf16_t* xb; float* out;
    __device__ __forceinline__ void operator()(f32x4 (&acc)[2][2][4][2], const Unit& u, int wr, int wc, int fr, int fq) const {
        asm volatile("" : "+v"(fr), "+v"(fq));
        const int col0 = u.pn * 256 + wc * 32 + 8 * fq;
        const size_t r0 = (size_t)(u.pm * 256 + wr * 64 + fr) * DM + col0;
#define RES2_LD(ai, m) const u32x4 wA##ai##m = *(const u32x4*)(xb + r0 + (size_t)((ai) * 128 + (m) * 16) * DM), wB##ai##m = *(const u32x4*)(xb + r0 + (size_t)((ai) * 128 + (m) * 16) * DM + 128);
#define RES2_DO(ai, m) { float* orow = out + r0 + (size_t)((ai) * 128 + (m) * 16) * DM; \
            *(f32x4*)(orow) = acc[ai][0][m][0] + (f32x4){bflo(wA##ai##m.x), bfhi(wA##ai##m.x), bflo(wA##ai##m.y), bfhi(wA##ai##m.y)}; \
            *(f32x4*)(orow + 4) = acc[ai][0][m][1] + (f32x4){bflo(wA##ai##m.z), bfhi(wA##ai##m.z), bflo(wA##ai##m.w), bfhi(wA##ai##m.w)}; \
            *(f32x4*)(orow + 128) = acc[ai][1][m][0] + (f32x4){bflo(wB##ai##m.x), bfhi(wB##ai##m.x), bflo(wB##ai##m.y), bfhi(wB##ai##m.y)}; \
            *(f32x4*)(orow + 132) = acc[ai][1][m][1] + (f32x4){bflo(wB##ai##m.z), bfhi(wB##ai##m.z), bflo(wB##ai##m.w), bfhi(wB##ai##m.w)}; }
        RES2_LD(0, 0) RES2_LD(0, 1) RES2_LD(0, 2) RES2_LD(0, 3) RES2_LD(1, 0) RES2_LD(1, 1) RES2_LD(1, 2) RES2_LD(1, 3)
        RES2_DO(0, 0) RES2_DO(0, 1) RES2_DO(0, 2) RES2_DO(0, 3) RES2_DO(1, 0) RES2_DO(1, 1) RES2_DO(1, 2) RES2_DO(1, 3)
        asm volatile("" ::: "memory");
    }
};
__device__ __forceinline__ float dpp_ror1(float v) { return __builtin_bit_cast(float, __builtin_amdgcn_update_dpp(0, __builtin_bit_cast(int, v), 0x121, 0xf, 0xf, false)); }
__device__ __forceinline__ float dpp_ror15(float v) { return __builtin_bit_cast(float, __builtin_amdgcn_update_dpp(0, __builtin_bit_cast(int, v), 0x12F, 0xf, 0xf, false)); }
struct EpiConvGate {
    static constexpr bool PERM = true, AFTER_DRAIN = false;
    const float *rss, *convw, *convb; bf16_t* act; LAS float* edge;
    template <bool BND> __device__ __forceinline__ void conv_gate(f32x4 (&acc)[2][2][4][2], const Unit& u, int wr, int wc, int fr, int fq, int tok0, int pcol) const {
        const int fcol = u.pn * 128 + pcol;
#pragma unroll
        for (int n = 0; n < 2; ++n) {
            f32x4 w0[2], w1[2], w2[2], bb[2];
#pragma unroll
            for (int bj = 0; bj < 2; ++bj) { const int c = bj * DFF + fcol + 4 * n;
                w0[bj] = *(const f32x4*)(convw + c); w1[bj] = *(const f32x4*)(convw + 2 * DFF + c); w2[bj] = *(const f32x4*)(convw + 4 * DFF + c); bb[bj] = *(const f32x4*)(convb + c); }
#pragma unroll
            for (int ai = 0; ai < 2; ++ai) {
                const int blk = 2 * ai + wr;
                f32x4 pe[2], ne[2];
#pragma unroll
                for (int bj = 0; bj < 2; ++bj) {
                    pe[bj] = blk > 0 ? *(const LAS f32x4*)(edge + ((blk - 1) * 2 + 1) * 256 + 128 * bj + pcol + 4 * n) : (f32x4){0.f, 0.f, 0.f, 0.f};
                    ne[bj] = blk < 3 ? *(const LAS f32x4*)(edge + ((blk + 1) * 2 + 0) * 256 + 128 * bj + pcol + 4 * n) : (f32x4){0.f, 0.f, 0.f, 0.f};
                }
#pragma unroll
                for (int m = 0; m < 4; ++m) {
                    const int r = ai * 128 + wr * 64 + m * 16 + fr, tok = tok0 + r;
                    bool isfirst = false, islast = false;
                    if (BND) { const int S1 = (tok < NPROMPT ? SEQP : SEQS) - 1, pos = tok & S1; isfirst = pos == 0; islast = pos == S1; }
                    f32x4 cv[2];
#pragma unroll
                    for (int bj = 0; bj < 2; ++bj) {
                        const f32x4 cur = acc[ai][bj][m][n];
                        const f32x4 ups = m > 0 ? acc[ai][bj][m > 0 ? m - 1 : 0][n] : pe[bj];
                        const f32x4 dns = m < 3 ? acc[ai][bj][m < 3 ? m + 1 : 3][n] : ne[bj];
                        f32x4 prev, next;
#pragma unroll
                        for (int j = 0; j < 4; ++j) {
                            const float t1 = fr == 15 ? ups[j] : cur[j]; float pv = dpp_ror1(t1);
                            const float t2 = fr == 0 ? dns[j] : cur[j]; float nx = dpp_ror15(t2);
                            if (BND) { prev[j] = isfirst ? 0.f : pv; next[j] = islast ? 0.f : nx; } else { prev[j] = pv; next[j] = nx; }
                        }
                        cv[bj] = w0[bj] * prev + w1[bj] * cur + w2[bj] * next + bb[bj];
                    }
                    f32x4 a;
#pragma unroll
                    for (int j = 0; j < 4; ++j) { const float g = cv[0][j]; const float sg = __builtin_amdgcn_rcpf(1.0f + __builtin_amdgcn_exp2f(-1.4426950408889634f * g)); a[j] = g * sg * cv[1][j]; }
                    if (r >= 1 && r <= 254 && (!BND || tok < MTOK)) *(u32x2*)(act + (size_t)tok * DFF + fcol + 4 * n) = pack4(a);
                    asm volatile("" ::: "memory");
                }
            }
        }
    }
    __device__ __forceinline__ void operator()(f32x4 (&acc)[2][2][4][2], const Unit& u, int wr, int wc, int fr, int fq) const {
        asm volatile("" : "+v"(fr), "+v"(fq));
        const int tok0 = 254 * u.pm - 1;
        const int pcol = wc * 32 + 8 * fq;
        const bool bnd = (tok0 < 0) || (((tok0 & (SEQP - 1)) + 256) >= SEQP) || (tok0 + 256 > MTOK);
#pragma unroll
        for (int ai = 0; ai < 2; ++ai)
#pragma unroll
            for (int m = 0; m < 4; ++m) {
                const int tok = tok0 + ai * 128 + wr * 64 + m * 16 + fr;
                if (bnd) {
                    const bool valid = (tok >= 0) && (tok < MTOK);
                    float rs = 0.f; if (valid) rs = rsqrtf(rss[tok] * (1.0f / 1024.0f) + EPSV);
#pragma unroll
                    for (int bj = 0; bj < 2; ++bj)
#pragma unroll
                        for (int n = 0; n < 2; ++n) { f32x4 x = acc[ai][bj][m][n] * rs;
#pragma unroll
                            for (int j = 0; j < 4; ++j) x[j] = valid ? x[j] : 0.f;
                            acc[ai][bj][m][n] = x; }
                } else {
                    const float rs = rsqrtf(rss[tok] * (1.0f / 1024.0f) + EPSV);
#pragma unroll
                    for (int bj = 0; bj < 2; ++bj)
#pragma unroll
                        for (int n = 0; n < 2; ++n) acc[ai][bj][m][n] = acc[ai][bj][m][n] * rs;
                }
            }
#pragma unroll
        for (int ai = 0; ai < 2; ++ai) {
            const int blk = 2 * ai + wr;
            if (fr == 0) {
#pragma unroll
                for (int bj = 0; bj < 2; ++bj)
#pragma unroll
                    for (int n = 0; n < 2; ++n) *(LAS f32x4*)(edge + (blk * 2 + 0) * 256 + 128 * bj + pcol + 4 * n) = acc[ai][bj][0][n];
            }
            if (fr == 15) {
#pragma unroll
                for (int bj = 0; bj < 2; ++bj)
#pragma unroll
                    for (int n = 0; n < 2; ++n) *(LAS f32x4*)(edge + (blk * 2 + 1) * 256 + 128 * bj + pcol + 4 * n) = acc[ai][bj][3][n];
            }
        }
        asm volatile("s_waitcnt lgkmcnt(0)\n\ts_barrier" ::: "memory");
        if (bnd) conv_gate<true>(acc, u, wr, wc, fr, fq, tok0, pcol); else conv_gate<false>(acc, u, wr, wc, fr, fq, tok0, pcol);
    }
};

#define XB_TMO      128
#define XB_XCNT(j)  (256  + 64 * (j))
#define XB_XSUB(j)  (1280 + 64 * (j))
#define XB_XGEN(j)  (2304 + 64 * (j))
#define XB_TOP      3328
#define XB_TOPGEN   3392
#define XCD_BAR_WORDS 3456
#define XB_SPIN_CAP (1u << 18)

__device__ __forceinline__ unsigned xb_ld(unsigned* p)              { return __hip_atomic_load(p, __ATOMIC_RELAXED, __HIP_MEMORY_SCOPE_AGENT); }
__device__ __forceinline__ unsigned xb_add(unsigned* p, unsigned v) { return __hip_atomic_fetch_add(p, v, __ATOMIC_RELAXED, __HIP_MEMORY_SCOPE_AGENT); }
__device__ __forceinline__ unsigned xb_xcc_id() { return (unsigned)__builtin_amdgcn_s_getreg((3 << 11) | 20) & 0xFu; }
#define XB_SPIN(cond, bar) do { unsigned _sp = 0; while (cond) { __builtin_amdgcn_s_sleep(1); \
    if ((++_sp & 255u) == 0u) { if (xb_ld(&(bar)[XB_TMO])) break; if (_sp > XB_SPIN_CAP) { atomicAdd(&(bar)[XB_TMO], 1u); break; } } } } while (0)

struct XcdBarrier {
    unsigned* bar; unsigned x;
    volatile LAS unsigned* st;
};

__device__ __forceinline__ XcdBarrier xcd_barrier_post(unsigned* bar, volatile LAS unsigned* st) {
    XcdBarrier b; b.bar = bar; b.x = xb_xcc_id(); b.st = st;
    if (threadIdx.x == 0) (void)xb_add(&bar[XB_XCNT(b.x)], 1u);
    return b;
}
__device__ __forceinline__ void xcd_barrier_complete(unsigned* bar, unsigned x, unsigned& nloc, unsigned& nx) {
    const unsigned G = gridDim.x * gridDim.y * gridDim.z;
    unsigned sum, cnt, mine, sp = 0u;
    for (;;) {
        sum = 0u; cnt = 0u; mine = 0u;
#pragma unroll
        for (unsigned j = 0; j < 16; ++j) { const unsigned c = xb_ld(&bar[XB_XCNT(j)]); sum += c; cnt += (c > 0u) ? 1u : 0u; mine = (j == x) ? c : mine; }
        if (sum == G) break;
        __builtin_amdgcn_s_sleep(1);
        if ((++sp & 255u) == 0u) { if (xb_ld(&bar[XB_TMO])) break; if (sp > XB_SPIN_CAP) { atomicAdd(&bar[XB_TMO], 1u); break; } }
    }
    nloc = mine > 0u ? mine : 1u; nx = cnt > 0u ? cnt : 1u;
}

__device__ __forceinline__ void xcd_barrier(const XcdBarrier& b) {
    asm volatile("s_waitcnt vmcnt(0)" ::: "memory");
    __syncthreads();
    if (threadIdx.x == 0) {
        unsigned* bar = b.bar;
        __builtin_amdgcn_s_waitcnt(0);
        unsigned nloc = b.st[0], nx = b.st[1];
        if (nloc == 0u) { xcd_barrier_complete(bar, b.x, nloc, nx); b.st[0] = nloc; b.st[1] = nx; }
        const unsigned old = xb_add(&bar[XB_XSUB(b.x)], 1u);
        const unsigned gen = old / nloc;
        if (old + 1u == (gen + 1u) * nloc) {
            __builtin_amdgcn_fence(__ATOMIC_RELEASE, "agent");
            asm volatile("s_waitcnt vmcnt(0)" ::: "memory");
            const unsigned og = xb_add(&bar[XB_TOP], 1u);
            const unsigned tg = og / nx;
            if (og + 1u == (tg + 1u) * nx) xb_add(&bar[XB_TOPGEN], 1u);
            else XB_SPIN(xb_ld(&bar[XB_TOPGEN]) == tg, bar);
            __builtin_amdgcn_fence(__ATOMIC_ACQUIRE, "agent");
            xb_add(&bar[XB_XGEN(b.x)], 1u);
            asm volatile("s_waitcnt vmcnt(0)" ::: "memory");
        } else {
            XB_SPIN(xb_ld(&bar[XB_XGEN(b.x)]) == gen, bar);
            __builtin_amdgcn_fence(__ATOMIC_ACQUIRE, "agent");
            asm volatile("s_waitcnt vmcnt(0)" ::: "memory");
        }
    }
    __syncthreads();
}

__device__ __forceinline__ void p0_prologue(const Params& p, LAS unsigned char* lds, const int wave_s) {
    int tid_ = wave_s * 64 + lane_id(); asm volatile("" : "+v"(tid_));
    const int tid = tid_, G = gridDim.x, gt = blockIdx.x * 512 + tid, GT = G * 512, lane = tid & 63, wid = tid >> 6;
    unsigned char* ws = p.ws;
    bf16_t* WQKP = (bf16_t*)(ws + WS_WQKP); bf16_t* WV = (bf16_t*)(ws + WS_WV); bf16_t* WOUT = (bf16_t*)(ws + WS_WOUT); bf16_t* WUP = (bf16_t*)(ws + WS_WUP); bf16_t* WDN = (bf16_t*)(ws + WS_WDN);
    LAS float* tile = (LAS float*)lds;
    for (int t = blockIdx.x; t < 2752; t += G) {
        const float* src; int ld, k0, n0, kind;
        if (t < 512) { kind = 0; k0 = (t >> 5) * 64; n0 = (t & 31) * 64; src = p.in[I_WIN]; ld = 2048; }
        else if (t < 640) { const int u = t - 512; kind = 1; k0 = (u >> 4) * 64; n0 = (u & 15) * 64; src = p.in[I_WOUT]; ld = 1024; }
        else if (t < 2048) { const int u = t - 640; kind = 2; k0 = (u / 88) * 64; n0 = (u % 88) * 64; src = p.in[I_WUP]; ld = 5632; }
        else { const int u = t - 2048; kind = 3; k0 = (u >> 4) * 64; n0 = (u & 15) * 64; src = p.in[I_WDOWN]; ld = 1024; }
#pragma unroll
        for (int i = 0; i < 8; ++i) { const int e = tid + i * 512, kk = e >> 6, nn = e & 63;
            float v = src[(size_t)(k0 + kk) * ld + n0 + nn];
            if (kind == 1) v *= p.in[I_SUBG][(k0 + kk) & 127] * 0.8f;
            if (kind == 2) v *= p.in[I_N2G][k0 + kk];
            tile[kk * 65 + nn] = v; }
        __syncthreads();
#pragma unroll
        for (int i = 0; i < 8; ++i) { const int e = tid + i * 512, nn = e >> 6, kk = e & 63, n = n0 + nn; bf16_t* dst;
            if (kind == 0) {
                if (n < 1024 || n >= 1536) { const int L = n < 1024 ? n : n - 512; const int prow = (L & ~255) + ((L >> 5) & 1) * 128 + ((L >> 6) & 3) * 32 + (L & 31); dst = WQKP + (size_t)prow * 1024 + k0 + kk; }
                else dst = WV + (size_t)(n - 1024) * 1024 + k0 + kk;
            } else if (kind == 1) dst = WOUT + (size_t)n * 1024 + k0 + kk;
            else if (kind == 2) { const int f = n < DFF ? n : n - DFF; const int prow = (f >> 7) * 256 + (n < DFF ? 0 : 128) + (f & 127); dst = WUP + (size_t)prow * 1024 + k0 + kk; }
            else dst = WDN + (size_t)n * DFF + k0 + kk;
            *dst = f2bf(tile[kk * 65 + nn]); }
        __syncthreads();
    }
    for (int o = gt; o < 128 * 1024; o += GT) {
        const int n = o & 1023, c = o >> 10;
        const float* wo = p.in[I_WOUT] + (size_t)512 * 1024 + n;
        float a0 = 0.f, a1 = 0.f, a2 = 0.f, a3 = 0.f;
        const float* wp = p.in[I_WPOOL] + (size_t)c * 128; const float* ps = p.in[I_PSCALE];
#pragma unroll 8
        for (int e = 0; e < 128; ++e) {
            a0 += wp[e] * ps[e] * wo[(size_t)e * 1024];
            a1 += wp[16384 + e] * ps[128 + e] * wo[(size_t)(128 + e) * 1024];
            a2 += wp[32768 + e] * ps[256 + e] * wo[(size_t)(256 + e) * 1024];
            a3 += wp[49152 + e] * ps[384 + e] * wo[(size_t)(384 + e) * 1024];
        }
        bf16_t* dst = WOUT + (size_t)n * 1024 + 512 + c;
        dst[0] = f2bf(a0); dst[128] = f2bf(a1); dst[256] = f2bf(a2); dst[384] = f2bf(a3);
    }
    float* cosT = (float*)(ws + WS_COS); float* sinT = (float*)(ws + WS_SIN);
    for (int o = gt; o < 8192 * 32; o += GT) {
        const int s = o >> 5, i = o & 31;
        const float inv = exp2f(-(float)i * (13.287712379549449f / 32.0f));
        const float ang = (float)s * inv;
        const double rev = (double)ang * 0.15915494309189535; const float fr = (float)(rev - __builtin_rint(rev));
        cosT[o] = __builtin_amdgcn_cosf(fr); sinT[o] = __builtin_amdgcn_sinf(fr);
    }
    float* rss = (float*)(ws + WS_RSS);
    for (int o = gt; o < MTOK; o += GT) rss[o] = 0.f;
    if (gt < 128) ((float*)(ws + WS_QKG))[gt] = gt < 64 ? p.in[I_QG][gt] : p.in[I_KG][gt - 64];
    bf16_t* H = (bf16_t*)(ws + WS_H);
    f32x4 g1[4];
#pragma unroll
    for (int i = 0; i < 4; ++i) g1[i] = *(const f32x4*)(p.in[I_N1G] + lane * 4 + 256 * i);
    for (int row = blockIdx.x * 8 + wid; row < MTOK; row += G * 8) {
        const float* xr = (row < NPROMPT ? p.in[I_XP] + (size_t)row * DM : p.in[I_XS] + (size_t)(row - NPROMPT) * DM) + lane * 4;
        f32x4 v[4]; float ss = 0.f;
#pragma unroll
        for (int i = 0; i < 4; ++i) { v[i] = *(const f32x4*)(xr + 256 * i); ss += (v[i][0] * v[i][0] + v[i][1] * v[i][1]) + (v[i][2] * v[i][2] + v[i][3] * v[i][3]); }
#pragma unroll
        for (int o = 1; o < 64; o <<= 1) ss += __shfl_xor(ss, o);
        const float rstd = rsqrtf(ss * (1.0f / 1024.0f) + EPSV);
        bf16_t* hr = H + (size_t)row * DM + lane * 4;
#pragma unroll
        for (int i = 0; i < 4; ++i) *(u32x2*)(hr + 256 * i) = pack4(v[i] * rstd * g1[i]);
    }
}

__device__ __forceinline__ void pool_phase(const bf16_t* zp, bf16_t* mixed, const int wave_s) {
    const int lane = lane_id(), c0 = lane * 8, half = 1 << (lane >> 4);
    for (int r = blockIdx.x * 8 + wave_s; r < MTOK / 64; r += gridDim.x * 8) {
        const int tok_base = r * 64, S = tok_base < NPROMPT ? SEQP : SEQS, pos0 = tok_base & (S - 1);
        const bf16_t* zs = zp + (size_t)(tok_base - pos0) * 512 + c0;
        bf16_t* ms = mixed + (size_t)(tok_base - pos0) * DM + 512 + c0;
        float s0 = 0.f, s1 = 0.f, s2 = 0.f, s3 = 0.f, s4 = 0.f, s5 = 0.f, s6 = 0.f, s7 = 0.f;
#define POOL_ACC(V_, sg) do { s0 += sg bflo(V_.x); s1 += sg bfhi(V_.x); s2 += sg bflo(V_.y); s3 += sg bfhi(V_.y); s4 += sg bflo(V_.z); s5 += sg bfhi(V_.z); s6 += sg bflo(V_.w); s7 += sg bfhi(V_.w); } while (0)
#pragma unroll
        for (int d = -8; d < 8; ++d) { const int j = pos0 + d; if (d >= -half && d < half && j >= 0 && j < S) { const u32x4 w = *(const u32x4*)(zs + (size_t)j * 512); POOL_ACC(w, +); } }
#pragma unroll 4
        for (int i = 0; i < 64; ++i) {
            const int sp = pos0 + i, lo = max(sp - half, 0), hi = min(sp + half - 1, S - 1);
            const float ic = 1.0f / (float)(hi - lo + 1);
            const u32x4 w = *(const u32x4*)(zs + (size_t)sp * 512);
            u32x4 o;
            o.x = cvt_pk_bf16(s0 * ic - bflo(w.x), s1 * ic - bfhi(w.x)); o.y = cvt_pk_bf16(s2 * ic - bflo(w.y), s3 * ic - bfhi(w.y));
            o.z = cvt_pk_bf16(s4 * ic - bflo(w.z), s5 * ic - bfhi(w.z)); o.w = cvt_pk_bf16(s6 * ic - bflo(w.w), s7 * ic - bfhi(w.w));
            *(u32x4*)(ms + (size_t)sp * DM) = o;
            const int jn = sp + half, jo = sp - half;
            if (jn < S) { const u32x4 wn = *(const u32x4*)(zs + (size_t)jn * 512); POOL_ACC(wn, +); }
            if (jo >= 0) { const u32x4 wo = *(const u32x4*)(zs + (size_t)jo * 512); POOL_ACC(wo, -); }
        }
    }
}

#define MFMA32(a, b, c) __builtin_amdgcn_mfma_f32_32x32x16_bf16((a), (b), (c), 0, 0, 0)
constexpr int KROW = 256, VROW = 128, KBUF = 64 * KROW, VBUF = 128 * VROW, ABUF = KBUF + VBUF, QROW = 272;
__device__ __forceinline__ bf16x8 packp(const f32x16& x, int s) {
    u32x4 w;
    w.x = cvt_pk_bf16(x[8 * s + 0], x[8 * s + 1]); w.y = cvt_pk_bf16(x[8 * s + 2], x[8 * s + 3]); w.z = cvt_pk_bf16(x[8 * s + 4], x[8 * s + 5]); w.w = cvt_pk_bf16(x[8 * s + 6], x[8 * s + 7]);
    return __builtin_bit_cast(bf16x8, w);
}
__device__ __forceinline__ void attn_phase_online(LAS unsigned char* lds, const bf16_t* q, const bf16_t* k, const bf16_t* vT, bf16_t* mixed, float lam, const int wave_s) {
    int tid_ = wave_s * 64 + lane_id(); asm volatile("" : "+v"(tid_));
    const int tid = tid_, lane = tid & 63, r32 = lane & 31, hi = lane >> 5, wid = __builtin_amdgcn_readfirstlane(tid >> 6), G = gridDim.x;
    unsigned koff[2], voff[2];
#pragma unroll
    for (int i = 0; i < 2; ++i) {
        const int kr = 4 * (2 * wid + i) + (lane >> 4), kc = (lane & 15) ^ (kr & 15); koff[i] = (unsigned)(kr * 512 + kc * 8) * 2u;
        const int vd = 8 * (2 * wid + i) + (lane >> 3), vc = (lane & 7) ^ ((vd >> 1) & 7); voff[i] = (unsigned)(vd * MTOK + vc * 8) * 2u;
    }
    const int kx = r32 & 15, vx = (r32 >> 1) & 7;
    const unsigned lds0 = (unsigned)(size_t)lds;
#define ATT_DMA1(sbase, voff_, ldsdst) do { unsigned keep_; asm volatile("s_mov_b32 %0, m0\n\ts_mov_b32 m0, %3\n\ts_nop 0\n\tglobal_load_lds_dwordx4 %1, %2\n\ts_mov_b32 m0, %0" : "=&s"(keep_) : "v"(voff_), "s"(sbase), "s"(ldsdst) : "memory"); } while (0)
#define ATT_DMA(buf, kp, vp) do { _Pragma("unroll") for (int _i = 0; _i < 2; ++_i) { \
        ATT_DMA1((kp), koff[_i], lds0 + (unsigned)((buf) + (2 * wid + _i) * 1024)); \
        ATT_DMA1((vp), voff[_i], lds0 + (unsigned)((buf) + KBUF + (2 * wid + _i) * 1024)); } } while (0)
    for (int U = blockIdx.x; U < 2048; U += G) {
        const int rnd = U >> 8, cc = U & 255, x = cc & 7, jj = cc >> 3;
        int S, tok0, h, qb;
        if (rnd < 4) { const int pair = 4 * x + rnd; S = SEQS; tok0 = NPROMPT + (pair >> 2) * SEQS; h = pair & 3; qb = jj; }
        else { const int pair = 8 * x + 2 * (rnd - 4) + (jj >> 4); S = SEQP; tok0 = (pair >> 2) * SEQP; h = pair & 3; qb = jj & 15; }
        const bf16_t* Kg = k + (size_t)tok0 * 512 + h * 128;
        const bf16_t* Vg = vT + (size_t)(h * 128) * MTOK + tok0;
        const int NT = S / 64;
        const size_t qrow = (size_t)tok0 + qb * 256 + wid * 32 + r32;
        ATT_DMA(0, Kg, Vg);
        LAS unsigned char* Qs = lds + 2 * ABUF + wid * (32 * QROW) + r32 * QROW + hi * 16;
#pragma unroll
        for (int m = 0; m < 2; ++m)
#pragma unroll
            for (int d0 = 0; d0 < 4; ++d0) *(LAS bf16x8*)(Qs + m * 128 + d0 * 32) = *(const bf16x8*)(q + qrow * 512 + h * 128 + m * 64 + d0 * 16 + hi * 8);
        f32x16 o[2][4];
#pragma unroll
        for (int m = 0; m < 2; ++m)
#pragma unroll
            for (int db = 0; db < 4; ++db)
#pragma unroll
                for (int i = 0; i < 16; ++i) o[m][db][i] = 0.f;
        float mu[2] = {-1e30f, -1e30f}, l[2] = {0.f, 0.f};
        asm volatile("s_waitcnt vmcnt(0)" ::: "memory");
        __syncthreads();
        for (int t = 0; t < NT; ++t) {
            const int cb = (t & 1) * ABUF, nb = ((t + 1) & 1) * ABUF;
            if (t + 1 < NT) ATT_DMA(nb, Kg + (size_t)(t + 1) * 64 * 512, Vg + (t + 1) * 64);
            const LAS unsigned char* Kb = lds + cb + r32 * KROW;
            const LAS unsigned char* Vb = lds + cb + KBUF + r32 * VROW;
#pragma unroll
            for (int m = 0; m < 2; ++m) {
                f32x16 s0, s1;
#pragma unroll
                for (int i = 0; i < 16; ++i) { s0[i] = 0.f; s1[i] = 0.f; }
#pragma unroll
                for (int d0 = 0; d0 < 4; ++d0) {
                    const int kpos = ((m * 8 + d0 * 2 + hi) ^ kx) * 16;
                    const bf16x8 k0 = *(const LAS bf16x8*)(Kb + kpos), k1 = *(const LAS bf16x8*)(Kb + 32 * KROW + kpos);
                    const bf16x8 qv = *(const LAS bf16x8*)(Qs + m * 128 + d0 * 32);
                    s0 = MFMA32(k0, qv, s0); s1 = MFMA32(k1, qv, s1);
                    if (d0 == 1) __builtin_amdgcn_sched_barrier(0);
                }
                __builtin_amdgcn_sched_barrier(0);
                float mx = fmaxf(s0[0], s1[0]);
#pragma unroll
                for (int i = 1; i < 16; ++i) mx = fmaxf(mx, fmaxf(s0[i], s1[i]));
                mx = fmaxf(mx, __shfl_xor(mx, 32));
                const bool need = mx > mu[m] + 8.0f;
                if (__builtin_amdgcn_ballot_w64(need) != 0ull) {
                    const float nm = need ? mx : mu[m];
                    const float alpha = __builtin_amdgcn_exp2f(mu[m] - nm);
                    mu[m] = nm; l[m] *= alpha;
#pragma unroll
                    for (int db = 0; db < 4; ++db)
#pragma unroll
                        for (int i = 0; i < 16; ++i) o[m][db][i] *= alpha;
                }
                const float mm = mu[m];
                float ls = 0.f;
#pragma unroll
                for (int i = 0; i < 16; ++i) { s0[i] = __builtin_amdgcn_exp2f(s0[i] - mm); s1[i] = __builtin_amdgcn_exp2f(s1[i] - mm); ls += s0[i] + s1[i]; }
                l[m] += ls;
                const bf16x8 p0 = packp(s0, 0), p1 = packp(s0, 1), p2 = packp(s1, 0), p3 = packp(s1, 1);
                __builtin_amdgcn_sched_barrier(0);
#pragma unroll
                for (int db = 0; db < 4; ++db) {
                    const LAS unsigned char* vb = Vb + db * 32 * VROW;
                    const bf16x8 v0 = *(const LAS bf16x8*)(vb + ((0 + hi) ^ vx) * 16), v1 = *(const LAS bf16x8*)(vb + ((2 + hi) ^ vx) * 16), v2 = *(const LAS bf16x8*)(vb + ((4 + hi) ^ vx) * 16), v3 = *(const LAS bf16x8*)(vb + ((6 + hi) ^ vx) * 16);
                    o[m][db] = MFMA32(v0, p0, o[m][db]); o[m][db] = MFMA32(v1, p1, o[m][db]); o[m][db] = MFMA32(v2, p2, o[m][db]); o[m][db] = MFMA32(v3, p3, o[m][db]);
                    __builtin_amdgcn_sched_barrier(0);
                }
            }
            asm volatile("s_waitcnt vmcnt(0)" ::: "memory");
            __syncthreads();
        }
        const float l0 = l[0] + __shfl_xor(l[0], 32), l1 = l[1] + __shfl_xor(l[1], 32);
        const float c0 = 1.0f / l0, c1 = lam / l1;
        float ss = 0.f;
#pragma unroll
        for (int db = 0; db < 4; ++db)
#pragma unroll
            for (int i = 0; i < 16; ++i) { const float v = o[0][db][i] * c0 - o[1][db][i] * c1; o[0][db][i] = v; ss += v * v; }
        ss += __shfl_xor(ss, 32);
        const float rstd = rsqrtf(ss * (1.0f / 128.0f) + EPSV);
        bf16_t* orow = mixed + qrow * DM + h * 128 + 4 * hi;
#pragma unroll
        for (int db = 0; db < 4; ++db)
#pragma unroll
            for (int i4 = 0; i4 < 4; ++i4) {
                u32x2 w; w.x = cvt_pk_bf16(o[0][db][4 * i4] * rstd, o[0][db][4 * i4 + 1] * rstd); w.y = cvt_pk_bf16(o[0][db][4 * i4 + 2] * rstd, o[0][db][4 * i4 + 3] * rstd);
                *(u32x2*)(orow + 32 * db + 8 * i4) = w;
            }
    }
}


__device__ __forceinline__ void attn_phase_fast(LAS unsigned char* lds, const bf16_t* q, const bf16_t* k, const bf16_t* vT, bf16_t* mixed, float lam, const int wave_s) {
    int tid_ = wave_s * 64 + lane_id(); asm volatile("" : "+v"(tid_));
    const int wid = __builtin_amdgcn_readfirstlane(tid_ >> 6), G = gridDim.x;
    const unsigned lds0 = (unsigned)(size_t)lds;
    if (wid >= 4) __builtin_amdgcn_s_setprio(1);
    for (int U = blockIdx.x; U < 2048; U += G) {
        int lane_ = tid_ & 63; asm volatile("" : "+v"(lane_));
        const int lane = lane_, r32 = lane & 31, hi = lane >> 5;
        unsigned koff[2], voff[2];
#pragma unroll
        for (int i = 0; i < 2; ++i) {
            const int kr = 4 * (2 * wid + i) + (lane >> 4), kc = (lane & 15) ^ (kr & 15); koff[i] = (unsigned)(kr * 512 + kc * 8) * 2u;
            const int vd = 8 * (2 * wid + i) + (lane >> 3), vc = (lane & 7) ^ ((vd >> 1) & 7); voff[i] = (unsigned)(vd * MTOK + vc * 8) * 2u;
        }
        const int kx = r32 & 15, vx = (r32 >> 1) & 7;
        const int rnd = U >> 8, cc = U & 255, x = cc & 7, jj = cc >> 3;
        int S, tok0, h, qb;
        if (rnd < 4) { const int pair = 4 * x + rnd; S = SEQS; tok0 = NPROMPT + (pair >> 2) * SEQS; h = pair & 3; qb = jj; }
        else { const int pair = 8 * x + 2 * (rnd - 4) + (jj >> 4); S = SEQP; tok0 = (pair >> 2) * SEQP; h = pair & 3; qb = jj & 15; }
        const bf16_t* Kg = k + (size_t)tok0 * 512 + h * 128;
        const bf16_t* Vg = vT + (size_t)(h * 128) * MTOK + tok0;
        const int NT = S / 64;
        const size_t qrow = (size_t)tok0 + qb * 256 + wid * 32 + r32;
        ATT_DMA(0, Kg, Vg);
        LAS unsigned char* Qs = lds + 2 * ABUF + wid * (32 * QROW) + r32 * QROW + hi * 16;
#pragma unroll
        for (int m = 0; m < 2; ++m)
#pragma unroll
            for (int d0 = 0; d0 < 4; ++d0) *(LAS bf16x8*)(Qs + m * 128 + d0 * 32) = *(const bf16x8*)(q + qrow * 512 + h * 128 + m * 64 + d0 * 16 + hi * 8);
        f32x16 o[2][4];
#pragma unroll
        for (int m = 0; m < 2; ++m)
#pragma unroll
            for (int db = 0; db < 4; ++db)
#pragma unroll
                for (int i = 0; i < 16; ++i) o[m][db][i] = 0.f;
        float l[2] = {0.f, 0.f};
        asm volatile("s_waitcnt vmcnt(0)" ::: "memory");
        __syncthreads();
        for (int t = 0; t < NT; ++t) {
            const int cb = (t & 1) * ABUF, nb = ((t + 1) & 1) * ABUF;
            int ln = lane; asm volatile("" : "+v"(ln));
            const int r32 = ln & 31, hi = ln >> 5, kx = r32 & 15, vx = (r32 >> 1) & 7;
            if (t + 1 < NT) {
                unsigned koff[2], voff[2];
#pragma unroll
                for (int i = 0; i < 2; ++i) {
                    const int kr = 4 * (2 * wid + i) + (ln >> 4), kc = (ln & 15) ^ (kr & 15); koff[i] = (unsigned)(kr * 512 + kc * 8) * 2u;
                    const int vd = 8 * (2 * wid + i) + (ln >> 3), vc = (ln & 7) ^ ((vd >> 1) & 7); voff[i] = (unsigned)(vd * MTOK + vc * 8) * 2u;
                }
                ATT_DMA(nb, Kg + (size_t)(t + 1) * 64 * 512, Vg + (t + 1) * 64);
            }
            const LAS unsigned char* Qs = lds + 2 * ABUF + wid * (32 * QROW) + r32 * QROW + hi * 16;
            int kxh = (kx >> 1) << 5, vxh = (vx >> 1) << 5, kq = cb + r32 * KROW + ((hi ^ (kx & 1)) << 4), vq = cb + KBUF + r32 * VROW + ((hi ^ (vx & 1)) << 4);
            asm volatile("" : "+v"(kxh), "+v"(vxh), "+v"(kq), "+v"(vq));
            const LAS unsigned char* Kb = lds + kq;
            const LAS unsigned char* Vb = lds + vq;
#pragma unroll
            for (int m = 0; m < 2; ++m) {
                f32x16 s0, s1;
#pragma unroll
                for (int i = 0; i < 16; ++i) { s0[i] = 0.f; s1[i] = 0.f; }
#pragma unroll
                for (int d0 = 0; d0 < 4; ++d0) {
                    const int kpos = ((m * 4 + d0) << 5) ^ kxh;
                    const bf16x8 k0 = *(const LAS bf16x8*)(Kb + kpos), k1 = *(const LAS bf16x8*)(Kb + 32 * KROW + kpos);
                    const bf16x8 qv = *(const LAS bf16x8*)(Qs + m * 128 + d0 * 32);
                    s0 = MFMA32(k0, qv, s0); s1 = MFMA32(k1, qv, s1);
                }
                __builtin_amdgcn_sched_barrier(0);
                float ls = 0.f, ls2 = 0.f;
#pragma unroll
                for (int i = 0; i < 16; ++i) { float e0 = __builtin_amdgcn_exp2f(s0[i]), e1 = __builtin_amdgcn_exp2f(s1[i]); asm volatile("" : "+v"(e0), "+v"(e1)); s0[i] = e0; s1[i] = e1; ls += e0; ls2 += e1; }
                ls += ls2;
                l[m] += ls;
                const bf16x8 p0 = packp(s0, 0), p1 = packp(s0, 1), p2 = packp(s1, 0), p3 = packp(s1, 1);
#pragma unroll
                for (int db = 0; db < 4; ++db) {
                    const LAS unsigned char* vb = Vb + db * 32 * VROW;
                    const bf16x8 v0 = *(const LAS bf16x8*)(vb + (0 ^ vxh)), v1 = *(const LAS bf16x8*)(vb + (32 ^ vxh)), v2 = *(const LAS bf16x8*)(vb + (64 ^ vxh)), v3 = *(const LAS bf16x8*)(vb + (96 ^ vxh));
                    o[m][db] = MFMA32(v0, p0, o[m][db]); o[m][db] = MFMA32(v1, p1, o[m][db]); o[m][db] = MFMA32(v2, p2, o[m][db]); o[m][db] = MFMA32(v3, p3, o[m][db]);
                    if (db == 1) __builtin_amdgcn_sched_barrier(0);
                }
                __builtin_amdgcn_sched_barrier(0);
            }
            asm volatile("s_waitcnt vmcnt(0)" ::: "memory");
            __syncthreads();
        }
        const float l0 = l[0] + __shfl_xor(l[0], 32), l1 = l[1] + __shfl_xor(l[1], 32);
        const float c0 = 1.0f / l0, c1 = lam / l1;
        float ss = 0.f;
#pragma unroll
        for (int db = 0; db < 4; ++db)
#pragma unroll
            for (int i = 0; i < 16; ++i) { const float v = o[0][db][i] * c0 - o[1][db][i] * c1; o[0][db][i] = v; ss += v * v; }
        ss += __shfl_xor(ss, 32);
        const float rstd = rsqrtf(ss * (1.0f / 128.0f) + EPSV);
        int lane2 = lane_id(); asm volatile("" : "+v"(lane2));
        bf16_t* orow = mixed + ((size_t)tok0 + qb * 256 + wid * 32 + (lane2 & 31)) * DM + h * 128 + 4 * (lane2 >> 5);
#pragma unroll
        for (int db = 0; db < 4; ++db)
#pragma unroll
            for (int i4 = 0; i4 < 4; ++i4) {
                u32x2 w; w.x = cvt_pk_bf16(o[0][db][4 * i4] * rstd, o[0][db][4 * i4 + 1] * rstd); w.y = cvt_pk_bf16(o[0][db][4 * i4 + 2] * rstd, o[0][db][4 * i4 + 3] * rstd);
                *(u32x2*)(orow + 32 * db + 8 * i4) = w;
            }
    }
    __builtin_amdgcn_s_setprio(0);
}


__global__ void __launch_bounds__(512) fwd_megakernel(Params p) {
    extern __shared__ __attribute__((aligned(16))) unsigned char lds_raw[];
    LAS unsigned char* lds = (LAS unsigned char*)lds_raw;
    cg::grid_group grid = cg::this_grid();
    unsigned char* ws = p.ws;
    const int G = gridDim.x, c = blockIdx.x;
    const int wave_s = __builtin_amdgcn_readfirstlane((int)threadIdx.x >> 6);
    bf16_t* WQKP = (bf16_t*)(ws + WS_WQKP); bf16_t* WV = (bf16_t*)(ws + WS_WV); bf16_t* WOUT = (bf16_t*)(ws + WS_WOUT); bf16_t* WUP = (bf16_t*)(ws + WS_WUP); bf16_t* WDN = (bf16_t*)(ws + WS_WDN);
    float* cosT = (float*)(ws + WS_COS); float* sinT = (float*)(ws + WS_SIN); float* rss = (float*)(ws + WS_RSS);
    bf16_t* Q = (bf16_t*)(ws + WS_Q); bf16_t* Kt = (bf16_t*)(ws + WS_K); bf16_t* VT = (bf16_t*)(ws + WS_VT); bf16_t* ZP = (bf16_t*)(ws + WS_ZP);
    bf16_t* H = (bf16_t*)(ws + WS_H); bf16_t* MIX = H; bf16_t* XB = (bf16_t*)(ws + WS_XB); bf16_t* ACT = (bf16_t*)(ws + WS_ACT);

    volatile LAS unsigned* xb_st = (volatile LAS unsigned*)(lds + LDS_STAGE + LDS_EDGE);
    if (threadIdx.x < 4) xb_st[threadIdx.x] = 0u;
    __syncthreads();
    const XcdBarrier xbar = xcd_barrier_post((unsigned*)(ws + WS_BAR), xb_st);
#ifndef SKIP_P0
    p0_prologue(p, lds, wave_s);
#endif
    grid.sync();
#ifndef SKIP_P1
    {
        pg8::Gemm g{H, WQKP, MTOK, 1536, DM}; pg8::StaticOrder S; S.init(MTOK, 1536, G, c);
        EpiQKP E{ws, (const float*)(ws + WS_QKG), cosT, sinT};
        pg8::gemm_phase<EpiQKP, pg8::StaticOrder, true, true>(lds, g, S, E, wave_s);
    }
    {
        pg8::Gemm g{WV, H, 512, MTOK, DM}; pg8::StaticOrder S; S.init(512, MTOK, G, c);
        EpiVT E{VT};
        pg8::gemm_phase<EpiVT, pg8::StaticOrder, true, true>(lds, g, S, E, wave_s);
    }
#endif
    xcd_barrier(xbar);
#ifndef SKIP_P2
    pool_phase(ZP, MIX, wave_s);
    {
        float d1 = 0.f, d2 = 0.f;
        for (int i = 0; i < 64; ++i) { d1 += p.in[I_LQ1][i] * p.in[I_LK1][i]; d2 += p.in[I_LQ2][i] * p.in[I_LK2][i]; }
        const float lam = __builtin_bit_cast(float, __builtin_amdgcn_readfirstlane(__builtin_bit_cast(int, __expf(d1) - __expf(d2) + 0.2f)));
        float gq = 0.f, gk = 0.f;
        for (int i = 0; i < 64; ++i) { gq = fmaxf(gq, fabsf(p.in[I_QG][i])); gk = fmaxf(gk, fabsf(p.in[I_KG][i])); }
        const float bound = 64.0f * QSCALE * gq * gk;
        if (bound < 100.0f) attn_phase_fast(lds, Q, Kt, VT, MIX, lam, wave_s);
        else attn_phase_online(lds, Q, Kt, VT, MIX, lam, wave_s);
    }
#endif
    xcd_barrier(xbar);
#ifndef SKIP_P3
    {
        pg8::Gemm g{MIX, WOUT, MTOK, DM, DM}; pg8::StaticOrder S; S.init(MTOK, DM, G, c);
        EpiRes1 E{p.in[I_XP], p.in[I_XS], XB, rss};
        pg8::gemm_phase<EpiRes1, pg8::StaticOrder, true, true>(lds, g, S, E, wave_s);
    }
#endif
    xcd_barrier(xbar);
#ifndef SKIP_P4
    {
        pg8::Gemm g{XB, WUP, MTOK, 2 * DFF, DM}; pg8::StaticOrder S; S.init_tiles(517, 22, G, c, 1);
        EpiConvGate E{rss, p.in[I_CONVW], p.in[I_CONVB], ACT, (LAS float*)(lds + LDS_STAGE)};
        pg8::gemm_phase<EpiConvGate, pg8::StaticOrder, true, true>(lds, g, S, E, wave_s);
    }
#endif
    xcd_barrier(xbar);
#ifndef SKIP_P5
    {
        pg8::Gemm g{ACT, WDN, MTOK, DM, DFF}; pg8::StaticOrder S; S.init(MTOK, DM, G, c);
        EpiRes2 E{XB, p.out};
        pg8::gemm_phase<EpiRes2, pg8::StaticOrder, true, true>(lds, g, S, E, wave_s);
    }
#endif
}

extern "C" void kernel_launch(void* const* d_in, const int* in_sizes, int n_in, void* d_out, int out_size, void* d_ws, size_t ws_size, hipStream_t stream) {
    static int grid_blocks = 0;
    if (grid_blocks == 0) {
        if (n_in != 19 || ws_size < WS_END) { fprintf(stderr, "kernel_launch: unexpected n_in %d / ws_size %zu (need %zu)\n", n_in, ws_size, (size_t)WS_END); grid_blocks = -1; return; }
        int dev = 0, cus = 0, per_cu = 0;
        (void)hipGetDevice(&dev);
        (void)hipDeviceGetAttribute(&cus, hipDeviceAttributeMultiprocessorCount, dev);
        if (hipFuncSetAttribute((const void*)fwd_megakernel, hipFuncAttributeMaxDynamicSharedMemorySize, LDS_TOTAL) != hipSuccess) { fprintf(stderr, "kernel_launch: hipFuncSetAttribute failed\n"); grid_blocks = -1; return; }
        if (hipOccupancyMaxActiveBlocksPerMultiprocessor(&per_cu, (const void*)fwd_megakernel, 512, LDS_TOTAL) != hipSuccess || per_cu < 1) { fprintf(stderr, "kernel_launch: occupancy query failed (%d)\n", per_cu); (void)hipGetLastError(); per_cu = 1; }
        grid_blocks = cus * per_cu;
    }
    if (grid_blocks < 0) return;
    if (hipMemsetAsync((char*)d_ws + WS_BAR, 0, XCD_BAR_WORDS * sizeof(unsigned), stream) != hipSuccess) { fprintf(stderr, "kernel_launch: hipMemsetAsync of the barrier words failed\n"); return; }
    Params p{};
    for (int i = 0; i < 19; ++i) p.in[i] = (const float*)d_in[i];
    p.out = (float*)d_out; p.ws = (unsigned char*)d_ws;
    void* args[] = {&p};
    hipError_t e = hipLaunchCooperativeKernel((const void*)fwd_megakernel, dim3(grid_blocks), dim3(512), args, LDS_TOTAL, stream);
    if (e != hipSuccess) fprintf(stderr, "cooperative launch failed: %s (grid %d)\n", hipGetErrorString(e), grid_blocks);
}
```
